# Optimizing an MI355X kernel written in HIP

```python
import jax, jax.numpy as jnp
from jax import lax
import numpy as np

D_MODEL = 1024
BATCH = 8
SEQ = 4096
DEPTH = 4

D_MIX = D_MODEL
A_WIDTH = D_MIX // 2
A_HEADS = 4
A_HEAD_DIM = A_WIDTH // A_HEADS
A_CHUNK = 128
B_WIDTH = D_MIX - A_WIDTH
B_HEADS = 4
B_V_DIM = B_WIDTH // B_HEADS
B_K_DIM = B_V_DIM // 2
B_KEY_WIDTH = B_HEADS * B_K_DIM
B_GATE_RANK = 16
B_GATE_TAU = 16.0
B_CHUNK = 64
IN_WIDTHS = (A_WIDTH, A_WIDTH, B_KEY_WIDTH, B_KEY_WIDTH, B_WIDTH, B_WIDTH, B_GATE_RANK)
IN_OFFSETS = tuple(int(o) for o in np.cumsum((0,) + IN_WIDTHS))
P_IN = IN_OFFSETS[-1]
N_GROUPS = 4
EXPERTS_PER_GROUP = 8
N_EXPERTS = N_GROUPS * EXPERTS_PER_GROUP
TOP_K_INNER = 2
D_EXPERT = 512
MOE_BLOCK = 256
EPS = 1e-6

kernel_name = "hymba_sgu_gla_hmoe_adaln_trunk"


def rms_norm(x, gain):
    x32 = x.astype(jnp.float32)
    y = x32 * lax.rsqrt(jnp.mean(x32 * x32, axis=-1, keepdims=True) + EPS)
    return (y * gain.astype(jnp.float32)).astype(x.dtype)


def sgu_mixer(u, v, v_gain, w_s, b_s):
    bsz, s, _ = u.shape
    nc = s // A_CHUNK
    v = rms_norm(v, v_gain).reshape(bsz, nc, A_CHUNK, A_HEADS, A_HEAD_DIM)
    causal = jnp.tril(jnp.ones((A_CHUNK, A_CHUNK), dtype=bool))
    w = jnp.where(causal[None], w_s, 0.0).astype(v.dtype)
    z = jnp.einsum('hts,bcshd->bcthd', w, v) + b_s.T.astype(v.dtype)[:, :, None]
    return u * z.reshape(bsz, s, A_WIDTH)


def gla_mixer(q, k, v, r, a_low, w_alpha, b_alpha, out_gain):
    f32 = jnp.float32
    bsz, s, _ = q.shape
    nc = s // B_CHUNK
    q = q.astype(f32).reshape(bsz, s, B_HEADS, B_K_DIM) * (B_K_DIM ** -0.5)
    k = k.astype(f32).reshape(bsz, s, B_HEADS, B_K_DIM)
    v = v.astype(f32).reshape(bsz, s, B_HEADS, B_V_DIM)
    log_a = jax.nn.log_sigmoid((a_low @ w_alpha + b_alpha).astype(f32)) / B_GATE_TAU
    log_a = log_a.reshape(bsz, s, B_HEADS, B_K_DIM)

    def chunks(t):
        return t.reshape(bsz, nc, B_CHUNK, *t.shape[2:]).swapaxes(0, 1)

    causal = jnp.tril(jnp.ones((B_CHUNK, B_CHUNK), dtype=bool))[None, :, :, None, None]

    def step(state, inp):
        qc, kc, vc, gc = inp
        bcum = jnp.cumsum(gc, axis=1)
        blast = bcum[:, -1]
        o_inter = jnp.einsum('bthk,bhkv->bthv', qc * jnp.exp(bcum), state)
        diff = jnp.where(causal, bcum[:, :, None] - bcum[:, None, :], -jnp.inf)
        scores = jnp.einsum('bthk,bshk,btshk->btsh', qc, kc, jnp.exp(diff))
        o_intra = jnp.einsum('btsh,bshv->bthv', scores, vc)
        k_dec = kc * jnp.exp(blast[:, None] - bcum)
        state = state * jnp.exp(blast)[..., None] + jnp.einsum('bshk,bshv->bhkv', k_dec, vc)
        return state, o_inter + o_intra

    state0 = jnp.zeros((bsz, B_HEADS, B_K_DIM, B_V_DIM), f32)
    _, o = lax.scan(step, state0, (chunks(q), chunks(k), chunks(v), chunks(log_a)))
    o = o.swapaxes(0, 1).reshape(bsz, s, B_HEADS, B_V_DIM)
    o = o * lax.rsqrt(jnp.mean(o * o, axis=-1, keepdims=True) + EPS)
    o = o * out_gain.astype(f32).reshape(B_HEADS, B_V_DIM)
    o = o.reshape(bsz, s, B_WIDTH) * jax.nn.silu(r.astype(f32))
    return o.astype(r.dtype)


def hier_moe(h, w_group, b_group, w_router, b_router, w1, w3, w2):
    bsz, s, d = h.shape
    t = bsz * s
    ht = h.reshape(t, d)
    g_logits = (ht @ w_group + b_group).astype(jnp.float32)
    g_prob = jax.nn.softmax(g_logits, axis=-1)
    grp = jnp.argmax(g_logits, axis=-1)
    p_grp = jnp.take_along_axis(g_prob, grp[:, None], axis=1)[:, 0]
    e_logits = (ht @ w_router + b_router).astype(jnp.float32).reshape(t, N_GROUPS, EXPERTS_PER_GROUP)
    e_sel = jnp.take_along_axis(e_logits, grp[:, None, None], axis=1)[:, 0]
    top_v, top_i = lax.top_k(e_sel, TOP_K_INNER)
    gate = jax.nn.softmax(top_v, axis=-1) * p_grp[:, None]
    expert = grp[:, None] * EXPERTS_PER_GROUP + top_i

    n_assign = t * TOP_K_INNER
    e_flat = expert.reshape(-1)
    tok = jnp.repeat(jnp.arange(t, dtype=jnp.int32), TOP_K_INNER)
    wt = gate.reshape(-1)
    order = jnp.argsort(e_flat)
    e_sorted = e_flat[order]
    tok_sorted = tok[order]
    counts = jax.ops.segment_sum(jnp.ones((n_assign,), jnp.int32), e_flat, num_segments=N_EXPERTS)
    starts = jnp.cumsum(counts) - counts
    padded = ((counts + MOE_BLOCK - 1) // MOE_BLOCK) * MOE_BLOCK
    pad_ends = jnp.cumsum(padded)
    pad_starts = pad_ends - padded
    dest = pad_starts[e_sorted] + (jnp.arange(n_assign, dtype=jnp.int32) - starts[e_sorted])
    n_blocks = (n_assign + MOE_BLOCK - 1) // MOE_BLOCK + N_EXPERTS
    total = n_blocks * MOE_BLOCK
    x_pad = jnp.zeros((total, d), h.dtype).at[dest].set(ht[tok_sorted])
    block_start = jnp.arange(n_blocks, dtype=jnp.int32) * MOE_BLOCK
    block_expert = jnp.minimum(jnp.searchsorted(pad_ends, block_start, side='right'), N_EXPERTS - 1)

    def run_block(args):
        xb, e = args
        return (jax.nn.silu(xb @ w1[e]) * (xb @ w3[e])) @ w2[e]

    y_pad = lax.map(run_block, (x_pad.reshape(n_blocks, MOE_BLOCK, d), block_expert))
    y = y_pad.reshape(total, d)[dest] * wt[order][:, None].astype(h.dtype)
    out = jnp.zeros((t, d), h.dtype).at[tok_sorted].add(y.astype(h.dtype))
    return out.reshape(bsz, s, d)


def setup_inputs(seed: int = 0) -> dict:
    key = jax.random.key(seed)
    ks = jax.random.split(key, 24)
    f32 = jnp.float32
    nrm = lambda k, shape, scale: jax.random.normal(k, shape, f32) * scale
    return {
        "x": nrm(ks[0], (BATCH, SEQ, D_MODEL), 1.0),
        "c": nrm(ks[1], (BATCH, D_MODEL), 1.0),
        "w_ada": nrm(ks[2], (DEPTH, D_MODEL, 6 * D_MODEL), 0.5 * D_MODEL ** -0.5),
        "b_ada": nrm(ks[3], (DEPTH, 6 * D_MODEL), 0.02),
        "norm1_gain": 1.0 + nrm(ks[4], (DEPTH, D_MODEL), 0.02),
        "norm2_gain": 1.0 + nrm(ks[5], (DEPTH, D_MODEL), 0.02),
        "w_in": nrm(ks[6], (DEPTH, D_MODEL, P_IN), D_MODEL ** -0.5),
        "a_v_gain": 1.0 + nrm(ks[7], (DEPTH, A_WIDTH), 0.02),
        "a_w_s": nrm(ks[8], (DEPTH, A_HEADS, A_CHUNK, A_CHUNK), A_CHUNK ** -0.5),
        "a_b_s": 1.0 + nrm(ks[9], (DEPTH, A_HEADS, A_CHUNK), 0.02),
        "b_w_alpha": nrm(ks[10], (DEPTH, B_GATE_RANK, B_KEY_WIDTH), B_GATE_RANK ** -0.5),
        "b_b_alpha": nrm(ks[11], (DEPTH, B_KEY_WIDTH), 0.1),
        "b_out_gain": 1.0 + nrm(ks[12], (DEPTH, B_WIDTH), 0.02),
        "w_out": nrm(ks[13], (DEPTH, D_MIX, D_MODEL), D_MIX ** -0.5),
        "w_group": nrm(ks[14], (DEPTH, D_MODEL, N_GROUPS), D_MODEL ** -0.5),
        "b_group": nrm(ks[15], (DEPTH, N_GROUPS), 0.01),
        "w_router": nrm(ks[16], (DEPTH, D_MODEL, N_EXPERTS), D_MODEL ** -0.5),
        "b_router": nrm(ks[17], (DEPTH, N_EXPERTS), 0.01),
        "w1": nrm(ks[18], (DEPTH, N_EXPERTS, D_MODEL, D_EXPERT), D_MODEL ** -0.5),
        "w3": nrm(ks[19], (DEPTH, N_EXPERTS, D_MODEL, D_EXPERT), D_MODEL ** -0.5),
        "w2": nrm(ks[20], (DEPTH, N_EXPERTS, D_EXPERT, D_MODEL), D_EXPERT ** -0.5),
        "final_gain": 1.0 + nrm(ks[21], (D_MODEL,), 0.02),
    }


def reference(x, c, w_ada, b_ada, norm1_gain, norm2_gain, w_in, a_v_gain, a_w_s, a_b_s,
              b_w_alpha, b_b_alpha, b_out_gain, w_out, w_group, b_group, w_router, b_router,
              w1, w3, w2, final_gain):
    o = IN_OFFSETS
    c_act = jax.nn.silu(c)
    for l in range(DEPTH):
        mod = c_act @ w_ada[l] + b_ada[l]
        sh1, sc1, g1, sh2, sc2, g2 = [m[:, None, :] for m in jnp.split(mod, 6, axis=-1)]
        h = rms_norm(x, norm1_gain[l]) * (1.0 + sc1) + sh1
        proj = h @ w_in[l]
        a_u = jax.nn.gelu(proj[..., o[0]:o[1]])
        a_v = jax.nn.gelu(proj[..., o[1]:o[2]])
        y_a = sgu_mixer(a_u, a_v, a_v_gain[l], a_w_s[l], a_b_s[l])
        y_b = gla_mixer(proj[..., o[2]:o[3]], proj[..., o[3]:o[4]], proj[..., o[4]:o[5]],
                        proj[..., o[5]:o[6]], proj[..., o[6]:o[7]],
                        b_w_alpha[l], b_b_alpha[l], b_out_gain[l])
        mixed = jnp.concatenate([y_a, y_b], axis=-1) @ w_out[l]
        x = x + g1 * mixed
        h2 = rms_norm(x, norm2_gain[l]) * (1.0 + sc2) + sh2
        x = x + g2 * hier_moe(h2, w_group[l], b_group[l], w_router[l], b_router[l],
                              w1[l], w3[l], w2[l])
    return rms_norm(x, final_gain)
```

```cpp
#include <hip/hip_runtime.h>
#include <stdint.h>
#include <stdio.h>

#define LAS __attribute__((address_space(3)))
typedef unsigned short bf16_t;
typedef short bf16x8 __attribute__((ext_vector_type(8)));
typedef short s16x4 __attribute__((ext_vector_type(4)));
typedef float f32x4 __attribute__((ext_vector_type(4)));
typedef float f32x2 __attribute__((ext_vector_type(2)));
typedef unsigned u32x4 __attribute__((ext_vector_type(4)));
typedef unsigned u32x2 __attribute__((ext_vector_type(2)));
typedef int i32x4 __attribute__((ext_vector_type(4)));
typedef int i32x8 __attribute__((ext_vector_type(8)));

constexpr int T = 32768, D = 1024, SEQ = 4096, NL = 4, PIN = 2576, NPJ = 2560, NIN = 2816;
constexpr int LDS_BYTES = 147456, SCR_OFF = 1024;
constexpr int L_BLK = 64, L_CNT = 256, L_NB = 384, L_QW = 448;
constexpr float EPS = 1e-6f;
constexpr size_t al256(size_t x) { return (x + 255) & ~(size_t)255; }
constexpr size_t WS_CTL = 0, CTL_BYTES = 1 << 20, CTL_CNT = 16384, CTL_Q = 20480;
constexpr size_t WS_MOD = WS_CTL + CTL_BYTES;
constexpr size_t WS_WIN = WS_MOD + al256((size_t)4 * 8 * 6144 * 4);
constexpr size_t WS_WOUT = WS_WIN + (size_t)4 * 2816 * 1024 * 2;
constexpr size_t WS_W13 = WS_WOUT + (size_t)4 * 1024 * 1024 * 2;
constexpr size_t WS_W2 = WS_W13 + (size_t)4 * 32 * 1024 * 1024 * 2;
constexpr size_t WS_WS = WS_W2 + (size_t)4 * 32 * 1024 * 512 * 2;
constexpr size_t WS_WR = WS_WS + (size_t)4 * 4 * 128 * 128 * 2;
constexpr size_t WS_H = WS_WR + (size_t)4 * 48 * 1024 * 2;
constexpr size_t WS_PROJ = WS_H + (size_t)T * 1024 * 2;
constexpr size_t WS_GATE = WS_PROJ + (size_t)T * 2560 * 2;
constexpr size_t WS_KV = WS_GATE + (size_t)T * 256 * 4;
constexpr size_t WS_SST = WS_KV + (size_t)2048 * 8192 * 4;
constexpr size_t WS_DEC = WS_SST + (size_t)2048 * 8192 * 2;
constexpr size_t WS_Y = WS_DEC + (size_t)2048 * 64 * 4;
constexpr size_t WS_ROUTE = WS_Y + (size_t)T * 1024 * 2;
constexpr size_t WS_TOKOF = WS_ROUTE + (size_t)T * 32;
constexpr size_t WS_XB = WS_TOKOF + (size_t)32 * 32768 * 4;
constexpr size_t WS_PSQ = WS_XB + (size_t)T * 1024 * 2;
constexpr size_t WS_AVSQ = WS_PSQ + (size_t)T * 16 * 4;
constexpr size_t WS_END = WS_AVSQ + (size_t)T * 8 * 4;
static_assert((size_t)73728 * 1024 * 2 <= (size_t)T * 2560 * 2, "YPAD alias");
static_assert((size_t)73728 * 512 * 2 <= (size_t)2048 * 8192 * 6, "HID alias");

__device__ __forceinline__ int lane_id() { return (int)__builtin_amdgcn_mbcnt_hi(~0u, __builtin_amdgcn_mbcnt_lo(~0u, 0u)); }
__device__ __forceinline__ unsigned pk2(float lo, float hi) { unsigned r; asm("v_cvt_pk_bf16_f32 %0, %1, %2" : "=v"(r) : "v"(lo), "v"(hi)); return r; }
__device__ __forceinline__ float bflo(unsigned u) { return __uint_as_float(u << 16); }
__device__ __forceinline__ float bfhi(unsigned u) { return __uint_as_float(u & 0xffff0000u); }
__device__ __forceinline__ float bf1(bf16_t u) { return __uint_as_float(((unsigned)u) << 16); }
__device__ __forceinline__ float fexp(float x) { return __builtin_amdgcn_exp2f(x * 1.4426950408889634f); }
__device__ __forceinline__ float frcp(float x) { return __builtin_amdgcn_rcpf(x); }
__device__ __forceinline__ float frsq(float x) { return __builtin_amdgcn_rsqf(x); }
__device__ __forceinline__ float silu_f(float x) { return x * frcp(1.f + fexp(-x)); }
__device__ __forceinline__ float gelu_f(float x) { const float u = 1.5957691216057308f * (x + 0.044715f * x * x * x); return x * frcp(1.f + fexp(-u)); }
__device__ __forceinline__ f32x2 silu_pk(f32x2 x) { const f32x2 t = x * (-1.4426950408889634f); f32x2 e; e.x = __builtin_amdgcn_exp2f(t.x); e.y = __builtin_amdgcn_exp2f(t.y);
    const f32x2 d = e + 1.0f; f32x2 r; r.x = __builtin_amdgcn_rcpf(d.x); r.y = __builtin_amdgcn_rcpf(d.y); return x * r; }
__device__ __forceinline__ f32x2 gelu_pk(f32x2 x) { const f32x2 t = (x * x * (-0.10294324f) + (-2.3022082f)) * x; f32x2 e; e.x = __builtin_amdgcn_exp2f(t.x); e.y = __builtin_amdgcn_exp2f(t.y);
    const f32x2 d = e + 1.0f; f32x2 r; r.x = __builtin_amdgcn_rcpf(d.x); r.y = __builtin_amdgcn_rcpf(d.y); return x * r; }
__device__ __forceinline__ f32x4 silu4(f32x4 v) { const f32x2 a = silu_pk((f32x2){v[0], v[1]}), b = silu_pk((f32x2){v[2], v[3]}); return (f32x4){a.x, a.y, b.x, b.y}; }
__device__ __forceinline__ f32x4 gelu4(f32x4 v) { const f32x2 a = gelu_pk((f32x2){v[0], v[1]}), b = gelu_pk((f32x2){v[2], v[3]}); return (f32x4){a.x, a.y, b.x, b.y}; }
__device__ __forceinline__ float logsig_f(float x) { return fminf(x, 0.f) - 0.6931471805599453f * __builtin_amdgcn_logf(1.f + fexp(-fabsf(x))); }

#define XB_TMO      128
#define XB_XCNT(j)  (256  + 64 * (j))
#define XB_XSUB(j)  (1280 + 64 * (j))
#define XB_XGEN(j)  (2304 + 64 * (j))
#define XB_TOP      3328
#define XB_TOPGEN   3392
#define XCD_BAR_WORDS 3456
#define XB_SPIN_CAP (1u << 18)
__device__ __forceinline__ unsigned xb_ld(unsigned* p)              { return __hip_atomic_load(p, __ATOMIC_RELAXED, __HIP_MEMORY_SCOPE_AGENT); }
__device__ __forceinline__ unsigned xb_add(unsigned* p, unsigned v) { return __hip_atomic_fetch_add(p, v, __ATOMIC_RELAXED, __HIP_MEMORY_SCOPE_AGENT); }
__device__ __forceinline__ unsigned xb_xcc_id() { return (unsigned)__builtin_amdgcn_s_getreg((3 << 11) | 20) & 0xFu; }
#define XB_SPIN(cond, bar) do { unsigned _sp = 0; while (cond) { __builtin_amdgcn_s_sleep(1); \
    if ((++_sp & 255u) == 0u) { if (xb_ld(&(bar)[XB_TMO])) break; if (_sp > XB_SPIN_CAP) { atomicAdd(&(bar)[XB_TMO], 1u); break; } } } } while (0)
struct XcdBarrier { unsigned* bar; unsigned x; volatile LAS unsigned* st; };
__device__ __forceinline__ XcdBarrier xcd_barrier_post(unsigned* bar, volatile LAS unsigned* st, bool leader) {
    XcdBarrier b; b.bar = bar; b.x = xb_xcc_id(); b.st = st;
    if (leader) (void)xb_add(&bar[XB_XCNT(b.x)], 1u);
    return b;
}
__device__ __forceinline__ void xcd_barrier_complete(unsigned* bar, unsigned x, unsigned& nloc, unsigned& nx) {
    const unsigned G = gridDim.x * gridDim.y * gridDim.z;
    unsigned sum, cnt, mine, sp = 0u;
    for (;;) {
        sum = 0u; cnt = 0u; mine = 0u;
#pragma unroll
        for (unsigned j = 0; j < 16; ++j) { const unsigned c = xb_ld(&bar[XB_XCNT(j)]); sum += c; cnt += (c > 0u) ? 1u : 0u; mine = (j == x) ? c : mine; }
        if (sum == G) break;
        __builtin_amdgcn_s_sleep(1);
        if ((++sp & 255u) == 0u) { if (xb_ld(&bar[XB_TMO])) break; if (sp > XB_SPIN_CAP) { atomicAdd(&bar[XB_TMO], 1u); break; } }
    }
    nloc = mine > 0u ? mine : 1u; nx = cnt > 0u ? cnt : 1u;
}
__device__ __forceinline__ void xcd_barrier(const XcdBarrier& b, bool leader) {
    asm volatile("s_waitcnt vmcnt(0)" ::: "memory");
    __syncthreads();
    if (leader) {
        unsigned* bar = b.bar;
        __builtin_amdgcn_s_waitcnt(0);
        unsigned nloc = b.st[0], nx = b.st[1];
        if (nloc == 0u) { xcd_barrier_complete(bar, b.x, nloc, nx); b.st[0] = nloc; b.st[1] = nx; }
        const unsigned old = xb_add(&bar[XB_XSUB(b.x)], 1u);
        const unsigned gen = old / nloc;
        if (old + 1u == (gen + 1u) * nloc) {
            __builtin_amdgcn_fence(__ATOMIC_RELEASE, "agent");
            asm volatile("s_waitcnt vmcnt(0)" ::: "memory");
            const unsigned og = xb_add(&bar[XB_TOP], 1u);
            const unsigned tg = og / nx;
            if (og + 1u == (tg + 1u) * nx) xb_add(&bar[XB_TOPGEN], 1u);
            else XB_SPIN(xb_ld(&bar[XB_TOPGEN]) == tg, bar);
            __builtin_amdgcn_fence(__ATOMIC_ACQUIRE, "agent");
            xb_add(&bar[XB_XGEN(b.x)], 1u);
            asm volatile("s_waitcnt vmcnt(0)" ::: "memory");
        } else {
            XB_SPIN(xb_ld(&bar[XB_XGEN(b.x)]) == gen, bar);
            __builtin_amdgcn_fence(__ATOMIC_ACQUIRE, "agent");
            asm volatile("s_waitcnt vmcnt(0)" ::: "memory");
        }
    }
    __syncthreads();
}

namespace pg8 {
__device__ __forceinline__ bf16x8 as_bf16x8(i32x4 v) { return __builtin_bit_cast(bf16x8, v); }
constexpr int BM = 256, BK = 64, HALF = 128, HTB = HALF * BK * 2, STAGE_BYTES = 8 * HTB, NXCD = 8, WGM = 4;
__device__ __forceinline__ int lds_byte(int r, int c) { const int st = (r >> 4) * 2 + (c >> 5), rr = r & 15, cc = c & 31, ob = rr * 64 + cc * 2; return st * 1024 + (ob ^ (((ob >> 9) & 1) << 5)); }
__device__ __forceinline__ void stage_rc(int b, int& R, int& C) { const int st = b / 1024, sb = b % 1024, swz = sb ^ (((sb >> 9) & 1) << 5); R = (st >> 1) * 16 + swz / 64; C = (st & 1) * 32 + (swz % 64) / 2; }
__device__ __forceinline__ int perm32(int rho) { const int n = rho >> 4, i = rho & 15; return 8 * (i >> 2) + 4 * n + (i & 3); }
struct Unit { int pm, pn, e; };
__device__ __forceinline__ int xcd_remap(int L, int nwg) { const int q = nwg / NXCD, r = nwg % NXCD, xcd = L % NXCD, off = L / NXCD; return (xcd < r ? xcd * (q + 1) : r * (q + 1) + (xcd - r) * q) + off; }

template <bool FP8, class Epi, class Sched>
__device__ __forceinline__ void gemm_phase(LAS unsigned char* lds, const char* Abase, const int Kb, const Sched& S, const Epi& E, const int wv) {
    int tid_ = wv * 64 + lane_id(); asm volatile("" : "+v"(tid_));
    const int tid = tid_, wid = __builtin_amdgcn_readfirstlane(tid >> 6), lane = tid & 63, wr = wid >> 2, wc = wid & 3, fr = lane & 15, fq = lane >> 4;
    constexpr bool GATHER = Sched::GATHER;
    const int nt = Kb / 128;
    int Ri[2], Ci[2]; unsigned voffB[2], voffA[2];
#pragma unroll
    for (int i = 0; i < 2; ++i) { int R, C; stage_rc(tid * 16 + i * 8192, R, C); Ri[i] = R; Ci[i] = C; const int Rb = Epi::PERM ? ((R & ~31) + perm32(R & 31)) : R; voffB[i] = (unsigned)(Rb * Kb + C * 2); voffA[i] = (unsigned)(R * Kb + C * 2); }
    const unsigned kstep = (unsigned)(BK * 2);
    const unsigned hstep = (unsigned)(HALF * Kb);
    const unsigned tstep = 2u * hstep;
    const unsigned ldsw = (unsigned)wid * 1024u;
    const int aoff = lds_byte(wr * 64 + fr, fq * 8), boff = lds_byte(wc * 32 + fr, fq * 8);
#define PG8_SA(b, h) (((b) * 2 + (h)) * HTB)
#define PG8_SB(b, h) ((4 + (b) * 2 + (h)) * HTB)
#define PG8_STAGE(bufoff, gbase, voff) do { _Pragma("unroll") for (int _i = 0; _i < 2; ++_i) \
        __builtin_amdgcn_global_load_lds((const unsigned*)((const char*)(gbase) + (voff)[_i]), (LAS unsigned*)(lds + (bufoff) + ldsw + _i * 8192), 16, 0, 0); } while (0)
#define PG8_LDA(dst, b, h) do { _Pragma("unroll") for (int m = 0; m < 4; ++m) { dst[m].lo = *(const LAS i32x4*)(lds + PG8_SA(b, h) + aoff + m * 2048); dst[m].hi = *(const LAS i32x4*)(lds + PG8_SA(b, h) + aoff + m * 2048 + 1024); } } while (0)
#define PG8_LDB(dst, b, h) do { _Pragma("unroll") for (int n = 0; n < 2; ++n) { dst[n].lo = *(const LAS i32x4*)(lds + PG8_SB(b, h) + boff + n * 2048); dst[n].hi = *(const LAS i32x4*)(lds + PG8_SB(b, h) + boff + n * 2048 + 1024); } } while (0)
#define PG8_MMA(ai, bj, At, Bt) do { __builtin_amdgcn_s_setprio(1); _Pragma("unroll") for (int m = 0; m < 4; ++m) _Pragma("unroll") for (int n = 0; n < 2; ++n) { \
        if constexpr (FP8) asm volatile("v_mfma_scale_f32_16x16x128_f8f6f4 %0, %1, %2, %0, %3, %3 op_sel_hi:[0,0,0]" : "+v"(acc[ai][bj][m][n]) : "v"(Bt[n]), "v"(At[m]), "v"(one_scale)); \
        else { acc[ai][bj][m][n] = __builtin_amdgcn_mfma_f32_16x16x32_bf16(as_bf16x8(Bt[n].lo), as_bf16x8(At[m].lo), acc[ai][bj][m][n], 0, 0, 0); \
               acc[ai][bj][m][n] = __builtin_amdgcn_mfma_f32_16x16x32_bf16(as_bf16x8(Bt[n].hi), as_bf16x8(At[m].hi), acc[ai][bj][m][n], 0, 0, 0); } } \
        __builtin_amdgcn_s_setprio(0); } while (0)
#define PG8_WAIT_V(n) asm volatile("s_waitcnt vmcnt(" #n ")" ::: "memory")
#define PG8_WAIT_L(n) asm volatile("s_waitcnt lgkmcnt(" #n ")" ::: "memory")
#define PG8_BAR __builtin_amdgcn_s_barrier()
#define PG8_SCHED __builtin_amdgcn_sched_barrier(0)
    Unit cur, nxt; int ui = 0;
    if (!S.next(0, cur)) return;
    f32x4 acc[2][2][4][2];
#pragma unroll
    for (int a = 0; a < 2; ++a)
#pragma unroll
        for (int b = 0; b < 2; ++b)
#pragma unroll
            for (int m = 0; m < 4; ++m)
#pragma unroll
                for (int n = 0; n < 2; ++n) acc[a][b][m][n] = (f32x4){0.f, 0.f, 0.f, 0.f};
    i32x8 At[4], B0[2], B1[2];
    const int one_scale = 0x7f7f7f7f;
    unsigned ao0[2], ao1[2], an0[2], an1[2];
    const char* cA0; const char* cA1;
    if constexpr (GATHER) { S.a_off(cur, Ri[0], Ci[0], ao0[0], ao1[0]); S.a_off(cur, Ri[1], Ci[1], ao0[1], ao1[1]); cA0 = Abase; cA1 = Abase; }
    else { ao0[0] = ao1[0] = an0[0] = an1[0] = voffA[0]; ao0[1] = ao1[1] = an0[1] = an1[1] = voffA[1]; cA0 = Abase + (size_t)((unsigned)cur.pm * tstep); cA1 = cA0 + hstep; }
    const char* cB = S.b_ptr(cur);
    PG8_STAGE(PG8_SB(0, 0), cB, voffB); PG8_STAGE(PG8_SB(0, 1), cB + hstep, voffB); PG8_STAGE(PG8_SA(0, 0), cA0, ao0); PG8_STAGE(PG8_SA(0, 1), cA1, ao1);
    if (wr == 1) PG8_BAR;
    PG8_WAIT_V(2); PG8_BAR;
    PG8_STAGE(PG8_SB(1, 0), cB + kstep, voffB); PG8_STAGE(PG8_SA(1, 0), cA0 + kstep, ao0); PG8_STAGE(PG8_SB(1, 1), cB + hstep + kstep, voffB);
    PG8_WAIT_V(6); PG8_BAR;
    for (;;) {
        const bool has_next = S.next(ui + 1, nxt);
        const char* nB = cB; const char* nA0 = cA0; const char* nA1 = cA1;
        if (has_next) { nB = S.b_ptr(nxt);
            if constexpr (GATHER) { S.a_off(nxt, Ri[0], Ci[0], an0[0], an1[0]); S.a_off(nxt, Ri[1], Ci[1], an0[1], an1[1]); }
            else { nA0 = Abase + (size_t)((unsigned)nxt.pm * tstep); nA1 = nA0 + hstep; } }
        else if constexpr (GATHER) { an0[0] = ao0[0]; an0[1] = ao0[1]; an1[0] = ao1[0]; an1[1] = ao1[1]; }
        for (int t = 0; t < nt; t += 2) {
            const bool last = (t == nt - 2);
            const char* a1h1 = cA1 + (unsigned)(t + 1) * kstep;
            const char* a2h0 = last ? nA0 : cA0 + (unsigned)(t + 2) * kstep; const char* a2h1 = last ? nA1 : cA1 + (unsigned)(t + 2) * kstep;
            const char* b2 = last ? nB : cB + (unsigned)(t + 2) * kstep;
            const char* a3h0 = a2h0 + kstep; const char* b3 = b2 + kstep;
            unsigned x0[2], x1[2];
            if constexpr (GATHER) { x0[0] = last ? an0[0] : ao0[0]; x0[1] = last ? an0[1] : ao0[1]; x1[0] = last ? an1[0] : ao1[0]; x1[1] = last ? an1[1] : ao1[1]; }
            else { x0[0] = x1[0] = voffA[0]; x0[1] = x1[1] = voffA[1]; }
            PG8_LDB(B0, 0, 0); PG8_LDB(B1, 0, 1); PG8_SCHED; PG8_LDA(At, 0, 0); PG8_STAGE(PG8_SA(1, 1), a1h1, ao1);
            PG8_WAIT_V(8); PG8_WAIT_L(0); PG8_BAR; PG8_MMA(0, 0, At, B0); PG8_MMA(0, 1, At, B1); PG8_BAR; PG8_SCHED;
            PG8_LDA(At, 0, 1); PG8_STAGE(PG8_SB(0, 0), b2, voffB); PG8_STAGE(PG8_SB(0, 1), b2 + hstep, voffB); PG8_STAGE(PG8_SA(0, 0), a2h0, x0);
            PG8_WAIT_V(8); PG8_WAIT_L(0); PG8_BAR; PG8_MMA(1, 0, At, B0); PG8_MMA(1, 1, At, B1); PG8_BAR; PG8_SCHED;
            PG8_LDB(B0, 1, 0); PG8_LDB(B1, 1, 1); PG8_SCHED; PG8_LDA(At, 1, 0); PG8_STAGE(PG8_SA(0, 1), a2h1, x1);
            PG8_WAIT_V(8); PG8_WAIT_L(0); PG8_BAR; PG8_MMA(0, 0, At, B0); PG8_MMA(0, 1, At, B1); PG8_BAR; PG8_SCHED;
            PG8_LDA(At, 1, 1); PG8_STAGE(PG8_SB(1, 0), b3, voffB); PG8_STAGE(PG8_SB(1, 1), b3 + hstep, voffB); PG8_STAGE(PG8_SA(1, 0), a3h0, x0);
            PG8_WAIT_V(8); PG8_WAIT_L(0); PG8_BAR; PG8_MMA(1, 0, At, B0); PG8_MMA(1, 1, At, B1); PG8_BAR; PG8_SCHED;
        }
        if (wr == 0) PG8_BAR;
        if constexpr (FP8) asm volatile("s_nop 15" ::: "memory");
        E(acc, cur, wr, wc, fr, fq);
        if (!has_next) break;
#pragma unroll
        for (int a = 0; a < 2; ++a)
#pragma unroll
            for (int b = 0; b < 2; ++b)
#pragma unroll
                for (int m = 0; m < 4; ++m)
#pragma unroll
                    for (int n = 0; n < 2; ++n) acc[a][b][m][n] = (f32x4){0.f, 0.f, 0.f, 0.f};
        cur = nxt; cB = nB; cA0 = nA0; cA1 = nA1; ++ui; if constexpr (GATHER) { ao0[0] = an0[0]; ao0[1] = an0[1]; ao1[0] = an1[0]; ao1[1] = an1[1]; }
        if (wr == 1) PG8_BAR;
    }
    PG8_WAIT_V(0);
    PG8_BAR;
#undef PG8_SA
#undef PG8_SB
#undef PG8_STAGE
#undef PG8_LDA
#undef PG8_LDB
#undef PG8_MMA
#undef PG8_WAIT_V
#undef PG8_WAIT_L
#undef PG8_BAR
#undef PG8_SCHED
}
}
#define LDS_BAR() do { asm volatile("s_waitcnt lgkmcnt(0)" ::: "memory"); __builtin_amdgcn_s_barrier(); asm volatile("" ::: "memory"); } while (0)
struct Params { const float* in[22]; float* out; unsigned char* ws; };
struct FP {
    const Params& P; LAS unsigned char* lds; int zi; int wv;
    __device__ __forceinline__ FP fresh() const { int q; asm volatile("s_mov_b32 %0, 0" : "=s"(q)); return FP{P, lds, q, wv}; }
#define FP_IN(name, idx) __device__ __forceinline__ const float* name() const { return P.in[idx + zi]; }
    FP_IN(x_in, 0) FP_IN(c, 1) FP_IN(w_ada, 2) FP_IN(b_ada, 3) FP_IN(n1g, 4) FP_IN(n2g, 5) FP_IN(w_in, 6) FP_IN(avg, 7) FP_IN(aws, 8) FP_IN(abs_, 9) FP_IN(bwa, 10) FP_IN(bba, 11)
    FP_IN(bog, 12) FP_IN(w_out, 13) FP_IN(w_group, 14) FP_IN(b_group, 15) FP_IN(w_router, 16) FP_IN(b_router, 17) FP_IN(w1, 18) FP_IN(w3, 19) FP_IN(w2, 20) FP_IN(fgain, 21)
#undef FP_IN
#define FP_WS(type, name, off) __device__ __forceinline__ type* name() const { return (type*)((&P.ws)[zi] + (off)); }
    FP_WS(float, MOD, WS_MOD) FP_WS(bf16_t, WIN, WS_WIN) FP_WS(bf16_t, WOUT, WS_WOUT) FP_WS(bf16_t, W13, WS_W13) FP_WS(bf16_t, W2, WS_W2) FP_WS(bf16_t, WSB, WS_WS) FP_WS(bf16_t, WR, WS_WR)
    FP_WS(bf16_t, H, WS_H) FP_WS(bf16_t, PROJ, WS_PROJ) FP_WS(unsigned char, YPAD, WS_PROJ) FP_WS(unsigned char, HID, WS_KV) FP_WS(unsigned char, H8, WS_H) FP_WS(unsigned char, W13B, WS_W13) FP_WS(unsigned char, W2B, WS_W2) FP_WS(bf16_t, SST, WS_SST) FP_WS(bf16_t, Y, WS_Y) FP_WS(bf16_t, GATE, WS_GATE)
    FP_WS(float, KV, WS_KV) FP_WS(float, DEC, WS_DEC) FP_WS(int, ROUTE, WS_ROUTE) FP_WS(int, TOKOF, WS_TOKOF) FP_WS(int, CNT, WS_CTL + CTL_CNT) FP_WS(int, QH, WS_CTL + CTL_Q) FP_WS(bf16_t, XB, WS_XB) FP_WS(float, PSQ, WS_PSQ) FP_WS(float, AVSQ, WS_AVSQ)
#undef FP_WS
    __device__ __forceinline__ float* xcur() const { return (&P.out)[zi]; }
    __device__ __forceinline__ int tid() const { return wv * 64 + lane_id(); }
};

struct DenseSched {
    static constexpr bool GATHER = false;
    int nM, nN, nwg, G, c, Kb, relabel; const char* Bt;
    __device__ __forceinline__ bool next(int i, pg8::Unit& u) const {
        const int L = i * G + c; if (L >= nwg) return false;
        const int wgid = pg8::xcd_remap(L, nwg);
        const int nig = pg8::WGM * nN, gid = wgid / nig, fm = gid * pg8::WGM, gsz = (nM - fm) < pg8::WGM ? (nM - fm) : pg8::WGM;
        const int rn = (wgid % nig) / gsz;
        u.pm = fm + ((wgid % nig) % gsz); u.pn = relabel ? (int)((0xA9783210654ull >> (4 * rn)) & 15ull) : rn; u.e = 0; return true;
    }
    __device__ __forceinline__ void a_off(const pg8::Unit&, int, int, unsigned&, unsigned&) const {}
    __device__ __forceinline__ const char* b_ptr(const pg8::Unit& u) const { return Bt + (size_t)u.pn * 256 * Kb; }
};
template <bool GATHER_> struct MoeSched {
    static constexpr bool GATHER = GATHER_;
    int nunits, G, c, Kb; const LAS int* blk; const LAS int* cnt; const int* tokof; const char* W; size_t estride, tstride;
    __device__ __forceinline__ bool next(int i, pg8::Unit& u) const {
        const int L = i * G + c; if (L >= nunits) return false;
        const int wgid = pg8::xcd_remap(L, nunits);
        u.pm = wgid >> 2; u.pn = wgid & 3; int e = 0; while (e < 31 && blk[e + 1] <= u.pm) ++e; u.e = e; return true;
    }
    __device__ __forceinline__ void a_off(const pg8::Unit& u, int R, int C, unsigned& o0, unsigned& o1) const {
        const int s0 = (u.pm - blk[u.e]) * 256 + R, s1 = s0 + 128, n = cnt[u.e];
        const int t0 = s0 < n ? tokof[u.e * 32768 + s0] : 0, t1 = s1 < n ? tokof[u.e * 32768 + s1] : 0;
        o0 = (unsigned)(t0 * Kb + C * 2); o1 = (unsigned)(t1 * Kb + C * 2);
    }
    __device__ __forceinline__ const char* b_ptr(const pg8::Unit& u) const { return W + (size_t)u.e * estride + (size_t)u.pn * tstride; }
};

#define THIN_ST(p, v) (*(p) = (v))
#define EPI_ST(p, v) (*(p) = (v))
struct EpiInProj {
    static constexpr bool PERM = true;
    bf16_t* PROJ; bf16_t* GATE; const float* b_alpha; float* avsq;
    __device__ __forceinline__ void operator()(const f32x4 (&acc)[2][2][4][2], const pg8::Unit& u, int wr, int wc, int fr, int fq) const {
        const int row0 = u.pm * 256 + wr * 64 + fr, cl = wc * 32 + 8 * fq;
        if (u.pn == 10) {
#pragma unroll
            for (int bj = 0; bj < 2; ++bj) { const f32x4 b0 = *(const f32x4*)(b_alpha + bj * 128 + cl), b1 = *(const f32x4*)(b_alpha + bj * 128 + cl + 4);
#pragma unroll
                for (int ai = 0; ai < 2; ++ai)
#pragma unroll
                    for (int m = 0; m < 4; ++m) { bf16_t* gp = GATE + (size_t)(row0 + ai * 128 + m * 16) * 256 + bj * 128 + cl; f32x4 v0 = acc[ai][bj][m][0] + b0, v1 = acc[ai][bj][m][1] + b1;
#pragma unroll
                        for (int j = 0; j < 4; ++j) { v0[j] = logsig_f(v0[j]) * 0.0625f; v1[j] = logsig_f(v1[j]) * 0.0625f; }
                        u32x4 w; w.x = pk2(v0[0], v0[1]); w.y = pk2(v0[2], v0[3]); w.z = pk2(v1[0], v1[1]); w.w = pk2(v1[2], v1[3]);
                        EPI_ST((u32x4*)gp, w); } }
        } else {
            const int mode = u.pn < 4 ? 0 : (u.pn == 4 ? 1 : (u.pn < 8 ? 2 : 3));
#pragma unroll
            for (int ai = 0; ai < 2; ++ai)
#pragma unroll
                for (int m = 0; m < 4; ++m) { bf16_t* rp = PROJ + (size_t)(row0 + ai * 128 + m * 16) * NPJ + u.pn * 256 + cl; float ssq = 0.f;
#pragma unroll
                    for (int bj = 0; bj < 2; ++bj) { f32x4 v0 = acc[ai][bj][m][0], v1 = acc[ai][bj][m][1];
                        if (mode == 0) {
                            v0 = gelu4(v0); v1 = gelu4(v1);
                            ssq += v0[0] * v0[0] + v0[1] * v0[1] + v0[2] * v0[2] + v0[3] * v0[3] + v1[0] * v1[0] + v1[1] * v1[1] + v1[2] * v1[2] + v1[3] * v1[3]; }
                        else if (mode == 1) { v0 = v0 * 0.125f; v1 = v1 * 0.125f; }
                        else if (mode == 3) {
                            v0 = silu4(v0); v1 = silu4(v1); }
                        u32x4 w; w.x = pk2(v0[0], v0[1]); w.y = pk2(v0[2], v0[3]); w.z = pk2(v1[0], v1[1]); w.w = pk2(v1[2], v1[3]);
                        EPI_ST((u32x4*)(rp + bj * 128), w); }
                    if (u.pn == 2 || u.pn == 3) { ssq += __shfl_xor(ssq, 16); ssq += __shfl_xor(ssq, 32);
                        if (fq == 0) avsq[(size_t)(row0 + ai * 128 + m * 16) * 8 + (u.pn - 2) * 4 + wc] = ssq; } }
        }
    }
};
struct EpiOutProj {
    static constexpr bool PERM = true;
    const float* xin32; const bf16_t* xin16; bf16_t* xout; const float* g1; float* psq;
    __device__ __forceinline__ void operator()(const f32x4 (&acc)[2][2][4][2], const pg8::Unit& u, int wr, int wc, int fr, int fq) const {
        const int row0 = u.pm * 256 + wr * 64 + fr, col0 = u.pn * 256 + wc * 32 + 8 * fq; const float* gb = g1 + (size_t)(u.pm >> 4) * 6144 + col0;
        f32x4 gv[2][2];
#pragma unroll
        for (int bj = 0; bj < 2; ++bj)
#pragma unroll
            for (int n = 0; n < 2; ++n) gv[bj][n] = *(const f32x4*)(gb + bj * 128 + n * 4);
#define EOP_ROW(X0, X1, ai, m, bj) do { f32x4 x0 = (X0), x1 = (X1); x0 += gv[bj][0] * acc[ai][bj][m][0]; x1 += gv[bj][1] * acc[ai][bj][m][1]; \
            ssq += x0[0] * x0[0] + x0[1] * x0[1] + x0[2] * x0[2] + x0[3] * x0[3] + x1[0] * x1[0] + x1[1] * x1[1] + x1[2] * x1[2] + x1[3] * x1[3]; \
            u32x4 w; w.x = pk2(x0[0], x0[1]); w.y = pk2(x0[2], x0[3]); w.z = pk2(x1[0], x1[1]); w.w = pk2(x1[2], x1[3]); \
            EPI_ST((u32x4*)(xout + (size_t)(row0 + ai * 128 + m * 16) * D + col0 + bj * 128), w); } while (0)
#define EOP_PSQ(ai, m) do { ssq += __shfl_xor(ssq, 16); ssq += __shfl_xor(ssq, 32); if (fq == 0) psq[(size_t)(row0 + ai * 128 + m * 16) * 16 + u.pn * 4 + wc] = ssq; } while (0)
        if (xin32 == nullptr) {
#pragma unroll
            for (int ai = 0; ai < 2; ++ai) { u32x4 xv[4][2];
#pragma unroll
                for (int m = 0; m < 4; ++m)
#pragma unroll
                    for (int bj = 0; bj < 2; ++bj) xv[m][bj] = *(const u32x4*)(xin16 + (size_t)(row0 + ai * 128 + m * 16) * D + col0 + bj * 128);
                asm volatile("" : "+v"(xv[0][0]), "+v"(xv[0][1]), "+v"(xv[1][0]), "+v"(xv[1][1]), "+v"(xv[2][0]), "+v"(xv[2][1]), "+v"(xv[3][0]), "+v"(xv[3][1]));
#pragma unroll
                for (int m = 0; m < 4; ++m) { float ssq = 0.f;
#pragma unroll
                    for (int bj = 0; bj < 2; ++bj) { const u32x4 q = xv[m][bj];
                        EOP_ROW(((f32x4){bflo(q[0]), bfhi(q[0]), bflo(q[1]), bfhi(q[1])}), ((f32x4){bflo(q[2]), bfhi(q[2]), bflo(q[3]), bfhi(q[3])}), ai, m, bj); }
                    EOP_PSQ(ai, m); } }
        } else {
#pragma unroll
            for (int ai = 0; ai < 2; ++ai)
#pragma unroll
                for (int mh = 0; mh < 2; ++mh) { f32x4 xf[2][2][2];
#pragma unroll
                    for (int m = 0; m < 2; ++m)
#pragma unroll
                        for (int bj = 0; bj < 2; ++bj) { const float* xp = xin32 + (size_t)(row0 + ai * 128 + (2 * mh + m) * 16) * D + col0 + bj * 128; xf[m][bj][0] = *(const f32x4*)xp; xf[m][bj][1] = *(const f32x4*)(xp + 4); }
                    asm volatile("" : "+v"(xf[0][0][0]), "+v"(xf[0][0][1]), "+v"(xf[0][1][0]), "+v"(xf[0][1][1]), "+v"(xf[1][0][0]), "+v"(xf[1][0][1]), "+v"(xf[1][1][0]), "+v"(xf[1][1][1]));
#pragma unroll
                    for (int m = 0; m < 2; ++m) { float ssq = 0.f;
#pragma unroll
                        for (int bj = 0; bj < 2; ++bj) EOP_ROW(xf[m][bj][0], xf[m][bj][1], ai, (2 * mh + m), bj);
                        EOP_PSQ(ai, (2 * mh + m)); } }
        }
#undef EOP_ROW
#undef EOP_PSQ
    }
};
__device__ __forceinline__ unsigned pk4_fp8(float a, float b, float c, float d) { int r = __builtin_amdgcn_cvt_pk_fp8_f32(a, b, 0, false); r = __builtin_amdgcn_cvt_pk_fp8_f32(c, d, r, true); return (unsigned)r; }
__device__ __forceinline__ f32x4 up4_fp8(unsigned u) { const f32x2 a = __builtin_amdgcn_cvt_pk_f32_fp8((int)u, false), b = __builtin_amdgcn_cvt_pk_f32_fp8((int)u, true); return (f32x4){a[0], a[1], b[0], b[1]}; }
constexpr float W8_SCALE = 32.f, W8_INV = 1.f / 32.f;
struct EpiMoe1 {
    static constexpr bool PERM = true;
    unsigned char* HID;
    __device__ __forceinline__ void operator()(const f32x4 (&acc)[2][2][4][2], const pg8::Unit& u, int wr, int wc, int fr, int fq) const {
        const int row0 = u.pm * 256 + wr * 64 + fr, col0 = u.pn * 128 + wc * 32 + 8 * fq;
#pragma unroll
        for (int ai = 0; ai < 2; ++ai)
#pragma unroll
            for (int m = 0; m < 4; ++m) { f32x4 v0 = acc[ai][0][m][0] * W8_INV, v1 = acc[ai][0][m][1] * W8_INV; const f32x4 g0 = acc[ai][1][m][0] * W8_INV, g1 = acc[ai][1][m][1] * W8_INV;
                v0 = silu4(v0) * g0; v1 = silu4(v1) * g1;
                u32x2 w; w.x = pk4_fp8(v0[0], v0[1], v0[2], v0[3]); w.y = pk4_fp8(v1[0], v1[1], v1[2], v1[3]);
                EPI_ST((u32x2*)(HID + (size_t)(row0 + ai * 128 + m * 16) * 512 + col0), w); }
    }
};
struct EpiMoe2 {
    static constexpr bool PERM = true;
    unsigned char* YPAD;
    __device__ __forceinline__ void operator()(const f32x4 (&acc)[2][2][4][2], const pg8::Unit& u, int wr, int wc, int fr, int fq) const {
        const int row0 = u.pm * 256 + wr * 64 + fr, col0 = u.pn * 256 + wc * 32 + 8 * fq;
#pragma unroll
        for (int ai = 0; ai < 2; ++ai)
#pragma unroll
            for (int m = 0; m < 4; ++m)
#pragma unroll
                for (int bj = 0; bj < 2; ++bj) { const f32x4 v0 = acc[ai][bj][m][0] * W8_INV, v1 = acc[ai][bj][m][1] * W8_INV;
                    u32x2 w; w.x = pk4_fp8(v0[0], v0[1], v0[2], v0[3]); w.y = pk4_fp8(v1[0], v1[1], v1[2], v1[3]);
                    EPI_ST((u32x2*)(YPAD + (size_t)(row0 + ai * 128 + m * 16) * 1024 + col0 + bj * 128), w); }
    }
};

__device__ __forceinline__ bf16x8 tr_frag(LAS const unsigned char* img, int pitch, int k0, int x0, int lane) {
    LAS const unsigned char* p = img + (k0 + 8 * (lane >> 4) + ((lane & 15) >> 2)) * pitch + (x0 + 4 * (lane & 3)) * 2;
    const s16x4 a = __builtin_amdgcn_ds_read_tr16_b64_v4i16((LAS s16x4*)p), b = __builtin_amdgcn_ds_read_tr16_b64_v4i16((LAS s16x4*)(p + 4 * pitch));
    return (bf16x8){a[0], a[1], a[2], a[3], b[0], b[1], b[2], b[3]};
}
__device__ __forceinline__ bf16x8 tr_frag_p8(LAS const unsigned char* img, int pitch, int k0, int m, int lane) {
    LAS const unsigned char* p = img + (k0 + 8 * (lane >> 4) + ((lane & 15) >> 2)) * pitch + (32 * (m >> 1) + 8 * (lane & 3) + 4 * (m & 1)) * 2;
    const s16x4 a = __builtin_amdgcn_ds_read_tr16_b64_v4i16((LAS s16x4*)p), b = __builtin_amdgcn_ds_read_tr16_b64_v4i16((LAS s16x4*)(p + 4 * pitch));
    return (bf16x8){a[0], a[1], a[2], a[3], b[0], b[1], b[2], b[3]};
}
__device__ __forceinline__ int perm_p8(int m, int i) { return 32 * (m >> 1) + 8 * (i >> 2) + 4 * (m & 1) + (i & 3); }
__device__ __forceinline__ f32x4 mfma16(bf16x8 a, bf16x8 b, f32x4 c) { return __builtin_amdgcn_mfma_f32_16x16x32_bf16(a, b, c, 0, 0, 0); }
#define PIN4(x) asm volatile("" : "+v"((x)[0]), "+v"((x)[1]), "+v"((x)[2]), "+v"((x)[3]))
#define PIN8(x) asm volatile("" : "+v"((x)[0]), "+v"((x)[1]), "+v"((x)[2]), "+v"((x)[3]), "+v"((x)[4]), "+v"((x)[5]), "+v"((x)[6]), "+v"((x)[7]))
struct TrTile { const float* src; unsigned char* dst; int ldn, K, kind, k0, n0; };
__device__ __forceinline__ TrTile tr_desc(const FP& F, int l, int r) {
    TrTile t;
    if (r < 160) { t.src = F.w_in() + (size_t)l * 1024 * PIN; t.ldn = PIN; t.K = 1024; t.kind = 0; t.dst = (unsigned char*)(F.WIN() + (size_t)l * NIN * 1024); t.k0 = (r / 10) * 64; t.n0 = (r % 10) * 256; }
    else if (r < 224) { r -= 160; t.src = F.w_out() + (size_t)l * 1024 * 1024; t.ldn = 1024; t.K = 1024; t.kind = 0; t.dst = (unsigned char*)(F.WOUT() + (size_t)l * 1024 * 1024); t.k0 = (r / 4) * 64; t.n0 = (r % 4) * 256; }
    else if (r < 1248) { r -= 224; const int e = r >> 5; r &= 31; t.src = F.w1() + ((size_t)l * 32 + e) * 1024 * 512; t.ldn = 512; t.K = 1024; t.kind = 1; t.dst = F.W13B() + ((size_t)l * 32 + e) * 1024 * 1024; t.k0 = (r >> 1) * 64; t.n0 = (r & 1) * 256; }
    else if (r < 2272) { r -= 1248; const int e = r >> 5; r &= 31; t.src = F.w3() + ((size_t)l * 32 + e) * 1024 * 512; t.ldn = 512; t.K = 1024; t.kind = 2; t.dst = F.W13B() + ((size_t)l * 32 + e) * 1024 * 1024; t.k0 = (r >> 1) * 64; t.n0 = (r & 1) * 256; }
    else { r -= 2272; const int e = r >> 5; r &= 31; t.src = F.w2() + ((size_t)l * 32 + e) * 512 * 1024; t.ldn = 1024; t.K = 512; t.kind = 3; t.dst = F.W2B() + ((size_t)l * 32 + e) * 1024 * 512; t.k0 = (r >> 2) * 64; t.n0 = (r & 3) * 256; }
    return t;
}
__device__ __forceinline__ void tr_load(const TrTile& t, f32x4 (&v)[8], int tid) {
    if (t.kind == 0) { const int kp = tid >> 4, nq = (tid & 15) * 4;
#pragma unroll
        for (int i = 0; i < 4; ++i) { const float* p = t.src + (size_t)(t.k0 + 2 * kp) * t.ldn + t.n0 + nq + 64 * i; v[i] = *(const f32x4*)p; v[4 + i] = *(const f32x4*)(p + t.ldn); } }
    else { const int kq = tid >> 5, nq = (tid & 31) * 4;
#pragma unroll
        for (int i = 0; i < 2; ++i)
#pragma unroll
            for (int rr = 0; rr < 4; ++rr) v[4 * i + rr] = *(const f32x4*)(t.src + (size_t)(t.k0 + 4 * kq + rr) * t.ldn + t.n0 + nq + 128 * i); }
}
__device__ __forceinline__ void convert_pull(const FP& F0, int l, int quota) {
    const FP F = F0.fresh();
    int tid_ = F.tid(); asm volatile("" : "+v"(tid_)); const int tid = tid_; volatile LAS int* qw = (volatile LAS int*)(F.lds + L_QW);
    LAS unsigned* sT = (LAS unsigned*)(F.lds + SCR_OFF);
    __syncthreads();
    if (tid == 0) qw[0] = quota > 0 ? __hip_atomic_fetch_add(F.QH() + l * 64, 1, __ATOMIC_RELAXED, __HIP_MEMORY_SCOPE_AGENT) : 3296;
    __syncthreads();
    int r = qw[0]; f32x4 v[8]; TrTile cur;
    if (r < 3296) { cur = tr_desc(F, l, r); tr_load(cur, v, tid); }
    for (int n = 1; r < 3296; ++n) {
        if (tid == 0) qw[1] = n < quota ? __hip_atomic_fetch_add(F.QH() + l * 64, 1, __ATOMIC_RELAXED, __HIP_MEMORY_SCOPE_AGENT) : 3296;
        if (cur.kind == 0) { const int kp = tid >> 4, nq = (tid & 15) * 4;
#pragma unroll
            for (int i = 0; i < 4; ++i)
#pragma unroll
                for (int j = 0; j < 4; ++j) sT[(nq + 64 * i + j) * 33 + kp] = pk2(v[i][j], v[4 + i][j]); }
        else { const int kq = tid >> 5, nq = (tid & 31) * 4;
#pragma unroll
            for (int i = 0; i < 2; ++i)
#pragma unroll
                for (int j = 0; j < 4; ++j) sT[(nq + 128 * i + j) * 17 + kq] = pk4_fp8(v[4 * i][j] * W8_SCALE, v[4 * i + 1][j] * W8_SCALE, v[4 * i + 2][j] * W8_SCALE, v[4 * i + 3][j] * W8_SCALE); }
        LDS_BAR();
        const int rn = qw[1]; const TrTile t = cur;
        if (rn < 3296) { cur = tr_desc(F, l, rn); tr_load(cur, v, tid); }
        if (t.kind == 0) {
#pragma unroll
            for (int i = 0; i < 4; ++i) { const int id = tid + 512 * i, nl = id >> 3, kc = id & 7;
                u32x4 w; w.x = sT[nl * 33 + kc * 4]; w.y = sT[nl * 33 + kc * 4 + 1]; w.z = sT[nl * 33 + kc * 4 + 2]; w.w = sT[nl * 33 + kc * 4 + 3];
                *(u32x4*)(t.dst + ((size_t)(t.n0 + nl) * t.K + t.k0 + kc * 8) * 2) = w; } }
        else {
#pragma unroll
            for (int i = 0; i < 2; ++i) { const int id = tid + 512 * i, nl = id >> 2, kc = id & 3; const int nn = t.n0 + nl;
                const int drow = t.kind == 3 ? nn : ((nn >> 7) * 256 + (nn & 127) + (t.kind == 2 ? 128 : 0));
                u32x4 w; w.x = sT[nl * 17 + kc * 4]; w.y = sT[nl * 17 + kc * 4 + 1]; w.z = sT[nl * 17 + kc * 4 + 2]; w.w = sT[nl * 17 + kc * 4 + 3];
                *(u32x4*)(t.dst + (size_t)drow * t.K + t.k0 + kc * 16) = w; } }
        LDS_BAR();
        r = rn;
    }
    __syncthreads();
}
__device__ __forceinline__ void p0_mod(const FP& F0) {
    const FP F = F0.fresh();
    int tid_ = F.tid(); asm volatile("" : "+v"(tid_)); const int tid = tid_; LAS float* sC = (LAS float*)(F.lds + SCR_OFF); LAS float* sR = sC + 8192;
    for (int j = tid; j < 8192; j += 512) sC[j] = silu_f(F.c()[j]);
    __syncthreads();
    const int cg = tid & 31, ks = tid >> 5;
    for (int it = blockIdx.x; it < 192; it += gridDim.x) {
        const int l = it / 48, j0 = (it % 48) * 128 + cg * 4; const float* wp = F.w_ada() + ((size_t)l * 1024 + ks * 64) * 6144 + j0;
        f32x4 acc[8];
#pragma unroll
        for (int b = 0; b < 8; ++b) acc[b] = (f32x4){0.f, 0.f, 0.f, 0.f};
#pragma unroll 4
        for (int k = 0; k < 64; ++k) { const f32x4 w = *(const f32x4*)(wp + (size_t)k * 6144);
#pragma unroll
            for (int b = 0; b < 8; ++b) acc[b] += w * sC[b * 1024 + ks * 64 + k]; }
#pragma unroll
        for (int b = 0; b < 8; ++b) *(LAS f32x4*)(sR + (ks * 8 + b) * 128 + cg * 4) = acc[b];
        __syncthreads();
        for (int o = tid; o < 1024; o += 512) { const int b = o >> 7, j = o & 127; float s = F.b_ada()[l * 6144 + (it % 48) * 128 + j];
#pragma unroll
            for (int q = 0; q < 16; ++q) s += sR[(q * 8 + b) * 128 + j];
            F.MOD()[((size_t)l * 8 + b) * 6144 + (it % 48) * 128 + j] = s; }
        __syncthreads();
    }
}
__device__ __forceinline__ void p0_small(const FP& F0) {
    const FP F = F0.fresh();
    int tid_ = F.tid(); asm volatile("" : "+v"(tid_));
    const size_t gsz = (size_t)gridDim.x * 512, g0 = (size_t)blockIdx.x * 512 + tid_;
    for (size_t i = g0; i < (size_t)4 * 256 * 1024; i += gsz) { const int l = (int)(i >> 18), n = (int)((i >> 10) & 255), k = (int)(i & 1023);
        const float* wl = F.w_in() + ((size_t)l * 1024 + k) * PIN + 2560; const float* wa = F.bwa() + (size_t)l * 16 * 256 + n; float s = 0.f;
#pragma unroll
        for (int r = 0; r < 16; ++r) s += wl[r] * wa[r * 256];
        F.WIN()[((size_t)l * NIN + 2560 + n) * 1024 + k] = (bf16_t)(pk2(s, 0.f) & 0xffffu); }
    for (size_t i = g0; i < (size_t)4 * 4 * 128 * 128; i += gsz) { const int t = (int)((i >> 7) & 127), s = (int)(i & 127); F.WSB()[i] = (bf16_t)(pk2(s <= t ? F.aws()[i] : 0.f, 0.f) & 0xffffu); }
    for (size_t i = g0; i < (size_t)4 * 48 * 1024; i += gsz) { const int l = (int)(i / (48 * 1024)), n = (int)((i >> 10) % 48), k = (int)(i & 1023);
        const float v = n < 4 ? F.w_group()[((size_t)l * 1024 + k) * 4 + n] : (n < 36 ? F.w_router()[((size_t)l * 1024 + k) * 32 + (n - 4)] : 0.f);
        F.WR()[i] = (bf16_t)(pk2(v, 0.f) & 0xffffu); }
}

__device__ __forceinline__ void moe_tables(const FP& F0, int l) {
    const FP F = F0.fresh();
    LAS int* blk = (LAS int*)(F.lds + L_BLK); LAS int* cnt = (LAS int*)(F.lds + L_CNT); LAS int* nb = (LAS int*)(F.lds + L_NB);
    __syncthreads();
    const int tx = F.tid();
    if (tx < 32) cnt[tx] = __hip_atomic_load(F.CNT() + l * 32 + tx, __ATOMIC_RELAXED, __HIP_MEMORY_SCOPE_AGENT);
    __syncthreads();
    if (tx == 0) { int s = 0; for (int e = 0; e < 32; ++e) { blk[e] = s; s += (cnt[e] + 255) >> 8; } blk[32] = s; nb[0] = s; }
    __syncthreads();
}

struct P1Row { u32x2 xb[4]; unsigned ya[4], yc[4]; float w0, w1; };
__device__ __forceinline__ void p1_issue(const FP& F, P1Row& R, const i32x4& r0, const i32x4& r1, const LAS int* blk, int t, int lane) {
    R.w0 = __int_as_float(r0[2]); R.w1 = __int_as_float(r1[1]);
    const unsigned char* y0 = F.YPAD() + ((size_t)blk[r0[0]] * 256 + r0[1]) * 1024; const unsigned char* y1 = F.YPAD() + ((size_t)blk[r0[3]] * 256 + r1[0]) * 1024;
#pragma unroll
    for (int j = 0; j < 4; ++j) { R.xb[j] = *(const u32x2*)(F.XB() + (size_t)t * D + lane * 4 + 256 * j); R.ya[j] = *(const unsigned*)(y0 + lane * 4 + 256 * j); R.yc[j] = *(const unsigned*)(y1 + lane * 4 + 256 * j); }
}
__device__ __forceinline__ void p1_finish(const FP& F, int l, int t, int lane, f32x4 (&x)[4], const f32x4 (&gv)[4], const f32x4 (&sv)[4]) {
    float ss = 0.f;
#pragma unroll
    for (int j = 0; j < 4; ++j) ss += x[j][0] * x[j][0] + x[j][1] * x[j][1] + x[j][2] * x[j][2] + x[j][3] * x[j][3];
#pragma unroll
    for (int o = 32; o >= 1; o >>= 1) ss += __shfl_xor(ss, o);
    const float rstd = frsq(ss * (1.f / D) + EPS);
#pragma unroll
    for (int j = 0; j < 4; ++j) { const f32x4 hv = x[j] * rstd * gv[j] + sv[j];
        if (l < NL) { u32x2 o; o[0] = pk2(hv[0], hv[1]); o[1] = pk2(hv[2], hv[3]); THIN_ST((u32x2*)(F.H() + (size_t)t * D + lane * 4 + 256 * j), o); }
        else THIN_ST((f32x4*)(F.xcur() + (size_t)t * D + lane * 4 + 256 * j), hv); }
}
__device__ __forceinline__ void p1_rows(const FP& F0, int l) {
    const FP F = F0.fresh();
    int tid_ = F.tid(); asm volatile("" : "+v"(tid_)); const int tid = tid_, w = tid >> 6, lane = tid & 63; const LAS int* blk = (const LAS int*)(F.lds + L_BLK);
    for (int u = blockIdx.x; u < 256; u += gridDim.x) {
        const int b = u >> 5, tok0 = u * 128 + w * 16;
        f32x4 gv[4], sv[4], g2v[4];
#pragma unroll
        for (int j = 0; j < 4; ++j) { const int col = lane * 4 + 256 * j;
            if (l < NL) { const float* m = F.MOD() + ((size_t)l * 8 + b) * 6144; const f32x4 g = *(const f32x4*)(F.n1g() + l * 1024 + col), sc = *(const f32x4*)(m + 1024 + col); gv[j] = g * (sc + 1.0f); sv[j] = *(const f32x4*)(m + col); }
            else { gv[j] = *(const f32x4*)(F.fgain() + col); sv[j] = (f32x4){0.f, 0.f, 0.f, 0.f}; }
            g2v[j] = l > 0 ? *(const f32x4*)(F.MOD() + ((size_t)(l - 1) * 8 + b) * 6144 + 5120 + col) : (f32x4){0.f, 0.f, 0.f, 0.f}; }
        if (l == 0) {
            f32x4 xn[4];
#pragma unroll
            for (int j = 0; j < 4; ++j) xn[j] = *(const f32x4*)(F.x_in() + (size_t)tok0 * D + lane * 4 + 256 * j);
#pragma unroll 1
            for (int i = 0; i < 16; ++i) { f32x4 x[4];
#pragma unroll
                for (int j = 0; j < 4; ++j) x[j] = xn[j];
                if (i < 15) {
#pragma unroll
                    for (int j = 0; j < 4; ++j) xn[j] = *(const f32x4*)(F.x_in() + (size_t)(tok0 + i + 1) * D + lane * 4 + 256 * j); }
                p1_finish(F, l, tok0 + i, lane, x, gv, sv); }
        } else {
            i32x4 ra = *(const i32x4*)(F.ROUTE() + (size_t)tok0 * 8), rb = *(const i32x4*)(F.ROUTE() + (size_t)tok0 * 8 + 4);
            P1Row nx; p1_issue(F, nx, ra, rb, blk, tok0, lane);
            ra = *(const i32x4*)(F.ROUTE() + (size_t)(tok0 + 1) * 8); rb = *(const i32x4*)(F.ROUTE() + (size_t)(tok0 + 1) * 8 + 4);
#pragma unroll 1
            for (int i = 0; i < 16; ++i) { const int t = tok0 + i; const P1Row cu = nx;
                if (i < 15) { p1_issue(F, nx, ra, rb, blk, t + 1, lane);
                    if (i < 14) { ra = *(const i32x4*)(F.ROUTE() + (size_t)(t + 2) * 8); rb = *(const i32x4*)(F.ROUTE() + (size_t)(t + 2) * 8 + 4); } }
                f32x4 x[4];
#pragma unroll
                for (int j = 0; j < 4; ++j) { const u32x2 xv = cu.xb[j]; const f32x4 a = up4_fp8(cu.ya[j]), c = up4_fp8(cu.yc[j]);
                    const f32x4 m = a * cu.w0 + c * cu.w1;
                    x[j] = (f32x4){bflo(xv[0]), bfhi(xv[0]), bflo(xv[1]), bfhi(xv[1])} + g2v[j] * m;
                    if (l < NL) { u32x2 xo; xo[0] = pk2(x[j][0], x[j][1]); xo[1] = pk2(x[j][2], x[j][3]); THIN_ST((u32x2*)(F.XB() + (size_t)t * D + lane * 4 + 256 * j), xo); } }
                p1_finish(F, l, t, lane, x, gv, sv); }
        }
    }
}

struct ChunkRegs { u32x4 v[4]; f32x2 g[8]; unsigned q[8], k[8]; };
template <bool WITH_Q> __device__ __forceinline__ void chunk_load(const FP& F, ChunkRegs& R, int tok0, int h, int tid) {
    const int kp = tid & 31, seg = tid >> 5;
#pragma unroll
    for (int i = 0; i < 4; ++i) { const int id = tid + 512 * i, row = id >> 4, ch = id & 15; R.v[i] = *(const u32x4*)(F.PROJ() + (size_t)(tok0 + row) * NPJ + 1536 + h * 128 + ch * 8); }
#pragma unroll
    for (int i = 0; i < 8; ++i) { const size_t t = (size_t)(tok0 + seg * 8 + i); { const unsigned gg = *(const unsigned*)(F.GATE() + t * 256 + h * 64 + 2 * kp); R.g[i] = (f32x2){bflo(gg), bfhi(gg)}; } const bf16_t* pr = F.PROJ() + t * NPJ + h * 64 + 2 * kp; R.k[i] = *(const unsigned*)(pr + 1280); if (WITH_Q) R.q[i] = *(const unsigned*)(pr + 1024); }
}
struct ChunkPre { u32x4 v[4]; f32x2 g[8]; };
__device__ __forceinline__ void chunk_pre(const FP& F, ChunkPre& R, int tok0, int h, int tid) {
    const int kp = tid & 31, seg = tid >> 5;
#pragma unroll
    for (int i = 0; i < 4; ++i) { const int id = tid + 512 * i, row = id >> 4, ch = id & 15; R.v[i] = *(const u32x4*)(F.PROJ() + (size_t)(tok0 + row) * NPJ + 1536 + h * 128 + ch * 8); }
#pragma unroll
    for (int i = 0; i < 8; ++i) { const unsigned gg = *(const unsigned*)(F.GATE() + (size_t)(tok0 + seg * 8 + i) * 256 + h * 64 + 2 * kp); R.g[i] = (f32x2){bflo(gg), bfhi(gg)}; }
}
__device__ __forceinline__ void chunk_cumsum(LAS float* sSeg, f32x2 (&g)[8], f32x2& pre, f32x2& tot, f32x2& ref, int tid) {
    const int kp = tid & 31, seg = tid >> 5;
#pragma unroll
    for (int i = 1; i < 8; ++i) g[i] += g[i - 1];
    *(LAS f32x2*)(sSeg + seg * 64 + 2 * kp) = g[7];
    LDS_BAR();
    pre = (f32x2){0.f, 0.f}; tot = pre; ref = pre;
#pragma unroll
    for (int s = 0; s < 16; ++s) { const f32x2 v = *(const LAS f32x2*)(sSeg + s * 64 + 2 * kp); tot += v; if (s < seg) pre += v; if (s < 8) ref += v; }
}

__device__ __forceinline__ void p3_agg_sgu(const FP& F0, int l) {
    const FP F = F0.fresh();
    int tid_ = F.tid(); asm volatile("" : "+v"(tid_)); const int tid = tid_, w = tid >> 6, lane = tid & 63; LAS unsigned char* sc = F.lds + SCR_OFF;
    LAS unsigned char* sV = sc; LAS unsigned char* sK = sc + 36864; LAS float* sSeg = (LAS float*)(sc + 57344); LAS float* sDec = sSeg + 1024;
    LAS unsigned char* sVn = sc + 61696; LAS float* sRstd = (LAS float*)(sc + 98560);
    LAS float* sAvg = (LAS float*)(sc + 99072); LAS float* sBs = (LAS float*)(sc + 101120);
    { const float ga = F.avg()[l * 512 + tid], gb = F.abs_()[l * 512 + tid]; sAvg[tid] = ga; sBs[tid] = gb; }
    const int tt = 16 * w + (lane & 15);
    for (int unit = blockIdx.x; unit < 256; unit += gridDim.x) {
        const int bh = unit >> 3, j = unit & 7, b = bh >> 2, h = bh & 3, tokb = b * SEQ + j * 512, tok0 = unit * 128;
        f32x4 acc[4]; f32x2 bsum = (f32x2){0.f, 0.f};
#pragma unroll
        for (int n = 0; n < 4; ++n) acc[n] = (f32x4){0.f, 0.f, 0.f, 0.f};
        ChunkPre nx; chunk_pre(F, nx, tokb, h, tid);
        unsigned nk[8];
        { const int kp = tid & 31, seg = tid >> 5;
#pragma unroll
          for (int i = 0; i < 8; ++i) nk[i] = *(const unsigned*)(F.PROJ() + (size_t)(tokb + seg * 8 + i) * NPJ + 1280 + h * 64 + 2 * kp); }
        u32x4 vc[4];
#pragma unroll
        for (int i = 0; i < 4; ++i) { const int id = tid + 512 * i, row = id >> 4, ch = id & 15; vc[i] = *(const u32x4*)(F.PROJ() + (size_t)(tok0 + row) * NPJ + 512 + ch * 8); }
        if (tid < 128) { const f32x4 p0 = *(const f32x4*)(F.AVSQ() + (size_t)(tok0 + tid) * 8), p1 = *(const f32x4*)(F.AVSQ() + (size_t)(tok0 + tid) * 8 + 4);
            sRstd[tid] = frsq((((p0[0] + p0[1]) + (p0[2] + p0[3])) + ((p1[0] + p1[1]) + (p1[2] + p1[3]))) * (1.f / 512.f) + EPS); }
        LDS_BAR();
#pragma unroll 1
        for (int it = 0; it < 4; ++it) {
            ChunkRegs cu;
#pragma unroll
            for (int i = 0; i < 4; ++i) cu.v[i] = nx.v[i];
#pragma unroll
            for (int i = 0; i < 8; ++i) cu.g[i] = nx.g[i];
#pragma unroll
            for (int i = 0; i < 8; ++i) cu.k[i] = nk[i];
            if (it < 3) chunk_pre(F, nx, tokb + (it + 1) * 128, h, tid);
            const bf16_t* wrow = F.WSB() + ((size_t)(l * 4 + it) * 128 + tt) * 128 + 8 * (lane >> 4);
            u32x4 au[4];
#pragma unroll
            for (int a = 0; a < 4; ++a) au[a] = *(const u32x4*)(F.PROJ() + (size_t)(tok0 + tt) * NPJ + it * 128 + 32 * a + 8 * (lane >> 4));
            const float bs = sBs[it * 128 + tt];
#pragma unroll
            for (int i = 0; i < 4; ++i) { const int id = tid + 512 * i, row = id >> 4, ch = id & 15; *(LAS u32x4*)(sV + row * 288 + ch * 16) = cu.v[i]; }
#pragma unroll
            for (int i = 0; i < 4; ++i) { const int id = tid + 512 * i, row = id >> 4, ch = id & 15; const u32x4 v = vc[i]; const float rs = sRstd[row];
                const f32x4 g0 = *(const LAS f32x4*)(sAvg + it * 128 + ch * 8), g1 = *(const LAS f32x4*)(sAvg + it * 128 + ch * 8 + 4);
                u32x4 o; o[0] = pk2(bflo(v[0]) * rs * g0[0], bfhi(v[0]) * rs * g0[1]); o[1] = pk2(bflo(v[1]) * rs * g0[2], bfhi(v[1]) * rs * g0[3]);
                o[2] = pk2(bflo(v[2]) * rs * g1[0], bfhi(v[2]) * rs * g1[1]); o[3] = pk2(bflo(v[3]) * rs * g1[2], bfhi(v[3]) * rs * g1[3]);
                *(LAS u32x4*)(sVn + row * 288 + ch * 16) = o; }
            if (it < 3) {
#pragma unroll
                for (int i = 0; i < 4; ++i) { const int id = tid + 512 * i, row = id >> 4, ch = id & 15; vc[i] = *(const u32x4*)(F.PROJ() + (size_t)(tok0 + row) * NPJ + 512 + (it + 1) * 128 + ch * 8); } }
            f32x2 pre, tot, ref; chunk_cumsum(sSeg, cu.g, pre, tot, ref, tid);
            bf16x8 wf[4];
#pragma unroll
            for (int ks = 0; ks < 4; ++ks) wf[ks] = *(const bf16x8*)(wrow + 32 * ks);
            { const int kp = tid & 31, seg = tid >> 5;
#pragma unroll
              for (int i = 0; i < 8; ++i) { const int t = seg * 8 + i; const f32x2 bc = pre + cu.g[i];
                  *(LAS unsigned*)(sK + t * 160 + kp * 4) = pk2(bflo(cu.k[i]) * fexp(tot[0] - bc[0]), bfhi(cu.k[i]) * fexp(tot[1] - bc[1])); }
              if (seg == 0) *(LAS f32x2*)(sDec + 2 * kp) = (f32x2){fexp(tot[0]), fexp(tot[1])};
              if (it < 3) {
#pragma unroll
                  for (int i = 0; i < 8; ++i) nk[i] = *(const unsigned*)(F.PROJ() + (size_t)(tokb + (it + 1) * 128 + seg * 8 + i) * NPJ + 1280 + h * 64 + 2 * kp); } }
            bsum += tot;
            { f32x4 z[8];
#pragma unroll
              for (int m = 0; m < 8; ++m) z[m] = (f32x4){0.f, 0.f, 0.f, 0.f};
#pragma unroll
              for (int ks = 0; ks < 4; ++ks) if (32 * ks <= 16 * w + 15) {
#pragma unroll
                  for (int hf = 0; hf < 2; ++hf) { bf16x8 vf[4];
#pragma unroll
                      for (int m = 0; m < 4; ++m) vf[m] = tr_frag_p8(sVn, 288, 32 * ks, 4 * hf + m, lane);
                      PIN4(vf);
#pragma unroll
                      for (int m = 0; m < 4; ++m) z[4 * hf + m] = mfma16(vf[m], wf[ks], z[4 * hf + m]); } }
#pragma unroll
              for (int a = 0; a < 4; ++a) { const int col = it * 128 + 32 * a + 8 * (lane >> 4);
                  u32x4 o; o[0] = pk2(bflo(au[a][0]) * (z[2 * a][0] + bs), bfhi(au[a][0]) * (z[2 * a][1] + bs)); o[1] = pk2(bflo(au[a][1]) * (z[2 * a][2] + bs), bfhi(au[a][1]) * (z[2 * a][3] + bs));
                  o[2] = pk2(bflo(au[a][2]) * (z[2 * a + 1][0] + bs), bfhi(au[a][2]) * (z[2 * a + 1][1] + bs)); o[3] = pk2(bflo(au[a][3]) * (z[2 * a + 1][2] + bs), bfhi(au[a][3]) * (z[2 * a + 1][3] + bs));
                  THIN_ST((u32x4*)(F.Y() + (size_t)(tok0 + tt) * D + col), o); } }
            LDS_BAR();
#pragma unroll
            for (int n = 0; n < 4; ++n) acc[n] = acc[n] * sDec[16 * n + (lane & 15)];
#pragma unroll
            for (int ks = 0; ks < 4; ++ks) { bf16x8 a = tr_frag(sV, 288, 32 * ks, 16 * w, lane), kb[4];
#pragma unroll
                for (int n = 0; n < 4; ++n) kb[n] = tr_frag(sK, 160, 32 * ks, 16 * n, lane);
                asm volatile("" : "+v"(a), "+v"(kb[0]), "+v"(kb[1]), "+v"(kb[2]), "+v"(kb[3]));
#pragma unroll
                for (int n = 0; n < 4; ++n) acc[n] = mfma16(a, kb[n], acc[n]); }
            LDS_BAR();
        }
        float* kv = F.KV() + (size_t)unit * 8192 + (16 * w + 4 * (lane >> 4)) * 64 + (lane & 15);
#pragma unroll
        for (int n = 0; n < 4; ++n)
#pragma unroll
            for (int r = 0; r < 4; ++r) kv[r * 64 + 16 * n] = acc[n][r];
        if (tid < 32) *(f32x2*)(F.DEC() + (size_t)unit * 64 + 2 * tid) = (f32x2){fexp(bsum[0]), fexp(bsum[1])};
    }
}

__device__ __forceinline__ void p5_gla_seq(const FP& F0, int l) {
    const FP F = F0.fresh();
    int tid_ = F.tid(); asm volatile("" : "+v"(tid_)); const int tid = tid_, w = tid >> 6, lane = tid & 63, fr = lane & 15, fg = lane >> 4; LAS unsigned char* sc = F.lds + SCR_OFF;
    LAS unsigned char* sV = sc; LAS unsigned char* sQ = sc + 36864; LAS unsigned char* sKt = sc + 55296; LAS unsigned char* sS = sc + 73728; LAS unsigned char* sP = sc + 92160;
    LAS float* sSeg = (LAS float*)(sc + 126976);
    LAS float* sBog = (LAS float*)(sc + 131072);
    const int tt = 16 * w + fr;
    for (int unit = blockIdx.x; unit < 256; unit += gridDim.x) {
        const int bh = unit >> 3, j = unit & 7, b = bh >> 2, h = bh & 3, tokb = b * SEQ + j * 512;
        const float bgv = F.bog()[l * 512 + h * 128 + (tid & 127)];
        ChunkPre nx; chunk_pre(F, nx, tokb, h, tid);
        f32x4 st[4];
#pragma unroll
        for (int n = 0; n < 4; ++n) st[n] = (f32x4){0.f, 0.f, 0.f, 0.f};
#pragma unroll 1
        for (int i0 = 0; i0 < j; i0 += 4) {
            f32x4 kq[4][4], dq[4];
#pragma unroll
            for (int u = 0; u < 4; ++u) { const int ui = bh * 8 + (i0 + u < j ? i0 + u : i0); const float* kv = F.KV() + (size_t)ui * 8192 + (16 * w + 4 * fg) * 64 + fr;
#pragma unroll
                for (int n = 0; n < 4; ++n) { dq[u][n] = F.DEC()[ui * 64 + 16 * n + fr];
#pragma unroll
                    for (int r = 0; r < 4; ++r) kq[u][n][r] = kv[r * 64 + 16 * n]; } }
            asm volatile("" : "+v"(kq[0][0]), "+v"(kq[0][1]), "+v"(kq[0][2]), "+v"(kq[0][3]), "+v"(kq[1][0]), "+v"(kq[1][1]), "+v"(kq[1][2]), "+v"(kq[1][3]), "+v"(kq[2][0]), "+v"(kq[2][1]), "+v"(kq[2][2]), "+v"(kq[2][3]),
                              "+v"(kq[3][0]), "+v"(kq[3][1]), "+v"(kq[3][2]), "+v"(kq[3][3]), "+v"(dq[0]), "+v"(dq[1]), "+v"(dq[2]), "+v"(dq[3]));
#pragma unroll
            for (int u = 0; u < 4; ++u) if (i0 + u < j) {
#pragma unroll
                for (int n = 0; n < 4; ++n) st[n] = st[n] * dq[u][n] + kq[u][n]; } }
        if (tid < 128) sBog[tid] = bgv;
#pragma unroll 1
        for (int c = 0; c < 4; ++c) {
            const int tok0 = tokb + c * 128;
            ChunkRegs cu; u32x4 rr[4];
#pragma unroll
            for (int i = 0; i < 4; ++i) cu.v[i] = nx.v[i];
#pragma unroll
            for (int i = 0; i < 8; ++i) cu.g[i] = nx.g[i];
            { const int kp = tid & 31, seg = tid >> 5;
#pragma unroll
              for (int i = 0; i < 8; ++i) { const bf16_t* pr = F.PROJ() + (size_t)(tok0 + seg * 8 + i) * NPJ + h * 64 + 2 * kp; cu.k[i] = *(const unsigned*)(pr + 1280); cu.q[i] = *(const unsigned*)(pr + 1024); } }
            if (c < 3) chunk_pre(F, nx, tok0 + 128, h, tid);
#pragma unroll
            for (int a = 0; a < 4; ++a) rr[a] = *(const u32x4*)(F.PROJ() + (size_t)(tok0 + tt) * NPJ + 2048 + h * 128 + 32 * a + 8 * fg);
#pragma unroll
            for (int i = 0; i < 4; ++i) { const int id = tid + 512 * i, row = id >> 4, ch = id & 15; *(LAS u32x4*)(sV + row * 288 + ch * 16) = cu.v[i]; }
            f32x2 pre, tot, ref; chunk_cumsum(sSeg, cu.g, pre, tot, ref, tid);
            float escl[4];
#pragma unroll
            for (int n = 0; n < 4; ++n) { float t2 = 0.f, r2 = 0.f;
#pragma unroll
                for (int s = 0; s < 16; ++s) { const float v = sSeg[s * 64 + 16 * n + fr]; t2 += v; if (s < 8) r2 += v; }
                escl[n] = fexp(t2 - r2); st[n] = st[n] * fexp(r2);
#pragma unroll
                for (int r = 0; r < 4; ++r) *(LAS bf16_t*)(sS + (16 * w + 4 * fg + r) * 144 + (16 * n + fr) * 2) = (bf16_t)(pk2(st[n][r], 0.f) & 0xffffu); }
            { const int kp = tid & 31, seg = tid >> 5;
#pragma unroll
              for (int i = 0; i < 8; ++i) { const int t = seg * 8 + i; const f32x2 bc = pre + cu.g[i];
                  *(LAS unsigned*)(sQ + t * 144 + kp * 4) = pk2(bflo(cu.q[i]) * fexp(bc[0] - ref[0]), bfhi(cu.q[i]) * fexp(bc[1] - ref[1]));
                  *(LAS unsigned*)(sKt + t * 144 + kp * 4) = pk2(bflo(cu.k[i]) * fexp(ref[0] - bc[0]), bfhi(cu.k[i]) * fexp(ref[1] - bc[1])); } }
            LDS_BAR();
            const bf16x8 bq0 = *(const LAS bf16x8*)(sQ + tt * 144 + (8 * fg) * 2), bq1 = *(const LAS bf16x8*)(sQ + tt * 144 + (32 + 8 * fg) * 2);
#pragma unroll
            for (int g = 0; g < 2; ++g) if (4 * g <= (w | 1)) {
                bf16x8 kf[8];
#pragma unroll
                for (int q = 0; q < 4; ++q) { kf[2 * q] = *(const LAS bf16x8*)(sKt + (16 * (4 * g + q) + fr) * 144 + (8 * fg) * 2); kf[2 * q + 1] = *(const LAS bf16x8*)(sKt + (16 * (4 * g + q) + fr) * 144 + (32 + 8 * fg) * 2); }
                PIN8(kf);
#pragma unroll
                for (int q = 0; q < 4; ++q) { f32x4 a = mfma16(kf[2 * q], bq0, (f32x4){0.f, 0.f, 0.f, 0.f}); a = mfma16(kf[2 * q + 1], bq1, a);
                    const int s0 = 16 * (4 * g + q) + 4 * fg;
                    u32x2 o; o[0] = pk2(s0 <= tt ? a[0] : 0.f, s0 + 1 <= tt ? a[1] : 0.f); o[1] = pk2(s0 + 2 <= tt ? a[2] : 0.f, s0 + 3 <= tt ? a[3] : 0.f);
                    *(LAS u32x2*)(sP + tt * 272 + s0 * 2) = o; } }
            asm volatile("s_waitcnt lgkmcnt(0)" ::: "memory");
#pragma unroll 1
            for (int ks = 0; ks < 4; ++ks) { bf16x8 a = tr_frag(sV, 288, 32 * ks, 16 * w, lane), kb[4];
#pragma unroll
                for (int n = 0; n < 4; ++n) kb[n] = tr_frag(sKt, 144, 32 * ks, 16 * n, lane);
                asm volatile("" : "+v"(a), "+v"(kb[0]), "+v"(kb[1]), "+v"(kb[2]), "+v"(kb[3]));
#pragma unroll
                for (int n = 0; n < 4; ++n) st[n] = mfma16(a, kb[n], st[n]); }
#pragma unroll
            for (int n = 0; n < 4; ++n) st[n] = st[n] * escl[n];
            f32x4 acc[8];
#pragma unroll
            for (int m = 0; m < 8; ++m) acc[m] = (f32x4){0.f, 0.f, 0.f, 0.f};
#pragma unroll 1
            for (int ks = 0; ks < 4; ++ks) if (32 * ks <= 16 * w + 15) { bf16x8 bfr = *(const LAS bf16x8*)(sP + tt * 272 + (32 * ks + 8 * fg) * 2), vf[8];
#pragma unroll
                for (int m = 0; m < 8; ++m) vf[m] = tr_frag_p8(sV, 288, 32 * ks, m, lane);
                PIN8(vf); asm volatile("" : "+v"(bfr));
#pragma unroll
                for (int m = 0; m < 8; ++m) acc[m] = mfma16(vf[m], bfr, acc[m]); }
#pragma unroll
            for (int hf = 0; hf < 2; ++hf) { bf16x8 sf[8];
#pragma unroll
                for (int q = 0; q < 4; ++q) { const int vr = perm_p8(4 * hf + q, fr); sf[2 * q] = *(const LAS bf16x8*)(sS + vr * 144 + (8 * fg) * 2); sf[2 * q + 1] = *(const LAS bf16x8*)(sS + vr * 144 + (32 + 8 * fg) * 2); }
                PIN8(sf);
#pragma unroll
                for (int q = 0; q < 4; ++q) { acc[4 * hf + q] = mfma16(sf[2 * q], bq0, acc[4 * hf + q]); acc[4 * hf + q] = mfma16(sf[2 * q + 1], bq1, acc[4 * hf + q]); } }
            float ss = 0.f;
#pragma unroll
            for (int m = 0; m < 8; ++m) ss += acc[m][0] * acc[m][0] + acc[m][1] * acc[m][1] + acc[m][2] * acc[m][2] + acc[m][3] * acc[m][3];
            ss += __shfl_xor(ss, 16); ss += __shfl_xor(ss, 32);
            const float rstd = frsq(ss * (1.f / 128.f) + EPS);
#pragma unroll
            for (int a = 0; a < 4; ++a) { const int col = h * 128 + 32 * a + 8 * fg; const f32x4 g0 = *(const LAS f32x4*)(sBog + 32 * a + 8 * fg), g1 = *(const LAS f32x4*)(sBog + 32 * a + 8 * fg + 4);
                u32x4 o; o[0] = pk2(acc[2 * a][0] * rstd * g0[0] * bflo(rr[a][0]), acc[2 * a][1] * rstd * g0[1] * bfhi(rr[a][0])); o[1] = pk2(acc[2 * a][2] * rstd * g0[2] * bflo(rr[a][1]), acc[2 * a][3] * rstd * g0[3] * bfhi(rr[a][1]));
                o[2] = pk2(acc[2 * a + 1][0] * rstd * g1[0] * bflo(rr[a][2]), acc[2 * a + 1][1] * rstd * g1[1] * bfhi(rr[a][2])); o[3] = pk2(acc[2 * a + 1][2] * rstd * g1[2] * bflo(rr[a][3]), acc[2 * a + 1][3] * rstd * g1[3] * bfhi(rr[a][3]));
                THIN_ST((u32x4*)(F.Y() + (size_t)(tok0 + tt) * D + 512 + col), o); }
            LDS_BAR();
        }
    }
}

__device__ __forceinline__ void p7_norm_route(const FP& F0, int l) {
    const FP F = F0.fresh();
    int tid_ = F.tid(); asm volatile("" : "+v"(tid_)); const int tid = tid_, w = tid >> 6, lane = tid & 63, fr = lane & 15, fq = lane >> 4; LAS unsigned char* sc = F.lds + SCR_OFF;
    LAS unsigned char* sW = sc; LAS float* sG = (LAS float*)(sc + 99072); LAS float* sS = (LAS float*)(sc + 103168); LAS float* sLog = (LAS float*)(sc + 107264);
    LAS int* sCnt = (LAS int*)(sc + 131840); LAS int* sBase = sCnt + 32;
    for (int u = blockIdx.x; u < 256; u += gridDim.x) {
        const int b = u >> 5, tok0 = u * 128; const float* m = F.MOD() + ((size_t)l * 8 + b) * 6144;
        u32x4 wreg[12];
#pragma unroll
        for (int i = 0; i < 12; ++i) { const int id = tid + 512 * i, row = id >> 7, ch = id & 127; wreg[i] = *(const u32x4*)(F.WR() + ((size_t)l * 48 + row) * 1024 + ch * 8); }
        float gvv[2], svv[2];
#pragma unroll
        for (int jj = 0; jj < 2; ++jj) { const int j = tid + 512 * jj; gvv[jj] = F.n2g()[l * 1024 + j] * (1.f + m[4096 + j]); svv[jj] = m[3072 + j]; }
        const int t = tok0 + 16 * w + fr; const bf16_t* xr = F.XB() + (size_t)t * D + 16 * fq; float ss = 0.f;
#pragma unroll
        for (int q = 0; q < 4; ++q) { const f32x4 v = *(const f32x4*)(F.PSQ() + (size_t)t * 16 + 4 * q); ss += (v[0] + v[1]) + (v[2] + v[3]); }
        const float rstd = frsq(ss * (1.f / D) + EPS);
#pragma unroll
        for (int i = 0; i < 12; ++i) { const int id = tid + 512 * i, row = id >> 7, ch = id & 127; *(LAS u32x4*)(sW + row * 2064 + ch * 16) = wreg[i]; }
#pragma unroll
        for (int jj = 0; jj < 2; ++jj) { sG[tid + 512 * jj] = gvv[jj]; sS[tid + 512 * jj] = svv[jj]; }
        if (tid < 32) sCnt[tid] = 0;
        __syncthreads();
        f32x4 acc[3];
#pragma unroll
        for (int n = 0; n < 3; ++n) acc[n] = (f32x4){0.f, 0.f, 0.f, 0.f};
#pragma unroll 2
        for (int kc = 0; kc < 16; ++kc) { const int k0 = 64 * kc + 16 * fq; unsigned pk[8]; u32x4 h8;
#pragma unroll
            for (int q = 0; q < 2; ++q) { const u32x4 xv = *(const u32x4*)(xr + 64 * kc + 8 * q);
#pragma unroll
                for (int hh = 0; hh < 2; ++hh) { const f32x4 v = (f32x4){bflo(xv[2 * hh]), bfhi(xv[2 * hh]), bflo(xv[2 * hh + 1]), bfhi(xv[2 * hh + 1])};
                    const f32x4 gg = *(const LAS f32x4*)(sG + k0 + 8 * q + 4 * hh), sh = *(const LAS f32x4*)(sS + k0 + 8 * q + 4 * hh);
                    const f32x4 hv = v * rstd * gg + sh; pk[4 * q + 2 * hh] = pk2(hv[0], hv[1]); pk[4 * q + 2 * hh + 1] = pk2(hv[2], hv[3]); h8[2 * q + hh] = pk4_fp8(hv[0], hv[1], hv[2], hv[3]); } }
            u32x4 o0 = {pk[0], pk[1], pk[2], pk[3]}, o1 = {pk[4], pk[5], pk[6], pk[7]};
            THIN_ST((u32x4*)(F.H8() + (size_t)t * D + k0), h8);
            const bf16x8 a0 = __builtin_bit_cast(bf16x8, o0), a1 = __builtin_bit_cast(bf16x8, o1);
#pragma unroll
            for (int n = 0; n < 3; ++n) { LAS const unsigned char* bp = sW + (n * 16 + fr) * 2064 + k0 * 2;
                acc[n] = mfma16(a0, *(const LAS bf16x8*)bp, acc[n]); acc[n] = mfma16(a1, *(const LAS bf16x8*)(bp + 16), acc[n]); } }
#pragma unroll
        for (int n = 0; n < 3; ++n)
#pragma unroll
            for (int r = 0; r < 4; ++r) sLog[(w * 16 + 4 * fq + r) * 48 + n * 16 + fr] = acc[n][r];
        __syncthreads();
        int e0 = 0, e1 = 0, ls0 = 0, ls1 = 0; float w0 = 0.f, w1 = 0.f; const int tr_ = tok0 + 16 * w + lane;
        if (lane < 16) {
            float lg[36];
#pragma unroll
            for (int j = 0; j < 36; ++j) lg[j] = sLog[(w * 16 + lane) * 48 + j];
            float gmax = -3.0e38f; int grp = 0;
#pragma unroll
            for (int j = 0; j < 4; ++j) { lg[j] += F.b_group()[l * 4 + j]; if (lg[j] > gmax) { gmax = lg[j]; grp = j; } }
            float den = 0.f;
#pragma unroll
            for (int j = 0; j < 4; ++j) den += fexp(lg[j] - gmax);
            const float pg = 1.f / den; float m0 = -3.0e38f, m1 = -3.0e38f; int i0 = 0, i1 = 0;
#pragma unroll
            for (int j = 0; j < 8; ++j) { float v = 0.f;
#pragma unroll
                for (int gq = 0; gq < 4; ++gq) if (grp == gq) v = lg[4 + gq * 8 + j];
                v += F.b_router()[l * 32 + grp * 8 + j];
                if (v > m0) { m1 = m0; i1 = i0; m0 = v; i0 = j; } else if (v > m1) { m1 = v; i1 = j; } }
            const float ex = fexp(m1 - m0); w0 = pg / (1.f + ex); w1 = pg * ex / (1.f + ex); e0 = grp * 8 + i0; e1 = grp * 8 + i1;
            ls0 = __hip_atomic_fetch_add(sCnt + e0, 1, __ATOMIC_RELAXED, __HIP_MEMORY_SCOPE_WORKGROUP); ls1 = __hip_atomic_fetch_add(sCnt + e1, 1, __ATOMIC_RELAXED, __HIP_MEMORY_SCOPE_WORKGROUP);
        }
        __syncthreads();
        if (tid < 32) { const int cc = sCnt[tid]; sBase[tid] = cc ? __hip_atomic_fetch_add(F.CNT() + l * 32 + tid, cc, __ATOMIC_RELAXED, __HIP_MEMORY_SCOPE_AGENT) : 0; }
        __syncthreads();
        if (lane < 16) { const int s0 = sBase[e0] + ls0, s1 = sBase[e1] + ls1;
            F.TOKOF()[(size_t)e0 * 32768 + s0] = tr_; F.TOKOF()[(size_t)e1 * 32768 + s1] = tr_;
            *(i32x4*)(F.ROUTE() + (size_t)tr_ * 8) = (i32x4){e0, s0, __float_as_int(w0), e1}; *(i32x4*)(F.ROUTE() + (size_t)tr_ * 8 + 4) = (i32x4){s1, __float_as_int(w1), 0, 0}; }
        __syncthreads();
    }
}
__global__ void __launch_bounds__(512, 2) mega_fwd(Params p) {
    extern __shared__ __attribute__((aligned(16))) unsigned char lds_raw[];
    const FP F{p, (LAS unsigned char*)lds_raw, 0, __builtin_amdgcn_readfirstlane((int)(threadIdx.x >> 6))};
    for (int i = F.tid(); i < SCR_OFF / 4; i += 512) ((LAS unsigned*)F.lds)[i] = 0u;
    __syncthreads();
    (void)xcd_barrier_post((unsigned*)(p.ws + WS_CTL), (volatile LAS unsigned*)F.lds, F.tid() == 0);
#define bar XcdBarrier{(unsigned*)(p.ws + WS_CTL), xb_xcc_id(), (volatile LAS unsigned*)F.lds}, F.tid() == 0
    const int G = gridDim.x, c = blockIdx.x;
    LAS unsigned char* stage = F.lds + SCR_OFF;
    const LAS int* blk = (const LAS int*)(F.lds + L_BLK); const LAS int* cnt = (const LAS int*)(F.lds + L_CNT); const LAS int* nbp = (const LAS int*)(F.lds + L_NB);
    constexpr int QUOTA_P2 = 8, QUOTA_P9 = 4;

    convert_pull(F, 0, 1 << 30); p0_mod(F); p0_small(F);
    xcd_barrier(bar);
    for (int l = 0; l < NL; ++l) {
        p1_rows(F, l);
        xcd_barrier(bar);
        {
            const FP Fq = F.fresh();
            DenseSched S; S.nM = T / 256; S.nN = NIN / 256; S.nwg = S.nM * S.nN; S.G = G; S.c = c; S.Kb = 2048; S.relabel = 1; S.Bt = (const char*)(Fq.WIN() + (size_t)l * NIN * 1024);
            EpiInProj E{Fq.PROJ(), Fq.GATE(), Fq.bba() + l * 256, Fq.AVSQ()};
            pg8::gemm_phase<false>(stage, (const char*)Fq.H(), 2048, S, E, Fq.wv);
            if (l + 1 < NL && c >= S.nwg % G && (S.nwg % G) != 0) convert_pull(F, l + 1, QUOTA_P2);
        }
        xcd_barrier(bar);
        p3_agg_sgu(F, l);
        xcd_barrier(bar);
        p5_gla_seq(F, l);
        xcd_barrier(bar);
        {
            const FP Fq = F.fresh();
            DenseSched S; S.nM = T / 256; S.nN = 4; S.nwg = S.nM * 4; S.G = G; S.c = c; S.Kb = 2048; S.relabel = 0; S.Bt = (const char*)(Fq.WOUT() + (size_t)l * 1024 * 1024);
            EpiOutProj E{l == 0 ? Fq.x_in() : nullptr, Fq.XB(), Fq.XB(), Fq.MOD() + (size_t)l * 8 * 6144 + 2048, Fq.PSQ()};
            pg8::gemm_phase<false>(stage, (const char*)Fq.Y(), 2048, S, E, Fq.wv);
        }
        xcd_barrier(bar);
        p7_norm_route(F, l);
        xcd_barrier(bar);
        moe_tables(F, l);
        {
            const FP Fq = F.fresh();
            MoeSched<true> S; S.nunits = nbp[0] * 4; S.G = G; S.c = c; S.Kb = 1024; S.blk = blk; S.cnt = cnt; S.tokof = Fq.TOKOF();
            S.W = (const char*)(Fq.W13B() + (size_t)l * 32 * 1024 * 1024); S.estride = (size_t)1024 * 1024; S.tstride = (size_t)256 * 1024;
            EpiMoe1 E{Fq.HID()};
            pg8::gemm_phase<true>(stage, (const char*)Fq.H8(), 1024, S, E, Fq.wv);
            if (l + 1 < NL && c >= S.nunits % G && (S.nunits % G) != 0) convert_pull(F, l + 1, QUOTA_P9);
        }
        xcd_barrier(bar);
        {
            const FP Fq = F.fresh();
            MoeSched<false> S; S.nunits = nbp[0] * 4; S.G = G; S.c = c; S.Kb = 512; S.blk = blk; S.cnt = cnt; S.tokof = Fq.TOKOF();
            S.W = (const char*)(Fq.W2B() + (size_t)l * 32 * 1024 * 512); S.estride = (size_t)1024 * 512; S.tstride = (size_t)256 * 512;
            EpiMoe2 E{Fq.YPAD()};
            pg8::gemm_phase<true>(stage, (const char*)Fq.HID(), 512, S, E, Fq.wv);
            if (l + 1 < NL) convert_pull(F, l + 1, 1 << 30);
        }
        xcd_barrier(bar);
    }
    p1_rows(F, NL);
}

extern "C" void kernel_launch(void* const* d_in, const int* in_sizes, int n_in, void* d_out, int out_size, void* d_ws, size_t ws_size, hipStream_t stream) {
    static int grid = 0;
    if (grid == 0) {
        if (n_in != 22 || out_size != T * D || ws_size < WS_END) { fprintf(stderr, "kernel_launch: unexpected shapes (n_in %d out %d ws %zu need %zu)\n", n_in, out_size, ws_size, (size_t)WS_END); grid = -1; return; }
        int dev = 0, cus = 0, per_cu = 0;
        if (hipGetDevice(&dev) != hipSuccess || hipDeviceGetAttribute(&cus, hipDeviceAttributeMultiprocessorCount, dev) != hipSuccess) { grid = -1; return; }
        if (hipFuncSetAttribute((const void*)mega_fwd, hipFuncAttributeMaxDynamicSharedMemorySize, LDS_BYTES) != hipSuccess) { fprintf(stderr, "kernel_launch: hipFuncSetAttribute failed\n"); grid = -1; return; }
        if (hipOccupancyMaxActiveBlocksPerMultiprocessor(&per_cu, (const void*)mega_fwd, 512, LDS_BYTES) != hipSuccess || per_cu < 1) { fprintf(stderr, "kernel_launch: occupancy query says %d\n", per_cu); }
        (void)hipGetLastError();
        grid = cus;
    }
    if (grid < 0) return;
    (void)hipMemsetAsync((char*)d_ws + WS_CTL, 0, CTL_BYTES, stream);
    Params p{};
    for (int i = 0; i < 22; ++i) p.in[i] = (const float*)d_in[i];
    p.out = (float*)d_out; p.ws = (unsigned char*)d_ws;
    hipLaunchKernelGGL(mega_fwd, dim3(grid), dim3(512), LDS_BYTES, stream, p);
}
```

```cpp
#include <hip/hip_runtime.h>
#include <stdint.h>
#include <stdio.h>

#define LAS __attribute__((address_space(3)))
typedef unsigned short bf16_t;
typedef short bf16x8 __attribute__((ext_vector_type(8)));
typedef short s16x4 __attribute__((ext_vector_type(4)));
typedef float f32x4 __attribute__((ext_vector_type(4)));
typedef float f32x2 __attribute__((ext_vector_type(2)));
typedef unsigned u32x4 __attribute__((ext_vector_type(4)));
typedef unsigned u32x2 __attribute__((ext_vector_type(2)));
typedef int i32x4 __attribute__((ext_vector_type(4)));
typedef int i32x8 __attribute__((ext_vector_type(8)));

constexpr int T = 32768, D = 1024, SEQ = 4096, NL = 4, PIN = 2576, NPJ = 2560, NIN = 2816;
constexpr int LDS_BYTES = 147456, SCR_OFF = 1024;
constexpr int L_BLK = 64, L_CNT = 256, L_NB = 384, L_QW = 448;
constexpr float EPS = 1e-6f;
constexpr size_t al256(size_t x) { return (x + 255) & ~(size_t)255; }
constexpr size_t WS_CTL = 0, CTL_BYTES = 1 << 20, CTL_CNT = 16384, CTL_Q = 20480;
constexpr size_t WS_MOD = WS_CTL + CTL_BYTES;
constexpr size_t WS_WIN = WS_MOD + al256((size_t)4 * 8 * 6144 * 4);
constexpr size_t WS_WOUT = WS_WIN + (size_t)4 * 2816 * 1024 * 2;
constexpr size_t WS_W13 = WS_WOUT + (size_t)4 * 1024 * 1024 * 2;
constexpr size_t WS_W2 = WS_W13 + (size_t)4 * 32 * 1024 * 1024 * 2;
constexpr size_t WS_WS = WS_W2 + (size_t)4 * 32 * 1024 * 512 * 2;
constexpr size_t WS_WR = WS_WS + (size_t)4 * 4 * 128 * 128 * 2;
constexpr size_t WS_H = WS_WR + (size_t)4 * 48 * 1024 * 2;
constexpr size_t WS_PROJ = WS_H + (size_t)T * 1024 * 2;
constexpr size_t WS_GATE = WS_PROJ + (size_t)T * 2560 * 2;
constexpr size_t WS_KV = WS_GATE + (size_t)T * 256 * 4;
constexpr size_t WS_SST = WS_KV + (size_t)2048 * 8192 * 4;
constexpr size_t WS_DEC = WS_SST + (size_t)2048 * 8192 * 2;
constexpr size_t WS_Y = WS_DEC + (size_t)2048 * 64 * 4;
constexpr size_t WS_ROUTE = WS_Y + (size_t)T * 1024 * 2;
constexpr size_t WS_TOKOF = WS_ROUTE + (size_t)T * 32;
constexpr size_t WS_XB = WS_TOKOF + (size_t)32 * 32768 * 4;
constexpr size_t WS_PSQ = WS_XB + (size_t)T * 1024 * 2;
constexpr size_t WS_AVSQ = WS_PSQ + (size_t)T * 16 * 4;
constexpr size_t WS_HS = WS_AVSQ + (size_t)T * 8 * 4;
constexpr size_t WS_WQ = WS_HS + (size_t)T * 8 * 4;
constexpr size_t WS_WQS = WS_WQ + (size_t)4 * 2816 * 1024;
constexpr size_t WS_END = WS_WQS + al256((size_t)4 * 2816 * 4);
static_assert((size_t)73728 * 1024 * 2 <= (size_t)T * 2560 * 2, "YPAD alias");
static_assert((size_t)73728 * 512 * 2 <= (size_t)2048 * 8192 * 6, "HID alias");

__device__ __forceinline__ int lane_id() { int r; asm volatile("v_mbcnt_lo_u32_b32 %0, -1, 0\n\tv_mbcnt_hi_u32_b32 %0, -1, %0" : "=v"(r)); return r; }
__device__ __forceinline__ unsigned pk2(float lo, float hi) { unsigned r; asm("v_cvt_pk_bf16_f32 %0, %1, %2" : "=v"(r) : "v"(lo), "v"(hi)); return r; }
__device__ __forceinline__ float bflo(unsigned u) { return __uint_as_float(u << 16); }
__device__ __forceinline__ float bfhi(unsigned u) { return __uint_as_float(u & 0xffff0000u); }
__device__ __forceinline__ float bf1(bf16_t u) { return __uint_as_float(((unsigned)u) << 16); }
__device__ __forceinline__ float fexp(float x) { return __builtin_amdgcn_exp2f(x * 1.4426950408889634f); }
__device__ __forceinline__ float frcp(float x) { return __builtin_amdgcn_rcpf(x); }
__device__ __forceinline__ float frsq(float x) { return __builtin_amdgcn_rsqf(x); }
__device__ __forceinline__ float silu_f(float x) { return x * frcp(1.f + fexp(-x)); }
__device__ __forceinline__ float gelu_f(float x) { const float u = 1.5957691216057308f * (x + 0.044715f * x * x * x); return x * frcp(1.f + fexp(-u)); }
__device__ __forceinline__ f32x2 silu_pk(f32x2 x) { const f32x2 t = x * (-1.4426950408889634f); f32x2 e; e.x = __builtin_amdgcn_exp2f(t.x); e.y = __builtin_amdgcn_exp2f(t.y);
    const f32x2 d = e + 1.0f; f32x2 r; r.x = __builtin_amdgcn_rcpf(d.x); r.y = __builtin_amdgcn_rcpf(d.y); return x * r; }
__device__ __forceinline__ f32x2 gelu_pk(f32x2 x) { const f32x2 t = (x * x * (-0.10294324f) + (-2.3022082f)) * x; f32x2 e; e.x = __builtin_amdgcn_exp2f(t.x); e.y = __builtin_amdgcn_exp2f(t.y);
    const f32x2 d = e + 1.0f; f32x2 r; r.x = __builtin_amdgcn_rcpf(d.x); r.y = __builtin_amdgcn_rcpf(d.y); return x * r; }
__device__ __forceinline__ f32x4 silu4(f32x4 v) { const f32x2 a = silu_pk((f32x2){v[0], v[1]}), b = silu_pk((f32x2){v[2], v[3]}); return (f32x4){a.x, a.y, b.x, b.y}; }
__device__ __forceinline__ f32x4 gelu4(f32x4 v) { const f32x2 a = gelu_pk((f32x2){v[0], v[1]}), b = gelu_pk((f32x2){v[2], v[3]}); return (f32x4){a.x, a.y, b.x, b.y}; }
__device__ __forceinline__ float logsig_f(float x) { return fminf(x, 0.f) - 0.6931471805599453f * __builtin_amdgcn_logf(1.f + fexp(-fabsf(x))); }

#define XB_TMO      128
#define XB_XCNT(j)  (256  + 64 * (j))
#define XB_XSUB(j)  (1280 + 64 * (j))
#define XB_XGEN(j)  (2304 + 64 * (j))
#define XB_TOP      3328
#define XB_TOPGEN   3392
#define XCD_BAR_WORDS 3456
#define XB_SPIN_CAP (1u << 18)
__device__ __forceinline__ unsigned xb_ld(unsigned* p)              { return __hip_atomic_load(p, __ATOMIC_RELAXED, __HIP_MEMORY_SCOPE_AGENT); }
__device__ __forceinline__ unsigned xb_add(unsigned* p, unsigned v) { return __hip_atomic_fetch_add(p, v, __ATOMIC_RELAXED, __HIP_MEMORY_SCOPE_AGENT); }
__device__ __forceinline__ unsigned xb_xcc_id() { return (unsigned)__builtin_amdgcn_s_getreg((3 << 11) | 20) & 0xFu; }
#define XB_SPIN(cond, bar) do { unsigned _sp = 0; while (cond) { __builtin_amdgcn_s_sleep(1); \
    if ((++_sp & 255u) == 0u) { if (xb_ld(&(bar)[XB_TMO])) break; if (_sp > XB_SPIN_CAP) { atomicAdd(&(bar)[XB_TMO], 1u); break; } } } } while (0)
struct XcdBarrier { unsigned* bar; unsigned x; volatile LAS unsigned* st; };
__device__ __forceinline__ XcdBarrier xcd_barrier_post(unsigned* bar, volatile LAS unsigned* st, bool leader) {
    XcdBarrier b; b.bar = bar; b.x = xb_xcc_id(); b.st = st;
    if (leader) (void)xb_add(&bar[XB_XCNT(b.x)], 1u);
    return b;
}
__device__ __forceinline__ void xcd_barrier_complete(unsigned* bar, unsigned x, unsigned& nloc, unsigned& nx) {
    const unsigned G = gridDim.x * gridDim.y * gridDim.z;
    unsigned sum, cnt, mine, sp = 0u;
    for (;;) {
        sum = 0u; cnt = 0u; mine = 0u;
#pragma unroll
        for (unsigned j = 0; j < 16; ++j) { const unsigned c = xb_ld(&bar[XB_XCNT(j)]); sum += c; cnt += (c > 0u) ? 1u : 0u; mine = (j == x) ? c : mine; }
        if (sum == G) break;
        __builtin_amdgcn_s_sleep(1);
        if ((++sp & 255u) == 0u) { if (xb_ld(&bar[XB_TMO])) break; if (sp > XB_SPIN_CAP) { atomicAdd(&bar[XB_TMO], 1u); break; } }
    }
    nloc = mine > 0u ? mine : 1u; nx = cnt > 0u ? cnt : 1u;
}
__device__ __forceinline__ void xcd_barrier(const XcdBarrier& b, bool leader) {
    asm volatile("s_waitcnt vmcnt(0)" ::: "memory");
    __syncthreads();
    if (leader) {
        unsigned* bar = b.bar;
        __builtin_amdgcn_s_waitcnt(0);
        unsigned nloc = b.st[0], nx = b.st[1];
        if (nloc == 0u) { xcd_barrier_complete(bar, b.x, nloc, nx); b.st[0] = nloc; b.st[1] = nx; }
        const unsigned old = xb_add(&bar[XB_XSUB(b.x)], 1u);
        const unsigned gen = old / nloc;
        if (old + 1u == (gen + 1u) * nloc) {
            __builtin_amdgcn_fence(__ATOMIC_RELEASE, "agent");
            asm volatile("s_waitcnt vmcnt(0)" ::: "memory");
            const unsigned og = xb_add(&bar[XB_TOP], 1u);
            const unsigned tg = og / nx;
            if (og + 1u == (tg + 1u) * nx) xb_add(&bar[XB_TOPGEN], 1u);
            else XB_SPIN(xb_ld(&bar[XB_TOPGEN]) == tg, bar);
            __builtin_amdgcn_fence(__ATOMIC_ACQUIRE, "agent");
            xb_add(&bar[XB_XGEN(b.x)], 1u);
            asm volatile("s_waitcnt vmcnt(0)" ::: "memory");
        } else {
            XB_SPIN(xb_ld(&bar[XB_XGEN(b.x)]) == gen, bar);
            __builtin_amdgcn_fence(__ATOMIC_ACQUIRE, "agent");
            asm volatile("s_waitcnt vmcnt(0)" ::: "memory");
        }
    }
    __syncthreads();
}

namespace pg8 {
__device__ __forceinline__ bf16x8 as_bf16x8(i32x4 v) { return __builtin_bit_cast(bf16x8, v); }
__device__ __forceinline__ i32x4 lo4(i32x8 v) { return v.lo; }
__device__ __forceinline__ i32x4 hi4(i32x8 v) { return v.hi; }
constexpr int BM = 256, BK = 64, HALF = 128, HTB = HALF * BK * 2, STAGE_BYTES = 8 * HTB, NXCD = 8, WGM = 4;
__device__ __forceinline__ int lds_byte(int r, int c) { const int st = (r >> 4) * 2 + (c >> 5), rr = r & 15, cc = c & 31, ob = rr * 64 + cc * 2; return st * 1024 + (ob ^ (((ob >> 9) & 1) << 5)); }
__device__ __forceinline__ void stage_rc(int b, int& R, int& C) { const int st = b / 1024, sb = b % 1024, swz = sb ^ (((sb >> 9) & 1) << 5); R = (st >> 1) * 16 + swz / 64; C = (st & 1) * 32 + (swz % 64) / 2; }
__device__ __forceinline__ int perm32(int rho) { const int n = rho >> 4, i = rho & 15; return 8 * (i >> 2) + 4 * n + (i & 3); }
struct Unit { int pm, pn, e; };
__device__ __forceinline__ int xcd_remap(int L, int nwg) { const int q = nwg / NXCD, r = nwg % NXCD, xcd = L % NXCD, off = L / NXCD; return (xcd < r ? xcd * (q + 1) : r * (q + 1) + (xcd - r) * q) + off; }

template <int MODE, class Epi, class Sched>
__device__ __forceinline__ void gemm_phase(LAS unsigned char* lds, const char* Abase, const int Kb, const Sched& S, const Epi& E, const int wv) {
    int tid_ = wv * 64 + lane_id(); asm volatile("" : "+v"(tid_));
    const int tid = tid_, wid = __builtin_amdgcn_readfirstlane(tid >> 6), lane = tid & 63, wr = wid >> 2, wc = wid & 3, fr = lane & 15, fq = lane >> 4;
    constexpr bool GATHER = Sched::GATHER;
    const int nt = Kb / 128;
    int Ri[2], Ci[2]; unsigned voffB[2], voffA[2];
#pragma unroll
    for (int i = 0; i < 2; ++i) { int R, C; stage_rc(tid * 16 + i * 8192, R, C); Ri[i] = R; Ci[i] = C; const int Rb = Epi::PERM ? ((R & ~31) + perm32(R & 31)) : R; voffB[i] = (unsigned)(Rb * Kb + C * 2); voffA[i] = (unsigned)(R * Kb + C * 2); }
    const unsigned kstep = (unsigned)(BK * 2);
    const unsigned hstep = (unsigned)(HALF * Kb);
    const unsigned tstep = 2u * hstep;
    const unsigned ldsw = (unsigned)wid * 1024u;
    const int aoff = lds_byte(wr * 64 + fr, fq * 8), boff = lds_byte(wc * 32 + fr, fq * 8);
#define PG8_SA(b, h) (((b) * 2 + (h)) * HTB)
#define PG8_SB(b, h) ((4 + (b) * 2 + (h)) * HTB)
#define PG8_STAGE(bufoff, gbase, voff) do { _Pragma("unroll") for (int _i = 0; _i < 2; ++_i) \
        __builtin_amdgcn_global_load_lds((const unsigned*)((const char*)(gbase) + (voff)[_i]), (LAS unsigned*)(lds + (bufoff) + ldsw + _i * 8192), 16, 0, 0); } while (0)
#define PG8_LDA(dst, b, h) do { _Pragma("unroll") for (int m = 0; m < 4; ++m) { dst[m].lo = *(const LAS i32x4*)(lds + PG8_SA(b, h) + aoff + m * 2048); dst[m].hi = *(const LAS i32x4*)(lds + PG8_SA(b, h) + aoff + m * 2048 + 1024); } } while (0)
#define PG8_LDB(dst, b, h) do { _Pragma("unroll") for (int n = 0; n < 2; ++n) { dst[n].lo = *(const LAS i32x4*)(lds + PG8_SB(b, h) + boff + n * 2048); dst[n].hi = *(const LAS i32x4*)(lds + PG8_SB(b, h) + boff + n * 2048 + 1024); } } while (0)
#define PG8_MMA(ai, bj, At, Bt) do { __builtin_amdgcn_s_setprio(1); \
        if constexpr (MODE == 2) {   \
            _Pragma("unroll") for (int m = 0; m < 4; ++m) _Pragma("unroll") for (int n = 0; n < 2; ++n) asm volatile("v_mfma_i32_16x16x64_i8 %0, %1, %2, %0" : "+v"(acc[ai][bj][m][n]) : "v"(lo4(Bt[n])), "v"(lo4(At[m]))); \
            _Pragma("unroll") for (int m = 0; m < 4; ++m) _Pragma("unroll") for (int n = 0; n < 2; ++n) asm volatile("v_mfma_i32_16x16x64_i8 %0, %1, %2, %0" : "+v"(acc[ai][bj][m][n]) : "v"(hi4(Bt[n])), "v"(hi4(At[m]))); } \
        else _Pragma("unroll") for (int m = 0; m < 4; ++m) _Pragma("unroll") for (int n = 0; n < 2; ++n) { \
        if constexpr (MODE == 1) asm volatile("v_mfma_scale_f32_16x16x128_f8f6f4 %0, %1, %2, %0, %3, %3 op_sel_hi:[0,0,0]" : "+v"(acc[ai][bj][m][n]) : "v"(Bt[n]), "v"(At[m]), "v"(one_scale)); \
        else { acc[ai][bj][m][n] = __builtin_amdgcn_mfma_f32_16x16x32_bf16(as_bf16x8(Bt[n].lo), as_bf16x8(At[m].lo), acc[ai][bj][m][n], 0, 0, 0); \
               acc[ai][bj][m][n] = __builtin_amdgcn_mfma_f32_16x16x32_bf16(as_bf16x8(Bt[n].hi), as_bf16x8(At[m].hi), acc[ai][bj][m][n], 0, 0, 0); } } \
        __builtin_amdgcn_s_setprio(0); } while (0)
#define PG8_WAIT_V(n) asm volatile("s_waitcnt vmcnt(" #n ")" ::: "memory")
#define PG8_WAIT_L(n) asm volatile("s_waitcnt lgkmcnt(" #n ")" ::: "memory")
#define PG8_BAR __builtin_amdgcn_s_barrier()
#define PG8_SCHED __builtin_amdgcn_sched_barrier(0)
    Unit cur, nxt; int ui = 0;
    if (!S.next(0, cur)) return;
    f32x4 acc[2][2][4][2];
#pragma unroll
    for (int a = 0; a < 2; ++a)
#pragma unroll
        for (int b = 0; b < 2; ++b)
#pragma unroll
            for (int m = 0; m < 4; ++m)
#pragma unroll
                for (int n = 0; n < 2; ++n) acc[a][b][m][n] = (f32x4){0.f, 0.f, 0.f, 0.f};
    i32x8 At[4], B0[2], B1[2];
    const int one_scale = 0x7f7f7f7f;
    unsigned ao0[2], ao1[2], an0[2], an1[2];
    const char* cA0; const char* cA1;
    if constexpr (GATHER) { S.a_off(cur, Ri[0], Ci[0], ao0[0], ao1[0]); S.a_off(cur, Ri[1], Ci[1], ao0[1], ao1[1]); cA0 = Abase; cA1 = Abase; }
    else { ao0[0] = ao1[0] = an0[0] = an1[0] = voffA[0]; ao0[1] = ao1[1] = an0[1] = an1[1] = voffA[1]; cA0 = Abase + (size_t)((unsigned)cur.pm * tstep); cA1 = cA0 + hstep; }
    const char* cB = S.b_ptr(cur);
    PG8_STAGE(PG8_SB(0, 0), cB, voffB); PG8_STAGE(PG8_SB(0, 1), cB + hstep, voffB); PG8_STAGE(PG8_SA(0, 0), cA0, ao0); PG8_STAGE(PG8_SA(0, 1), cA1, ao1);
    if (wr == 1) PG8_BAR;
    PG8_WAIT_V(2); PG8_BAR;
    PG8_STAGE(PG8_SB(1, 0), cB + kstep, voffB); PG8_STAGE(PG8_SA(1, 0), cA0 + kstep, ao0); PG8_STAGE(PG8_SB(1, 1), cB + hstep + kstep, voffB);
    PG8_WAIT_V(6); PG8_BAR;
    for (;;) {
        const bool has_next = S.next(ui + 1, nxt);
        const char* nB = cB; const char* nA0 = cA0; const char* nA1 = cA1;
        if (has_next) { nB = S.b_ptr(nxt);
            if constexpr (GATHER) { S.a_off(nxt, Ri[0], Ci[0], an0[0], an1[0]); S.a_off(nxt, Ri[1], Ci[1], an0[1], an1[1]); }
            else { nA0 = Abase + (size_t)((unsigned)nxt.pm * tstep); nA1 = nA0 + hstep; } }
        else if constexpr (GATHER) { an0[0] = ao0[0]; an0[1] = ao0[1]; an1[0] = ao1[0]; an1[1] = ao1[1]; }
        for (int t = 0; t < nt; t += 2) {
            const bool last = (t == nt - 2);
            const char* a1h1 = cA1 + (unsigned)(t + 1) * kstep;
            const char* a2h0 = last ? nA0 : cA0 + (unsigned)(t + 2) * kstep; const char* a2h1 = last ? nA1 : cA1 + (unsigned)(t + 2) * kstep;
            const char* b2 = last ? nB : cB + (unsigned)(t + 2) * kstep;
            const char* a3h0 = a2h0 + kstep; const char* b3 = b2 + kstep;
            unsigned x0[2], x1[2];
            if constexpr (GATHER) { x0[0] = last ? an0[0] : ao0[0]; x0[1] = last ? an0[1] : ao0[1]; x1[0] = last ? an1[0] : ao1[0]; x1[1] = last ? an1[1] : ao1[1]; }
            else { x0[0] = x1[0] = voffA[0]; x0[1] = x1[1] = voffA[1]; }
            PG8_LDB(B0, 0, 0); PG8_LDB(B1, 0, 1); PG8_SCHED; PG8_LDA(At, 0, 0); PG8_STAGE(PG8_SA(1, 1), a1h1, ao1);
            PG8_WAIT_V(8); PG8_WAIT_L(0); PG8_BAR; PG8_MMA(0, 0, At, B0); PG8_MMA(0, 1, At, B1); PG8_BAR; PG8_SCHED;
            PG8_LDA(At, 0, 1); PG8_STAGE(PG8_SB(0, 0), b2, voffB); PG8_STAGE(PG8_SB(0, 1), b2 + hstep, voffB); PG8_STAGE(PG8_SA(0, 0), a2h0, x0);
            PG8_WAIT_V(8); PG8_WAIT_L(0); PG8_BAR; PG8_MMA(1, 0, At, B0); PG8_MMA(1, 1, At, B1); PG8_BAR; PG8_SCHED;
            PG8_LDB(B0, 1, 0); PG8_LDB(B1, 1, 1); PG8_SCHED; PG8_LDA(At, 1, 0); PG8_STAGE(PG8_SA(0, 1), a2h1, x1);
            PG8_WAIT_V(8); PG8_WAIT_L(0); PG8_BAR; PG8_MMA(0, 0, At, B0); PG8_MMA(0, 1, At, B1); PG8_BAR; PG8_SCHED;
            PG8_LDA(At, 1, 1); PG8_STAGE(PG8_SB(1, 0), b3, voffB); PG8_STAGE(PG8_SB(1, 1), b3 + hstep, voffB); PG8_STAGE(PG8_SA(1, 0), a3h0, x0);
            PG8_WAIT_V(8); PG8_WAIT_L(0); PG8_BAR; PG8_MMA(1, 0, At, B0); PG8_MMA(1, 1, At, B1); PG8_BAR; PG8_SCHED;
        }
        if (wr == 0) PG8_BAR;
        if constexpr (MODE != 0) asm volatile("s_nop 15" ::: "memory");
        E(acc, cur, wr, wc, fr, fq);
        if (!has_next) break;
#pragma unroll
        for (int a = 0; a < 2; ++a)
#pragma unroll
            for (int b = 0; b < 2; ++b)
#pragma unroll
                for (int m = 0; m < 4; ++m)
#pragma unroll
                    for (int n = 0; n < 2; ++n) acc[a][b][m][n] = (f32x4){0.f, 0.f, 0.f, 0.f};
        cur = nxt; cB = nB; cA0 = nA0; cA1 = nA1; ++ui; if constexpr (GATHER) { ao0[0] = an0[0]; ao0[1] = an0[1]; ao1[0] = an1[0]; ao1[1] = an1[1]; }
        if (wr == 1) PG8_BAR;
    }
    PG8_WAIT_V(0);
    PG8_BAR;
#undef PG8_SA
#undef PG8_SB
#undef PG8_STAGE
#undef PG8_LDA
#undef PG8_LDB
#undef PG8_MMA
#undef PG8_WAIT_V
#undef PG8_WAIT_L
#undef PG8_BAR
#undef PG8_SCHED
}
}
#define LDS_BAR() do { asm volatile("s_waitcnt lgkmcnt(0)" ::: "memory"); __builtin_amdgcn_s_barrier(); asm volatile("" ::: "memory"); } while (0)
struct Params { const float* in[22]; float* out; unsigned char* ws; };
struct FP {
    const Params& P; LAS unsigned char* lds; int zi; int wv;
    __device__ __forceinline__ FP fresh() const { int q; asm volatile("s_mov_b32 %0, 0" : "=s"(q)); return FP{P, lds, q, wv}; }
#define FP_IN(name, idx) __device__ __forceinline__ const float* name() const { return P.in[idx + zi]; }
    FP_IN(x_in, 0) FP_IN(c, 1) FP_IN(w_ada, 2) FP_IN(b_ada, 3) FP_IN(n1g, 4) FP_IN(n2g, 5) FP_IN(w_in, 6) FP_IN(avg, 7) FP_IN(aws, 8) FP_IN(abs_, 9) FP_IN(bwa, 10) FP_IN(bba, 11)
    FP_IN(bog, 12) FP_IN(w_out, 13) FP_IN(w_group, 14) FP_IN(b_group, 15) FP_IN(w_router, 16) FP_IN(b_router, 17) FP_IN(w1, 18) FP_IN(w3, 19) FP_IN(w2, 20) FP_IN(fgain, 21)
#undef FP_IN
#define FP_WS(type, name, off) __device__ __forceinline__ type* name() const { return (type*)((&P.ws)[zi] + (off)); }
    FP_WS(float, MOD, WS_MOD) FP_WS(bf16_t, WIN, WS_WIN) FP_WS(bf16_t, WOUT, WS_WOUT) FP_WS(bf16_t, W13, WS_W13) FP_WS(bf16_t, W2, WS_W2) FP_WS(bf16_t, WSB, WS_WS) FP_WS(bf16_t, WR, WS_WR)
    FP_WS(bf16_t, H, WS_H) FP_WS(bf16_t, PROJ, WS_PROJ) FP_WS(unsigned char, YPAD, WS_PROJ) FP_WS(unsigned char, HID, WS_KV) FP_WS(unsigned char, H8, WS_H) FP_WS(unsigned char, H8I, WS_H + (size_t)T * 1024) FP_WS(float, HS, WS_HS) FP_WS(unsigned char, WQ, WS_WQ) FP_WS(float, WQS, WS_WQS) FP_WS(unsigned char, W13B, WS_W13) FP_WS(unsigned char, W2B, WS_W2) FP_WS(bf16_t, SST, WS_SST) FP_WS(bf16_t, Y, WS_Y) FP_WS(bf16_t, GATE, WS_GATE)
    FP_WS(float, KV, WS_KV) FP_WS(float, DEC, WS_DEC) FP_WS(int, ROUTE, WS_ROUTE) FP_WS(int, TOKOF, WS_TOKOF) FP_WS(int, CNT, WS_CTL + CTL_CNT) FP_WS(int, QH, WS_CTL + CTL_Q) FP_WS(bf16_t, XB, WS_XB) FP_WS(float, PSQ, WS_PSQ) FP_WS(float, AVSQ, WS_AVSQ)
#undef FP_WS
    __device__ __forceinline__ float* xcur() const { return (&P.out)[zi]; }
    __device__ __forceinline__ int tid() const { return wv * 64 + lane_id(); }
};

struct DenseSched {
    static constexpr bool GATHER = false;
    int nM, nN, nwg, G, c, Kb; const char* Bt;
    __device__ __forceinline__ bool next(int i, pg8::Unit& u) const {
        const int L = i * G + c; if (L >= nwg) return false;
        const int wgid = pg8::xcd_remap(L, nwg);
        const int nig = pg8::WGM * nN, gid = wgid / nig, fm = gid * pg8::WGM, gsz = (nM - fm) < pg8::WGM ? (nM - fm) : pg8::WGM;
        u.pm = fm + ((wgid % nig) % gsz); u.pn = (wgid % nig) / gsz; u.e = 0; return true;
    }
    __device__ __forceinline__ void a_off(const pg8::Unit&, int, int, unsigned&, unsigned&) const {}
    __device__ __forceinline__ const char* b_ptr(const pg8::Unit& u) const { return Bt + (size_t)u.pn * 256 * Kb; }
};
template <bool GATHER_> struct MoeSched {
    static constexpr bool GATHER = GATHER_;
    int nunits, G, c, Kb; const LAS int* blk; const LAS int* cnt; const int* tokof; const char* W; size_t estride, tstride;
    __device__ __forceinline__ bool next(int i, pg8::Unit& u) const {
        const int L = i * G + c; if (L >= nunits) return false;
        const int wgid = pg8::xcd_remap(L, nunits);
        u.pm = wgid >> 2; u.pn = wgid & 3; int e = 0; while (e < 31 && blk[e + 1] <= u.pm) ++e; u.e = e; return true;
    }
    __device__ __forceinline__ void a_off(const pg8::Unit& u, int R, int C, unsigned& o0, unsigned& o1) const {
        const int s0 = (u.pm - blk[u.e]) * 256 + R, s1 = s0 + 128, n = cnt[u.e];
        const int t0 = s0 < n ? tokof[u.e * 32768 + s0] : 0, t1 = s1 < n ? tokof[u.e * 32768 + s1] : 0;
        o0 = (unsigned)(t0 * Kb + C * 2); o1 = (unsigned)(t1 * Kb + C * 2);
    }
    __device__ __forceinline__ const char* b_ptr(const pg8::Unit& u) const { return W + (size_t)u.e * estride + (size_t)u.pn * tstride; }
};

#define THIN_ST(p, v) (*(p) = (v))
#define EPI_ST(p, v) (*(p) = (v))
struct EpiInProj {
    static constexpr bool PERM = true;
    bf16_t* PROJ; bf16_t* GATE; const float* b_alpha; float* avsq; const float* hs; const float* wqs;
    __device__ __forceinline__ void operator()(const f32x4 (&acc)[2][2][4][2], const pg8::Unit& u, int wr, int wc, int fr, int fq) const {
        int rl_ = wr * 64 + fr, cl_ = wc * 32 + 8 * fq; asm volatile("" : "+v"(rl_), "+v"(cl_));
        const int row0 = u.pm * 256 + rl_, cl = cl_;
        float rsv[2][4]; f32x4 csv[2][2];
#pragma unroll
        for (int ai = 0; ai < 2; ++ai)
#pragma unroll
            for (int m = 0; m < 4; ++m) rsv[ai][m] = hs[(size_t)(row0 + ai * 128 + m * 16) * 8];
#pragma unroll
        for (int bj = 0; bj < 2; ++bj)
#pragma unroll
            for (int n = 0; n < 2; ++n) csv[bj][n] = *(const f32x4*)(wqs + u.pn * 256 + bj * 128 + cl + 4 * n);
#define EIP_ACC(ai, bj, m, n) (__builtin_convertvector(__builtin_bit_cast(i32x4, acc[ai][bj][m][n]), f32x4) * csv[bj][n] * rsv[ai][m])
        if (u.pn == 10) {
#pragma unroll
            for (int bj = 0; bj < 2; ++bj) { const f32x4 b0 = *(const f32x4*)(b_alpha + bj * 128 + cl), b1 = *(const f32x4*)(b_alpha + bj * 128 + cl + 4);
#pragma unroll
                for (int ai = 0; ai < 2; ++ai)
#pragma unroll
                    for (int m = 0; m < 4; ++m) { bf16_t* gp = GATE + (size_t)(row0 + ai * 128 + m * 16) * 256 + bj * 128 + cl; f32x4 v0 = EIP_ACC(ai, bj, m, 0) + b0, v1 = EIP_ACC(ai, bj, m, 1) + b1;
#pragma unroll
                        for (int j = 0; j < 4; ++j) { v0[j] = logsig_f(v0[j]) * 0.0625f; v1[j] = logsig_f(v1[j]) * 0.0625f; }
                        u32x4 w; w.x = pk2(v0[0], v0[1]); w.y = pk2(v0[2], v0[3]); w.z = pk2(v1[0], v1[1]); w.w = pk2(v1[2], v1[3]);
                        EPI_ST((u32x4*)gp, w); } }
        } else {
            const int mode = u.pn < 4 ? 0 : (u.pn == 4 ? 1 : (u.pn < 8 ? 2 : 3));
#pragma unroll
            for (int ai = 0; ai < 2; ++ai)
#pragma unroll
                for (int m = 0; m < 4; ++m) { bf16_t* rp = PROJ + (size_t)(row0 + ai * 128 + m * 16) * NPJ + u.pn * 256 + cl; float ssq = 0.f;
#pragma unroll
                    for (int bj = 0; bj < 2; ++bj) { f32x4 v0 = EIP_ACC(ai, bj, m, 0), v1 = EIP_ACC(ai, bj, m, 1);
                        if (mode == 0) {
                            v0 = gelu4(v0); v1 = gelu4(v1);
                            ssq += v0[0] * v0[0] + v0[1] * v0[1] + v0[2] * v0[2] + v0[3] * v0[3] + v1[0] * v1[0] + v1[1] * v1[1] + v1[2] * v1[2] + v1[3] * v1[3]; }
                        else if (mode == 1) { v0 = v0 * 0.125f; v1 = v1 * 0.125f; }
                        else if (mode == 3) {
                            v0 = silu4(v0); v1 = silu4(v1); }
                        u32x4 w; w.x = pk2(v0[0], v0[1]); w.y = pk2(v0[2], v0[3]); w.z = pk2(v1[0], v1[1]); w.w = pk2(v1[2], v1[3]);
                        EPI_ST((u32x4*)(rp + bj * 128), w); }
                    if (u.pn == 2 || u.pn == 3) { ssq += __shfl_xor(ssq, 16); ssq += __shfl_xor(ssq, 32);
                        if (fq == 0) avsq[(size_t)(row0 + ai * 128 + m * 16) * 8 + (u.pn - 2) * 4 + wc] = ssq; } }
        }
    }
};
#undef EIP_ACC
struct EpiOutProj {
    static constexpr bool PERM = true;
    const float* xin32; const bf16_t* xin16; bf16_t* xout; const float* g1; float* psq;
    __device__ __forceinline__ void operator()(const f32x4 (&acc)[2][2][4][2], const pg8::Unit& u, int wr, int wc, int fr, int fq) const {
        const int row0 = u.pm * 256 + wr * 64 + fr, col0 = u.pn * 256 + wc * 32 + 8 * fq; const float* gb = g1 + (size_t)(u.pm >> 4) * 6144 + col0;
        f32x4 gv[2][2];
#pragma unroll
        for (int bj = 0; bj < 2; ++bj)
#pragma unroll
            for (int n = 0; n < 2; ++n) gv[bj][n] = *(const f32x4*)(gb + bj * 128 + n * 4);
#define EOP_ROW(X0, X1, ai, m, bj) do { f32x4 x0 = (X0), x1 = (X1); x0 += gv[bj][0] * acc[ai][bj][m][0]; x1 += gv[bj][1] * acc[ai][bj][m][1]; \
            ssq += x0[0] * x0[0] + x0[1] * x0[1] + x0[2] * x0[2] + x0[3] * x0[3] + x1[0] * x1[0] + x1[1] * x1[1] + x1[2] * x1[2] + x1[3] * x1[3]; \
            u32x4 w; w.x = pk2(x0[0], x0[1]); w.y = pk2(x0[2], x0[3]); w.z = pk2(x1[0], x1[1]); w.w = pk2(x1[2], x1[3]); \
            EPI_ST((u32x4*)(xout + (size_t)(row0 + ai * 128 + m * 16) * D + col0 + bj * 128), w); } while (0)
#define EOP_PSQ(ai, m) do { ssq += __shfl_xor(ssq, 16); ssq += __shfl_xor(ssq, 32); if (fq == 0) psq[(size_t)(row0 + ai * 128 + m * 16) * 16 + u.pn * 4 + wc] = ssq; } while (0)
        if (xin32 == nullptr) {
#pragma unroll
            for (int ai = 0; ai < 2; ++ai) { u32x4 xv[4][2];
#pragma unroll
                for (int m = 0; m < 4; ++m)
#pragma unroll
                    for (int bj = 0; bj < 2; ++bj) xv[m][bj] = *(const u32x4*)(xin16 + (size_t)(row0 + ai * 128 + m * 16) * D + col0 + bj * 128);
                asm volatile("" : "+v"(xv[0][0]), "+v"(xv[0][1]), "+v"(xv[1][0]), "+v"(xv[1][1]), "+v"(xv[2][0]), "+v"(xv[2][1]), "+v"(xv[3][0]), "+v"(xv[3][1]));
#pragma unroll
                for (int m = 0; m < 4; ++m) { float ssq = 0.f;
#pragma unroll
                    for (int bj = 0; bj < 2; ++bj) { const u32x4 q = xv[m][bj];
                        EOP_ROW(((f32x4){bflo(q[0]), bfhi(q[0]), bflo(q[1]), bfhi(q[1])}), ((f32x4){bflo(q[2]), bfhi(q[2]), bflo(q[3]), bfhi(q[3])}), ai, m, bj); }
                    EOP_PSQ(ai, m); } }
        } else {
#pragma unroll
            for (int ai = 0; ai < 2; ++ai)
#pragma unroll
                for (int mh = 0; mh < 2; ++mh) { f32x4 xf[2][2][2];
#pragma unroll
                    for (int m = 0; m < 2; ++m)
#pragma unroll
                        for (int bj = 0; bj < 2; ++bj) { const float* xp = xin32 + (size_t)(row0 + ai * 128 + (2 * mh + m) * 16) * D + col0 + bj * 128; xf[m][bj][0] = *(const f32x4*)xp; xf[m][bj][1] = *(const f32x4*)(xp + 4); }
                    asm volatile("" : "+v"(xf[0][0][0]), "+v"(xf[0][0][1]), "+v"(xf[0][1][0]), "+v"(xf[0][1][1]), "+v"(xf[1][0][0]), "+v"(xf[1][0][1]), "+v"(xf[1][1][0]), "+v"(xf[1][1][1]));
#pragma unroll
                    for (int m = 0; m < 2; ++m) { float ssq = 0.f;
#pragma unroll
                        for (int bj = 0; bj < 2; ++bj) EOP_ROW(xf[m][bj][0], xf[m][bj][1], ai, (2 * mh + m), bj);
                        EOP_PSQ(ai, (2 * mh + m)); } }
        }
#undef EOP_ROW
#undef EOP_PSQ
    }
};
__device__ __forceinline__ unsigned pk4_fp8(float a, float b, float c, float d) { int r = __builtin_amdgcn_cvt_pk_fp8_f32(a, b, 0, false); r = __builtin_amdgcn_cvt_pk_fp8_f32(c, d, r, true); return (unsigned)r; }
__device__ __forceinline__ f32x4 up4_fp8(unsigned u) { const f32x2 a = __builtin_amdgcn_cvt_pk_f32_fp8((int)u, false), b = __builtin_amdgcn_cvt_pk_f32_fp8((int)u, true); return (f32x4){a[0], a[1], b[0], b[1]}; }
constexpr float W8_SCALE = 32.f, W8_INV = 1.f / 32.f;
struct EpiMoe1 {
    static constexpr bool PERM = true;
    unsigned char* HID;
    __device__ __forceinline__ void operator()(const f32x4 (&acc)[2][2][4][2], const pg8::Unit& u, int wr, int wc, int fr, int fq) const {
        const int row0 = u.pm * 256 + wr * 64 + fr, col0 = u.pn * 128 + wc * 32 + 8 * fq;
#pragma unroll
        for (int ai = 0; ai < 2; ++ai)
#pragma unroll
            for (int m = 0; m < 4; ++m) { f32x4 v0 = acc[ai][0][m][0] * W8_INV, v1 = acc[ai][0][m][1] * W8_INV; const f32x4 g0 = acc[ai][1][m][0] * W8_INV, g1 = acc[ai][1][m][1] * W8_INV;
                v0 = silu4(v0) * g0; v1 = silu4(v1) * g1;
                u32x2 w; w.x = pk4_fp8(v0[0], v0[1], v0[2], v0[3]); w.y = pk4_fp8(v1[0], v1[1], v1[2], v1[3]);
                EPI_ST((u32x2*)(HID + (size_t)(row0 + ai * 128 + m * 16) * 512 + col0), w); }
    }
};
struct EpiMoe2 {
    static constexpr bool PERM = true;
    unsigned char* YPAD;
    __device__ __forceinline__ void operator()(const f32x4 (&acc)[2][2][4][2], const pg8::Unit& u, int wr, int wc, int fr, int fq) const {
        const int row0 = u.pm * 256 + wr * 64 + fr, col0 = u.pn * 256 + wc * 32 + 8 * fq;
#pragma unroll
        for (int ai = 0; ai < 2; ++ai)
#pragma unroll
            for (int m = 0; m < 4; ++m)
#pragma unroll
                for (int bj = 0; bj < 2; ++bj) { const f32x4 v0 = acc[ai][bj][m][0] * W8_INV, v1 = acc[ai][bj][m][1] * W8_INV;
                    u32x2 w; w.x = pk4_fp8(v0[0], v0[1], v0[2], v0[3]); w.y = pk4_fp8(v1[0], v1[1], v1[2], v1[3]);
                    EPI_ST((u32x2*)(YPAD + (size_t)(row0 + ai * 128 + m * 16) * 1024 + col0 + bj * 128), w); }
    }
};

__device__ __forceinline__ bf16x8 tr_frag(LAS const unsigned char* img, int pitch, int k0, int x0, int lane) {
    LAS const unsigned char* p = img + (k0 + 8 * (lane >> 4) + ((lane & 15) >> 2)) * pitch + (x0 + 4 * (lane & 3)) * 2;
    const s16x4 a = __builtin_amdgcn_ds_read_tr16_b64_v4i16((LAS s16x4*)p), b = __builtin_amdgcn_ds_read_tr16_b64_v4i16((LAS s16x4*)(p + 4 * pitch));
    return (bf16x8){a[0], a[1], a[2], a[3], b[0], b[1], b[2], b[3]};
}
__device__ __forceinline__ bf16x8 tr_frag_p8(LAS const unsigned char* img, int pitch, int k0, int m, int lane) {
    LAS const unsigned char* p = img + (k0 + 8 * (lane >> 4) + ((lane & 15) >> 2)) * pitch + (32 * (m >> 1) + 8 * (lane & 3) + 4 * (m & 1)) * 2;
    const s16x4 a = __builtin_amdgcn_ds_read_tr16_b64_v4i16((LAS s16x4*)p), b = __builtin_amdgcn_ds_read_tr16_b64_v4i16((LAS s16x4*)(p + 4 * pitch));
    return (bf16x8){a[0], a[1], a[2], a[3], b[0], b[1], b[2], b[3]};
}
__device__ __forceinline__ int perm_p8(int m, int i) { return 32 * (m >> 1) + 8 * (i >> 2) + 4 * (m & 1) + (i & 3); }
__device__ __forceinline__ f32x4 mfma16(bf16x8 a, bf16x8 b, f32x4 c) { return __builtin_amdgcn_mfma_f32_16x16x32_bf16(a, b, c, 0, 0, 0); }
#define PIN4(x) asm volatile("" : "+v"((x)[0]), "+v"((x)[1]), "+v"((x)[2]), "+v"((x)[3]))
#define PIN8(x) asm volatile("" : "+v"((x)[0]), "+v"((x)[1]), "+v"((x)[2]), "+v"((x)[3]), "+v"((x)[4]), "+v"((x)[5]), "+v"((x)[6]), "+v"((x)[7]))
struct TrTile { const float* src; unsigned char* dst; int ldn, K, kind, k0, n0; };
__device__ __forceinline__ TrTile tr_desc(const FP& F, int l, int r) {
    TrTile t;
    if (r < 160) { t.src = F.w_in() + (size_t)l * 1024 * PIN; t.ldn = PIN; t.K = 1024; t.kind = 0; t.dst = (unsigned char*)(F.WIN() + (size_t)l * NIN * 1024); t.k0 = (r / 10) * 64; t.n0 = (r % 10) * 256; }
    else if (r < 224) { r -= 160; t.src = F.w_out() + (size_t)l * 1024 * 1024; t.ldn = 1024; t.K = 1024; t.kind = 0; t.dst = (unsigned char*)(F.WOUT() + (size_t)l * 1024 * 1024); t.k0 = (r / 4) * 64; t.n0 = (r % 4) * 256; }
    else if (r < 1248) { r -= 224; const int e = r >> 5; r &= 31; t.src = F.w1() + ((size_t)l * 32 + e) * 1024 * 512; t.ldn = 512; t.K = 1024; t.kind = 1; t.dst = F.W13B() + ((size_t)l * 32 + e) * 1024 * 1024; t.k0 = (r >> 1) * 64; t.n0 = (r & 1) * 256; }
    else if (r < 2272) { r -= 1248; const int e = r >> 5; r &= 31; t.src = F.w3() + ((size_t)l * 32 + e) * 1024 * 512; t.ldn = 512; t.K = 1024; t.kind = 2; t.dst = F.W13B() + ((size_t)l * 32 + e) * 1024 * 1024; t.k0 = (r >> 1) * 64; t.n0 = (r & 1) * 256; }
    else { r -= 2272; const int e = r >> 5; r &= 31; t.src = F.w2() + ((size_t)l * 32 + e) * 512 * 1024; t.ldn = 1024; t.K = 512; t.kind = 3; t.dst = F.W2B() + ((size_t)l * 32 + e) * 1024 * 512; t.k0 = (r >> 2) * 64; t.n0 = (r & 3) * 256; }
    return t;
}
__device__ __forceinline__ void tr_load(const TrTile& t, f32x4 (&v)[8], int tid) {
    if (t.kind == 0) { const int kp = tid >> 4, nq = (tid & 15) * 4;
#pragma unroll
        for (int i = 0; i < 4; ++i) { const float* p = t.src + (size_t)(t.k0 + 2 * kp) * t.ldn + t.n0 + nq + 64 * i; v[i] = *(const f32x4*)p; v[4 + i] = *(const f32x4*)(p + t.ldn); } }
    else { const int kq = tid >> 5, nq = (tid & 31) * 4;
#pragma unroll
        for (int i = 0; i < 2; ++i)
#pragma unroll
            for (int rr = 0; rr < 4; ++rr) v[4 * i + rr] = *(const f32x4*)(t.src + (size_t)(t.k0 + 4 * kq + rr) * t.ldn + t.n0 + nq + 128 * i); }
}
__device__ __forceinline__ void convert_pull(const FP& F0, int l, int quota) {
    const FP F = F0.fresh();
    int tid_ = F.tid(); asm volatile("" : "+v"(tid_)); const int tid = tid_; volatile LAS int* qw = (volatile LAS int*)(F.lds + L_QW);
    LAS unsigned* sT = (LAS unsigned*)(F.lds + SCR_OFF);
    __syncthreads();
    if (tid == 0) qw[0] = quota > 0 ? __hip_atomic_fetch_add(F.QH() + l * 64, 1, __ATOMIC_RELAXED, __HIP_MEMORY_SCOPE_AGENT) : 3296;
    __syncthreads();
    int r = qw[0]; f32x4 v[8]; TrTile cur;
    if (r < 3296) { cur = tr_desc(F, l, r); tr_load(cur, v, tid); }
    for (int n = 1; r < 3296; ++n) {
        if (tid == 0) qw[1] = n < quota ? __hip_atomic_fetch_add(F.QH() + l * 64, 1, __ATOMIC_RELAXED, __HIP_MEMORY_SCOPE_AGENT) : 3296;
        if (cur.kind == 0) { const int kp = tid >> 4, nq = (tid & 15) * 4;
#pragma unroll
            for (int i = 0; i < 4; ++i)
#pragma unroll
                for (int j = 0; j < 4; ++j) sT[(nq + 64 * i + j) * 33 + kp] = pk2(v[i][j], v[4 + i][j]); }
        else { const int kq = tid >> 5, nq = (tid & 31) * 4;
#pragma unroll
            for (int i = 0; i < 2; ++i)
#pragma unroll
                for (int j = 0; j < 4; ++j) sT[(nq + 128 * i + j) * 17 + kq] = pk4_fp8(v[4 * i][j] * W8_SCALE, v[4 * i + 1][j] * W8_SCALE, v[4 * i + 2][j] * W8_SCALE, v[4 * i + 3][j] * W8_SCALE); }
        LDS_BAR();
        const int rn = qw[1]; const TrTile t = cur;
        if (rn < 3296) { cur = tr_desc(F, l, rn); tr_load(cur, v, tid); }
        if (t.kind == 0) {
#pragma unroll
            for (int i = 0; i < 4; ++i) { const int id = tid + 512 * i, nl = id >> 3, kc = id & 7;
                u32x4 w; w.x = sT[nl * 33 + kc * 4]; w.y = sT[nl * 33 + kc * 4 + 1]; w.z = sT[nl * 33 + kc * 4 + 2]; w.w = sT[nl * 33 + kc * 4 + 3];
                *(u32x4*)(t.dst + ((size_t)(t.n0 + nl) * t.K + t.k0 + kc * 8) * 2) = w; } }
        else {
#pragma unroll
            for (int i = 0; i < 2; ++i) { const int id = tid + 512 * i, nl = id >> 2, kc = id & 3; const int nn = t.n0 + nl;
                const int drow = t.kind == 3 ? nn : ((nn >> 7) * 256 + (nn & 127) + (t.kind == 2 ? 128 : 0));
                u32x4 w; w.x = sT[nl * 17 + kc * 4]; w.y = sT[nl * 17 + kc * 4 + 1]; w.z = sT[nl * 17 + kc * 4 + 2]; w.w = sT[nl * 17 + kc * 4 + 3];
                *(u32x4*)(t.dst + (size_t)drow * t.K + t.k0 + kc * 16) = w; } }
        LDS_BAR();
        r = rn;
    }
    __syncthreads();
}
__device__ __forceinline__ void p0_mod(const FP& F0) {
    const FP F = F0.fresh();
    int tid_ = F.tid(); asm volatile("" : "+v"(tid_)); const int tid = tid_; LAS float* sC = (LAS float*)(F.lds + SCR_OFF); LAS float* sR = sC + 8192;
    for (int j = tid; j < 8192; j += 512) sC[j] = silu_f(F.c()[j]);
    __syncthreads();
    const int cg = tid & 31, ks = tid >> 5;
    for (int it = blockIdx.x; it < 192; it += gridDim.x) {
        const int l = it / 48, j0 = (it % 48) * 128 + cg * 4; const float* wp = F.w_ada() + ((size_t)l * 1024 + ks * 64) * 6144 + j0;
        f32x4 acc[8];
#pragma unroll
        for (int b = 0; b < 8; ++b) acc[b] = (f32x4){0.f, 0.f, 0.f, 0.f};
#pragma unroll 4
        for (int k = 0; k < 64; ++k) { const f32x4 w = *(const f32x4*)(wp + (size_t)k * 6144);
#pragma unroll
            for (int b = 0; b < 8; ++b) acc[b] += w * sC[b * 1024 + ks * 64 + k]; }
#pragma unroll
        for (int b = 0; b < 8; ++b) *(LAS f32x4*)(sR + (ks * 8 + b) * 128 + cg * 4) = acc[b];
        __syncthreads();
        for (int o = tid; o < 1024; o += 512) { const int b = o >> 7, j = o & 127; float s = F.b_ada()[l * 6144 + (it % 48) * 128 + j];
#pragma unroll
            for (int q = 0; q < 16; ++q) s += sR[(q * 8 + b) * 128 + j];
            F.MOD()[((size_t)l * 8 + b) * 6144 + (it % 48) * 128 + j] = s; }
        __syncthreads();
    }
}
__device__ __forceinline__ void p0_small(const FP& F0) {
    const FP F = F0.fresh();
    int tid_ = F.tid(); asm volatile("" : "+v"(tid_));
    const size_t gsz = (size_t)gridDim.x * 512, g0 = (size_t)blockIdx.x * 512 + tid_;
    for (size_t i = g0; i < (size_t)4 * 256 * 1024; i += gsz) { const int l = (int)(i >> 18), n = (int)((i >> 10) & 255), k = (int)(i & 1023);
        const float* wl = F.w_in() + ((size_t)l * 1024 + k) * PIN + 2560; const float* wa = F.bwa() + (size_t)l * 16 * 256 + n; float s = 0.f;
#pragma unroll
        for (int r = 0; r < 16; ++r) s += wl[r] * wa[r * 256];
        F.WIN()[((size_t)l * NIN + 2560 + n) * 1024 + k] = (bf16_t)(pk2(s, 0.f) & 0xffffu); }
    for (size_t i = g0; i < (size_t)4 * 4 * 128 * 128; i += gsz) { const int t = (int)((i >> 7) & 127), s = (int)(i & 127); F.WSB()[i] = (bf16_t)(pk2(s <= t ? F.aws()[i] : 0.f, 0.f) & 0xffffu); }
    for (size_t i = g0; i < (size_t)4 * 48 * 1024; i += gsz) { const int l = (int)(i / (48 * 1024)), n = (int)((i >> 10) % 48), k = (int)(i & 1023);
        const float v = n < 4 ? F.w_group()[((size_t)l * 1024 + k) * 4 + n] : (n < 36 ? F.w_router()[((size_t)l * 1024 + k) * 32 + (n - 4)] : 0.f);
        F.WR()[i] = (bf16_t)(pk2(v, 0.f) & 0xffffu); }
}

__device__ __forceinline__ void moe_tables(const FP& F0, int l) {
    const FP F = F0.fresh();
    LAS int* blk = (LAS int*)(F.lds + L_BLK); LAS int* cnt = (LAS int*)(F.lds + L_CNT); LAS int* nb = (LAS int*)(F.lds + L_NB);
    __syncthreads();
    const int tx = F.tid();
    if (tx < 32) cnt[tx] = __hip_atomic_load(F.CNT() + l * 32 + tx, __ATOMIC_RELAXED, __HIP_MEMORY_SCOPE_AGENT);
    __syncthreads();
    if (tx == 0) { int s = 0; for (int e = 0; e < 32; ++e) { blk[e] = s; s += (cnt[e] + 255) >> 8; } blk[32] = s; nb[0] = s; }
    __syncthreads();
}

struct P1Row { u32x2 xb[4]; unsigned ya[4], yc[4]; float w0, w1; };
__device__ __forceinline__ void p1_issue(const FP& F, P1Row& R, const i32x4& r0, const i32x4& r1, const LAS int* blk, int t, int lane) {
    R.w0 = __int_as_float(r0[2]); R.w1 = __int_as_float(r1[1]);
    const unsigned char* y0 = F.YPAD() + ((size_t)blk[r0[0]] * 256 + r0[1]) * 1024; const unsigned char* y1 = F.YPAD() + ((size_t)blk[r0[3]] * 256 + r1[0]) * 1024;
#pragma unroll
    for (int j = 0; j < 4; ++j) { R.xb[j] = *(const u32x2*)(F.XB() + (size_t)t * D + lane * 4 + 256 * j); R.ya[j] = *(const unsigned*)(y0 + lane * 4 + 256 * j); R.yc[j] = *(const unsigned*)(y1 + lane * 4 + 256 * j); }
}
__device__ __forceinline__ void p1_finish(const FP& F, int l, int t, int lane, f32x4 (&x)[4], const f32x4 (&gv)[4], const f32x4 (&sv)[4]) {
    float ss = 0.f;
#pragma unroll
    for (int j = 0; j < 4; ++j) ss += x[j][0] * x[j][0] + x[j][1] * x[j][1] + x[j][2] * x[j][2] + x[j][3] * x[j][3];
#pragma unroll
    for (int o = 32; o >= 1; o >>= 1) ss += __shfl_xor(ss, o);
    const float rstd = frsq(ss * (1.f / D) + EPS);
    if (l < NL) {
        f32x4 hv[4]; float am = 0.f;
#pragma unroll
        for (int j = 0; j < 4; ++j) { hv[j] = x[j] * rstd * gv[j] + sv[j]; am = fmaxf(fmaxf(am, fmaxf(fabsf(hv[j][0]), fabsf(hv[j][1]))), fmaxf(fabsf(hv[j][2]), fabsf(hv[j][3]))); }
#pragma unroll
        for (int o = 32; o >= 1; o >>= 1) am = fmaxf(am, __shfl_xor(am, o));
        const float inv = am > 0.f ? 127.f / am : 0.f;
#pragma unroll
        for (int j = 0; j < 4; ++j) { const f32x4 q = hv[j] * inv + 12582912.f;
            const unsigned o = (__float_as_uint(q[0]) & 0xffu) | ((__float_as_uint(q[1]) & 0xffu) << 8) | ((__float_as_uint(q[2]) & 0xffu) << 16) | (__float_as_uint(q[3]) << 24);
            THIN_ST((unsigned*)(F.H8I() + (size_t)t * D + lane * 4 + 256 * j), o); }
        if (lane == 0) F.HS()[(size_t)t * 8] = am * (1.f / 127.f);
    } else {
#pragma unroll
        for (int j = 0; j < 4; ++j) { const f32x4 hv = x[j] * rstd * gv[j] + sv[j]; THIN_ST((f32x4*)(F.xcur() + (size_t)t * D + lane * 4 + 256 * j), hv); }
    }
}
__device__ __forceinline__ void win_requant(const FP& F, int l, int w, int lane) {
    for (int r = blockIdx.x * 8 + w; r < NIN; r += gridDim.x * 8) {
        const bf16_t* src = F.WIN() + ((size_t)l * NIN + r) * 1024 + lane * 16;
        const u32x4 a = *(const u32x4*)src, b = *(const u32x4*)(src + 8);
        float v[16];
#pragma unroll
        for (int i = 0; i < 4; ++i) { v[2 * i] = bflo(a[i]); v[2 * i + 1] = bfhi(a[i]); v[8 + 2 * i] = bflo(b[i]); v[8 + 2 * i + 1] = bfhi(b[i]); }
        float am = 0.f;
#pragma unroll
        for (int i = 0; i < 16; ++i) am = fmaxf(am, fabsf(v[i]));
#pragma unroll
        for (int o = 32; o >= 1; o >>= 1) am = fmaxf(am, __shfl_xor(am, o));
        const float inv = am > 0.f ? 127.f / am : 0.f;
        u32x4 o;
#pragma unroll
        for (int i = 0; i < 4; ++i) { unsigned q[4];
#pragma unroll
            for (int e = 0; e < 4; ++e) q[e] = __float_as_uint(v[4 * i + e] * inv + 12582912.f);
            o[i] = (q[0] & 0xffu) | ((q[1] & 0xffu) << 8) | ((q[2] & 0xffu) << 16) | (q[3] << 24); }
        *(u32x4*)(F.WQ() + ((size_t)l * NIN + r) * 1024 + lane * 16) = o;
        if (lane == 0) F.WQS()[l * NIN + r] = am * (1.f / 127.f);
    }
}
__device__ __forceinline__ void p1_rows(const FP& F0, int l) {
    const FP F = F0.fresh();
    int tid_ = F.tid(); asm volatile("" : "+v"(tid_)); const int tid = tid_, w = tid >> 6, lane = tid & 63; const LAS int* blk = (const LAS int*)(F.lds + L_BLK);
    if (l < NL) win_requant(F, l, w, lane);
    for (int u = blockIdx.x; u < 256; u += gridDim.x) {
        const int b = u >> 5, tok0 = u * 128 + w * 16;
        f32x4 gv[4], sv[4], g2v[4];
#pragma unroll
        for (int j = 0; j < 4; ++j) { const int col = lane * 4 + 256 * j;
            if (l < NL) { const float* m = F.MOD() + ((size_t)l * 8 + b) * 6144; const f32x4 g = *(const f32x4*)(F.n1g() + l * 1024 + col), sc = *(const f32x4*)(m + 1024 + col); gv[j] = g * (sc + 1.0f); sv[j] = *(const f32x4*)(m + col); }
            else { gv[j] = *(const f32x4*)(F.fgain() + col); sv[j] = (f32x4){0.f, 0.f, 0.f, 0.f}; }
            g2v[j] = l > 0 ? *(const f32x4*)(F.MOD() + ((size_t)(l - 1) * 8 + b) * 6144 + 5120 + col) : (f32x4){0.f, 0.f, 0.f, 0.f}; }
        if (l == 0) {
            f32x4 xn[4];
#pragma unroll
            for (int j = 0; j < 4; ++j) xn[j] = *(const f32x4*)(F.x_in() + (size_t)tok0 * D + lane * 4 + 256 * j);
#pragma unroll 1
            for (int i = 0; i < 16; ++i) { f32x4 x[4];
#pragma unroll
                for (int j = 0; j < 4; ++j) x[j] = xn[j];
                if (i < 15) {
#pragma unroll
                    for (int j = 0; j < 4; ++j) xn[j] = *(const f32x4*)(F.x_in() + (size_t)(tok0 + i + 1) * D + lane * 4 + 256 * j); }
                p1_finish(F, l, tok0 + i, lane, x, gv, sv); }
        } else {
            i32x4 ra = *(const i32x4*)(F.ROUTE() + (size_t)tok0 * 8), rb = *(const i32x4*)(F.ROUTE() + (size_t)tok0 * 8 + 4);
            P1Row nx; p1_issue(F, nx, ra, rb, blk, tok0, lane);
            ra = *(const i32x4*)(F.ROUTE() + (size_t)(tok0 + 1) * 8); rb = *(const i32x4*)(F.ROUTE() + (size_t)(tok0 + 1) * 8 + 4);
#pragma unroll 1
            for (int i = 0; i < 16; ++i) { const int t = tok0 + i; const P1Row cu = nx;
                if (i < 15) { p1_issue(F, nx, ra, rb, blk, t + 1, lane);
                    if (i < 14) { ra = *(const i32x4*)(F.ROUTE() + (size_t)(t + 2) * 8); rb = *(const i32x4*)(F.ROUTE() + (size_t)(t + 2) * 8 + 4); } }
                f32x4 x[4];
#pragma unroll
                for (int j = 0; j < 4; ++j) { const u32x2 xv = cu.xb[j]; const f32x4 a = up4_fp8(cu.ya[j]), c = up4_fp8(cu.yc[j]);
                    const f32x4 m = a * cu.w0 + c * cu.w1;
                    x[j] = (f32x4){bflo(xv[0]), bfhi(xv[0]), bflo(xv[1]), bfhi(xv[1])} + g2v[j] * m;
                    if (l < NL) { u32x2 xo; xo[0] = pk2(x[j][0], x[j][1]); xo[1] = pk2(x[j][2], x[j][3]); THIN_ST((u32x2*)(F.XB() + (size_t)t * D + lane * 4 + 256 * j), xo); } }
                p1_finish(F, l, t, lane, x, gv, sv); }
        }
    }
}

struct ChunkRegs { u32x4 v[4]; f32x2 g[8]; unsigned q[8], k[8]; };
template <bool WITH_Q> __device__ __forceinline__ void chunk_load(const FP& F, ChunkRegs& R, int tok0, int h, int tid) {
    const int kp = tid & 31, seg = tid >> 5;
#pragma unroll
    for (int i = 0; i < 4; ++i) { const int id = tid + 512 * i, row = id >> 4, ch = id & 15; R.v[i] = *(const u32x4*)(F.PROJ() + (size_t)(tok0 + row) * NPJ + 1536 + h * 128 + ch * 8); }
#pragma unroll
    for (int i = 0; i < 8; ++i) { const size_t t = (size_t)(tok0 + seg * 8 + i); { const unsigned gg = *(const unsigned*)(F.GATE() + t * 256 + h * 64 + 2 * kp); R.g[i] = (f32x2){bflo(gg), bfhi(gg)}; } const bf16_t* pr = F.PROJ() + t * NPJ + h * 64 + 2 * kp; R.k[i] = *(const unsigned*)(pr + 1280); if (WITH_Q) R.q[i] = *(const unsigned*)(pr + 1024); }
}
struct ChunkPre { u32x4 v[4]; f32x2 g[8]; };
__device__ __forceinline__ void chunk_pre(const FP& F, ChunkPre& R, int tok0, int h, int tid) {
    const int kp = tid & 31, seg = tid >> 5;
#pragma unroll
    for (int i = 0; i < 4; ++i) { const int id = tid + 512 * i, row = id >> 4, ch = id & 15; R.v[i] = *(const u32x4*)(F.PROJ() + (size_t)(tok0 + row) * NPJ + 1536 + h * 128 + ch * 8); }
#pragma unroll
    for (int i = 0; i < 8; ++i) { const unsigned gg = *(const unsigned*)(F.GATE() + (size_t)(tok0 + seg * 8 + i) * 256 + h * 64 + 2 * kp); R.g[i] = (f32x2){bflo(gg), bfhi(gg)}; }
}
__device__ __forceinline__ void chunk_cumsum(LAS float* sSeg, f32x2 (&g)[8], f32x2& pre, f32x2& tot, f32x2& ref, int tid) {
    const int kp = tid & 31, seg = tid >> 5;
#pragma unroll
    for (int i = 1; i < 8; ++i) g[i] += g[i - 1];
    *(LAS f32x2*)(sSeg + seg * 64 + 2 * kp) = g[7];
    LDS_BAR();
    pre = (f32x2){0.f, 0.f}; tot = pre; ref = pre;
#pragma unroll
    for (int s = 0; s < 16; ++s) { const f32x2 v = *(const LAS f32x2*)(sSeg + s * 64 + 2 * kp); tot += v; if (s < seg) pre += v; if (s < 8) ref += v; }
}

__device__ __forceinline__ void p3_agg_sgu(const FP& F0, int l) {
    const FP F = F0.fresh();
    int tid_ = F.tid(); asm volatile("" : "+v"(tid_)); const int tid = tid_, w = tid >> 6, lane = tid & 63; LAS unsigned char* sc = F.lds + SCR_OFF;
    LAS unsigned char* sV = sc; LAS unsigned char* sK = sc + 36864; LAS float* sSeg = (LAS float*)(sc + 57344); LAS float* sDec = sSeg + 1024;
    LAS unsigned char* sVn = sc + 61696; LAS float* sRstd = (LAS float*)(sc + 98560);
    LAS float* sAvg = (LAS float*)(sc + 99072); LAS float* sBs = (LAS float*)(sc + 101120);
    { const float ga = F.avg()[l * 512 + tid], gb = F.abs_()[l * 512 + tid]; sAvg[tid] = ga; sBs[tid] = gb; }
    const int tt = 16 * w + (lane & 15);
    for (int unit = blockIdx.x; unit < 256; unit += gridDim.x) {
        const int bh = unit >> 3, j = unit & 7, b = bh >> 2, h = bh & 3, tokb = b * SEQ + j * 512, tok0 = unit * 128;
        f32x4 acc[4]; f32x2 bsum = (f32x2){0.f, 0.f};
#pragma unroll
        for (int n = 0; n < 4; ++n) acc[n] = (f32x4){0.f, 0.f, 0.f, 0.f};
        ChunkPre nx; chunk_pre(F, nx, tokb, h, tid);
        unsigned nk[8];
        { const int kp = tid & 31, seg = tid >> 5;
#pragma unroll
          for (int i = 0; i < 8; ++i) nk[i] = *(const unsigned*)(F.PROJ() + (size_t)(tokb + seg * 8 + i) * NPJ + 1280 + h * 64 + 2 * kp); }
        u32x4 vc[4];
#pragma unroll
        for (int i = 0; i < 4; ++i) { const int id = tid + 512 * i, row = id >> 4, ch = id & 15; vc[i] = *(const u32x4*)(F.PROJ() + (size_t)(tok0 + row) * NPJ + 512 + ch * 8); }
        if (tid < 128) { const f32x4 p0 = *(const f32x4*)(F.AVSQ() + (size_t)(tok0 + tid) * 8), p1 = *(const f32x4*)(F.AVSQ() + (size_t)(tok0 + tid) * 8 + 4);
            sRstd[tid] = frsq((((p0[0] + p0[1]) + (p0[2] + p0[3])) + ((p1[0] + p1[1]) + (p1[2] + p1[3]))) * (1.f / 512.f) + EPS); }
        LDS_BAR();
#pragma unroll 1
        for (int it = 0; it < 4; ++it) {
            ChunkRegs cu;
#pragma unroll
            for (int i = 0; i < 4; ++i) cu.v[i] = nx.v[i];
#pragma unroll
            for (int i = 0; i < 8; ++i) cu.g[i] = nx.g[i];
#pragma unroll
            for (int i = 0; i < 8; ++i) cu.k[i] = nk[i];
            if (it < 3) chunk_pre(F, nx, tokb + (it + 1) * 128, h, tid);
            const bf16_t* wrow = F.WSB() + ((size_t)(l * 4 + it) * 128 + tt) * 128 + 8 * (lane >> 4);
            u32x4 au[4];
#pragma unroll
            for (int a = 0; a < 4; ++a) au[a] = *(const u32x4*)(F.PROJ() + (size_t)(tok0 + tt) * NPJ + it * 128 + 32 * a + 8 * (lane >> 4));
            const float bs = sBs[it * 128 + tt];
#pragma unroll
            for (int i = 0; i < 4; ++i) { const int id = tid + 512 * i, row = id >> 4, ch = id & 15; *(LAS u32x4*)(sV + row * 288 + ch * 16) = cu.v[i]; }
#pragma unroll
            for (int i = 0; i < 4; ++i) { const int id = tid + 512 * i, row = id >> 4, ch = id & 15; const u32x4 v = vc[i]; const float rs = sRstd[row];
                const f32x4 g0 = *(const LAS f32x4*)(sAvg + it * 128 + ch * 8), g1 = *(const LAS f32x4*)(sAvg + it * 128 + ch * 8 + 4);
                u32x4 o; o[0] = pk2(bflo(v[0]) * rs * g0[0], bfhi(v[0]) * rs * g0[1]); o[1] = pk2(bflo(v[1]) * rs * g0[2], bfhi(v[1]) * rs * g0[3]);
                o[2] = pk2(bflo(v[2]) * rs * g1[0], bfhi(v[2]) * rs * g1[1]); o[3] = pk2(bflo(v[3]) * rs * g1[2], bfhi(v[3]) * rs * g1[3]);
                *(LAS u32x4*)(sVn + row * 288 + ch * 16) = o; }
            if (it < 3) {
#pragma unroll
                for (int i = 0; i < 4; ++i) { const int id = tid + 512 * i, row = id >> 4, ch = id & 15; vc[i] = *(const u32x4*)(F.PROJ() + (size_t)(tok0 + row) * NPJ + 512 + (it + 1) * 128 + ch * 8); } }
            f32x2 pre, tot, ref; chunk_cumsum(sSeg, cu.g, pre, tot, ref, tid);
            bf16x8 wf[4];
#pragma unroll
            for (int ks = 0; ks < 4; ++ks) wf[ks] = *(const bf16x8*)(wrow + 32 * ks);
            { const int kp = tid & 31, seg = tid >> 5;
#pragma unroll
              for (int i = 0; i < 8; ++i) { const int t = seg * 8 + i; const f32x2 bc = pre + cu.g[i];
                  *(LAS unsigned*)(sK + t * 160 + kp * 4) = pk2(bflo(cu.k[i]) * fexp(tot[0] - bc[0]), bfhi(cu.k[i]) * fexp(tot[1] - bc[1])); }
              if (seg == 0) *(LAS f32x2*)(sDec + 2 * kp) = (f32x2){fexp(tot[0]), fexp(tot[1])};
              if (it < 3) {
#pragma unroll
                  for (int i = 0; i < 8; ++i) nk[i] = *(const unsigned*)(F.PROJ() + (size_t)(tokb + (it + 1) * 128 + seg * 8 + i) * NPJ + 1280 + h * 64 + 2 * kp); } }
            bsum += tot;
            { f32x4 z[8];
#pragma unroll
              for (int m = 0; m < 8; ++m) z[m] = (f32x4){0.f, 0.f, 0.f, 0.f};
#pragma unroll
              for (int ks = 0; ks < 4; ++ks) if (32 * ks <= 16 * w + 15) {
#pragma unroll
                  for (int hf = 0; hf < 2; ++hf) { bf16x8 vf[4];
#pragma unroll
                      for (int m = 0; m < 4; ++m) vf[m] = tr_frag_p8(sVn, 288, 32 * ks, 4 * hf + m, lane);
                      PIN4(vf);
#pragma unroll
                      for (int m = 0; m < 4; ++m) z[4 * hf + m] = mfma16(vf[m], wf[ks], z[4 * hf + m]); } }
#pragma unroll
              for (int a = 0; a < 4; ++a) { const int col = it * 128 + 32 * a + 8 * (lane >> 4);
                  u32x4 o; o[0] = pk2(bflo(au[a][0]) * (z[2 * a][0] + bs), bfhi(au[a][0]) * (z[2 * a][1] + bs)); o[1] = pk2(bflo(au[a][1]) * (z[2 * a][2] + bs), bfhi(au[a][1]) * (z[2 * a][3] + bs));
                  o[2] = pk2(bflo(au[a][2]) * (z[2 * a + 1][0] + bs), bfhi(au[a][2]) * (z[2 * a + 1][1] + bs)); o[3] = pk2(bflo(au[a][3]) * (z[2 * a + 1][2] + bs), bfhi(au[a][3]) * (z[2 * a + 1][3] + bs));
                  THIN_ST((u32x4*)(F.Y() + (size_t)(tok0 + tt) * D + col), o); } }
            LDS_BAR();
#pragma unroll
            for (int n = 0; n < 4; ++n) acc[n] = acc[n] * sDec[16 * n + (lane & 15)];
#pragma unroll
            for (int ks = 0; ks < 4; ++ks) { bf16x8 a = tr_frag(sV, 288, 32 * ks, 16 * w, lane), kb[4];
#pragma unroll
                for (int n = 0; n < 4; ++n) kb[n] = tr_frag(sK, 160, 32 * ks, 16 * n, lane);
                asm volatile("" : "+v"(a), "+v"(kb[0]), "+v"(kb[1]), "+v"(kb[2]), "+v"(kb[3]));
#pragma unroll
                for (int n = 0; n < 4; ++n) acc[n] = mfma16(a, kb[n], acc[n]); }
            LDS_BAR();
        }
        float* kv = F.KV() + (size_t)unit * 8192 + (16 * w + 4 * (lane >> 4)) * 64 + (lane & 15);
#pragma unroll
        for (int n = 0; n < 4; ++n)
#pragma unroll
            for (int r = 0; r < 4; ++r) kv[r * 64 + 16 * n] = acc[n][r];
        if (tid < 32) *(f32x2*)(F.DEC() + (size_t)unit * 64 + 2 * tid) = (f32x2){fexp(bsum[0]), fexp(bsum[1])};
    }
}

__device__ __forceinline__ void p5_gla_seq(const FP& F0, int l) {
    const FP F = F0.fresh();
    int tid_ = F.tid(); asm volatile("" : "+v"(tid_)); const int tid = tid_, w = tid >> 6, lane = tid & 63, fr = lane & 15, fg = lane >> 4; LAS unsigned char* sc = F.lds + SCR_OFF;
    LAS unsigned char* sV = sc; LAS unsigned char* sQ = sc + 36864; LAS unsigned char* sKt = sc + 55296; LAS unsigned char* sS = sc + 73728; LAS unsigned char* sP = sc + 92160;
    LAS float* sSeg = (LAS float*)(sc + 126976);
    LAS float* sBog = (LAS float*)(sc + 131072);
    const int tt = 16 * w + fr;
    for (int unit = blockIdx.x; unit < 256; unit += gridDim.x) {
        const int bh = unit >> 3, j = unit & 7, b = bh >> 2, h = bh & 3, tokb = b * SEQ + j * 512;
        const float bgv = F.bog()[l * 512 + h * 128 + (tid & 127)];
        ChunkPre nx; chunk_pre(F, nx, tokb, h, tid);
        f32x4 st[4];
#pragma unroll
        for (int n = 0; n < 4; ++n) st[n] = (f32x4){0.f, 0.f, 0.f, 0.f};
#pragma unroll 1
        for (int i0 = 0; i0 < j; i0 += 4) {
            f32x4 kq[4][4], dq[4];
#pragma unroll
            for (int u = 0; u < 4; ++u) { const int ui = bh * 8 + (i0 + u < j ? i0 + u : i0); const float* kv = F.KV() + (size_t)ui * 8192 + (16 * w + 4 * fg) * 64 + fr;
#pragma unroll
                for (int n = 0; n < 4; ++n) { dq[u][n] = F.DEC()[ui * 64 + 16 * n + fr];
#pragma unroll
                    for (int r = 0; r < 4; ++r) kq[u][n][r] = kv[r * 64 + 16 * n]; } }
            asm volatile("" : "+v"(kq[0][0]), "+v"(kq[0][1]), "+v"(kq[0][2]), "+v"(kq[0][3]), "+v"(kq[1][0]), "+v"(kq[1][1]), "+v"(kq[1][2]), "+v"(kq[1][3]), "+v"(kq[2][0]), "+v"(kq[2][1]), "+v"(kq[2][2]), "+v"(kq[2][3]),
                              "+v"(kq[3][0]), "+v"(kq[3][1]), "+v"(kq[3][2]), "+v"(kq[3][3]), "+v"(dq[0]), "+v"(dq[1]), "+v"(dq[2]), "+v"(dq[3]));
#pragma unroll
            for (int u = 0; u < 4; ++u) if (i0 + u < j) {
#pragma unroll
                for (int n = 0; n < 4; ++n) st[n] = st[n] * dq[u][n] + kq[u][n]; } }
        if (tid < 128) sBog[tid] = bgv;
#pragma unroll 1
        for (int c = 0; c < 4; ++c) {
            const int tok0 = tokb + c * 128;
            ChunkRegs cu; u32x4 rr[4];
#pragma unroll
            for (int i = 0; i < 4; ++i) cu.v[i] = nx.v[i];
#pragma unroll
            for (int i = 0; i < 8; ++i) cu.g[i] = nx.g[i];
            { const int kp = tid & 31, seg = tid >> 5;
#pragma unroll
              for (int i = 0; i < 8; ++i) { const bf16_t* pr = F.PROJ() + (size_t)(tok0 + seg * 8 + i) * NPJ + h * 64 + 2 * kp; cu.k[i] = *(const unsigned*)(pr + 1280); cu.q[i] = *(const unsigned*)(pr + 1024); } }
            if (c < 3) chunk_pre(F, nx, tok0 + 128, h, tid);
#pragma unroll
            for (int a = 0; a < 4; ++a) rr[a] = *(const u32x4*)(F.PROJ() + (size_t)(tok0 + tt) * NPJ + 2048 + h * 128 + 32 * a + 8 * fg);
#pragma unroll
            for (int i = 0; i < 4; ++i) { const int id = tid + 512 * i, row = id >> 4, ch = id & 15; *(LAS u32x4*)(sV + row * 288 + ch * 16) = cu.v[i]; }
            f32x2 pre, tot, ref; chunk_cumsum(sSeg, cu.g, pre, tot, ref, tid);
            float escl[4];
#pragma unroll
            for (int n = 0; n < 4; ++n) { float t2 = 0.f, r2 = 0.f;
#pragma unroll
                for (int s = 0; s < 16; ++s) { const float v = sSeg[s * 64 + 16 * n + fr]; t2 += v; if (s < 8) r2 += v; }
                escl[n] = fexp(t2 - r2); st[n] = st[n] * fexp(r2);
#pragma unroll
                for (int r = 0; r < 4; ++r) *(LAS bf16_t*)(sS + (16 * w + 4 * fg + r) * 144 + (16 * n + fr) * 2) = (bf16_t)(pk2(st[n][r], 0.f) & 0xffffu); }
            { const int kp = tid & 31, seg = tid >> 5;
#pragma unroll
              for (int i = 0; i < 8; ++i) { const int t = seg * 8 + i; const f32x2 bc = pre + cu.g[i];
                  *(LAS unsigned*)(sQ + t * 144 + kp * 4) = pk2(bflo(cu.q[i]) * fexp(bc[0] - ref[0]), bfhi(cu.q[i]) * fexp(bc[1] - ref[1]));
                  *(LAS unsigned*)(sKt + t * 144 + kp * 4) = pk2(bflo(cu.k[i]) * fexp(ref[0] - bc[0]), bfhi(cu.k[i]) * fexp(ref[1] - bc[1])); } }
            LDS_BAR();
            const bf16x8 bq0 = *(const LAS bf16x8*)(sQ + tt * 144 + (8 * fg) * 2), bq1 = *(const LAS bf16x8*)(sQ + tt * 144 + (32 + 8 * fg) * 2);
#pragma unroll
            for (int g = 0; g < 2; ++g) if (4 * g <= (w | 1)) {
                bf16x8 kf[8];
#pragma unroll
                for (int q = 0; q < 4; ++q) { kf[2 * q] = *(const LAS bf16x8*)(sKt + (16 * (4 * g + q) + fr) * 144 + (8 * fg) * 2); kf[2 * q + 1] = *(const LAS bf16x8*)(sKt + (16 * (4 * g + q) + fr) * 144 + (32 + 8 * fg) * 2); }
                PIN8(kf);
#pragma unroll
                for (int q = 0; q < 4; ++q) { f32x4 a = mfma16(kf[2 * q], bq0, (f32x4){0.f, 0.f, 0.f, 0.f}); a = mfma16(kf[2 * q + 1], bq1, a);
                    const int s0 = 16 * (4 * g + q) + 4 * fg;
                    u32x2 o; o[0] = pk2(s0 <= tt ? a[0] : 0.f, s0 + 1 <= tt ? a[1] : 0.f); o[1] = pk2(s0 + 2 <= tt ? a[2] : 0.f, s0 + 3 <= tt ? a[3] : 0.f);
                    *(LAS u32x2*)(sP + tt * 272 + s0 * 2) = o; } }
            asm volatile("s_waitcnt lgkmcnt(0)" ::: "memory");
#pragma unroll 1
            for (int ks = 0; ks < 4; ++ks) { bf16x8 a = tr_frag(sV, 288, 32 * ks, 16 * w, lane), kb[4];
#pragma unroll
                for (int n = 0; n < 4; ++n) kb[n] = tr_frag(sKt, 144, 32 * ks, 16 * n, lane);
                asm volatile("" : "+v"(a), "+v"(kb[0]), "+v"(kb[1]), "+v"(kb[2]), "+v"(kb[3]));
#pragma unroll
                for (int n = 0; n < 4; ++n) st[n] = mfma16(a, kb[n], st[n]); }
#pragma unroll
            for (int n = 0; n < 4; ++n) st[n] = st[n] * escl[n];
            f32x4 acc[8];
#pragma unroll
            for (int m = 0; m < 8; ++m) acc[m] = (f32x4){0.f, 0.f, 0.f, 0.f};
#pragma unroll 1
            for (int ks = 0; ks < 4; ++ks) if (32 * ks <= 16 * w + 15) { bf16x8 bfr = *(const LAS bf16x8*)(sP + tt * 272 + (32 * ks + 8 * fg) * 2), vf[8];
#pragma unroll
                for (int m = 0; m < 8; ++m) vf[m] = tr_frag_p8(sV, 288, 32 * ks, m, lane);
                PIN8(vf); asm volatile("" : "+v"(bfr));
#pragma unroll
                for (int m = 0; m < 8; ++m) acc[m] = mfma16(vf[m], bfr, acc[m]); }
#pragma unroll
            for (int hf = 0; hf < 2; ++hf) { bf16x8 sf[8];
#pragma unroll
                for (int q = 0; q < 4; ++q) { const int vr = perm_p8(4 * hf + q, fr); sf[2 * q] = *(const LAS bf16x8*)(sS + vr * 144 + (8 * fg) * 2); sf[2 * q + 1] = *(const LAS bf16x8*)(sS + vr * 144 + (32 + 8 * fg) * 2); }
                PIN8(sf);
#pragma unroll
                for (int q = 0; q < 4; ++q) { acc[4 * hf + q] = mfma16(sf[2 * q], bq0, acc[4 * hf + q]); acc[4 * hf + q] = mfma16(sf[2 * q + 1], bq1, acc[4 * hf + q]); } }
            float ss = 0.f;
#pragma unroll
            for (int m = 0; m < 8; ++m) ss += acc[m][0] * acc[m][0] + acc[m][1] * acc[m][1] + acc[m][2] * acc[m][2] + acc[m][3] * acc[m][3];
            ss += __shfl_xor(ss, 16); ss += __shfl_xor(ss, 32);
            const float rstd = frsq(ss * (1.f / 128.f) + EPS);
#pragma unroll
            for (int a = 0; a < 4; ++a) { const int col = h * 128 + 32 * a + 8 * fg; const f32x4 g0 = *(const LAS f32x4*)(sBog + 32 * a + 8 * fg), g1 = *(const LAS f32x4*)(sBog + 32 * a + 8 * fg + 4);
                u32x4 o; o[0] = pk2(acc[2 * a][0] * rstd * g0[0] * bflo(rr[a][0]), acc[2 * a][1] * rstd * g0[1] * bfhi(rr[a][0])); o[1] = pk2(acc[2 * a][2] * rstd * g0[2] * bflo(rr[a][1]), acc[2 * a][3] * rstd * g0[3] * bfhi(rr[a][1]));
                o[2] = pk2(acc[2 * a + 1][0] * rstd * g1[0] * bflo(rr[a][2]), acc[2 * a + 1][1] * rstd * g1[1] * bfhi(rr[a][2])); o[3] = pk2(acc[2 * a + 1][2] * rstd * g1[2] * bflo(rr[a][3]), acc[2 * a + 1][3] * rstd * g1[3] * bfhi(rr[a][3]));
                THIN_ST((u32x4*)(F.Y() + (size_t)(tok0 + tt) * D + 512 + col), o); }
            LDS_BAR();
        }
    }
}

__device__ __forceinline__ void p7_norm_route(const FP& F0, int l) {
    const FP F = F0.fresh();
    int tid_ = F.tid(); asm volatile("" : "+v"(tid_)); const int tid = tid_, w = tid >> 6, lane = tid & 63, fr = lane & 15, fq = lane >> 4; LAS unsigned char* sc = F.lds + SCR_OFF;
    LAS unsigned char* sW = sc; LAS float* sG = (LAS float*)(sc + 99072); LAS float* sS = (LAS float*)(sc + 103168); LAS float* sLog = (LAS float*)(sc + 107264);
    LAS int* sCnt = (LAS int*)(sc + 131840); LAS int* sBase = sCnt + 32;
    for (int u = blockIdx.x; u < 256; u += gridDim.x) {
        const int b = u >> 5, tok0 = u * 128; const float* m = F.MOD() + ((size_t)l * 8 + b) * 6144;
        u32x4 wreg[12];
#pragma unroll
        for (int i = 0; i < 12; ++i) { const int id = tid + 512 * i, row = id >> 7, ch = id & 127; wreg[i] = *(const u32x4*)(F.WR() + ((size_t)l * 48 + row) * 1024 + ch * 8); }
        float gvv[2], svv[2];
#pragma unroll
        for (int jj = 0; jj < 2; ++jj) { const int j = tid + 512 * jj; gvv[jj] = F.n2g()[l * 1024 + j] * (1.f + m[4096 + j]); svv[jj] = m[3072 + j]; }
        const int t = tok0 + 16 * w + fr; const bf16_t* xr = F.XB() + (size_t)t * D + 16 * fq; float ss = 0.f;
#pragma unroll
        for (int q = 0; q < 4; ++q) { const f32x4 v = *(const f32x4*)(F.PSQ() + (size_t)t * 16 + 4 * q); ss += (v[0] + v[1]) + (v[2] + v[3]); }
        const float rstd = frsq(ss * (1.f / D) + EPS);
#pragma unroll
        for (int i = 0; i < 12; ++i) { const int id = tid + 512 * i, row = id >> 7, ch = id & 127; *(LAS u32x4*)(sW + row * 2064 + ch * 16) = wreg[i]; }
#pragma unroll
        for (int jj = 0; jj < 2; ++jj) { sG[tid + 512 * jj] = gvv[jj]; sS[tid + 512 * jj] = svv[jj]; }
        if (tid < 32) sCnt[tid] = 0;
        __syncthreads();
        f32x4 acc[3];
#pragma unroll
        for (int n = 0; n < 3; ++n) acc[n] = (f32x4){0.f, 0.f, 0.f, 0.f};
#pragma unroll 2
        for (int kc = 0; kc < 16; ++kc) { const int k0 = 64 * kc + 16 * fq; unsigned pk[8]; u32x4 h8;
#pragma unroll
            for (int q = 0; q < 2; ++q) { const u32x4 xv = *(const u32x4*)(xr + 64 * kc + 8 * q);
#pragma unroll
                for (int hh = 0; hh < 2; ++hh) { const f32x4 v = (f32x4){bflo(xv[2 * hh]), bfhi(xv[2 * hh]), bflo(xv[2 * hh + 1]), bfhi(xv[2 * hh + 1])};
                    const f32x4 gg = *(const LAS f32x4*)(sG + k0 + 8 * q + 4 * hh), sh = *(const LAS f32x4*)(sS + k0 + 8 * q + 4 * hh);
                    const f32x4 hv = v * rstd * gg + sh; pk[4 * q + 2 * hh] = pk2(hv[0], hv[1]); pk[4 * q + 2 * hh + 1] = pk2(hv[2], hv[3]); h8[2 * q + hh] = pk4_fp8(hv[0], hv[1], hv[2], hv[3]); } }
            u32x4 o0 = {pk[0], pk[1], pk[2], pk[3]}, o1 = {pk[4], pk[5], pk[6], pk[7]};
            THIN_ST((u32x4*)(F.H8() + (size_t)t * D + k0), h8);
            const bf16x8 a0 = __builtin_bit_cast(bf16x8, o0), a1 = __builtin_bit_cast(bf16x8, o1);
#pragma unroll
            for (int n = 0; n < 3; ++n) { LAS const unsigned char* bp = sW + (n * 16 + fr) * 2064 + k0 * 2;
                acc[n] = mfma16(a0, *(const LAS bf16x8*)bp, acc[n]); acc[n] = mfma16(a1, *(const LAS bf16x8*)(bp + 16), acc[n]); } }
#pragma unroll
        for (int n = 0; n < 3; ++n)
#pragma unroll
            for (int r = 0; r < 4; ++r) sLog[(w * 16 + 4 * fq + r) * 48 + n * 16 + fr] = acc[n][r];
        __syncthreads();
        int e0 = 0, e1 = 0, ls0 = 0, ls1 = 0; float w0 = 0.f, w1 = 0.f; const int tr_ = tok0 + 16 * w + lane;
        if (lane < 16) {
            float lg[36];
#pragma unroll
            for (int j = 0; j < 36; ++j) lg[j] = sLog[(w * 16 + lane) * 48 + j];
            float gmax = -3.0e38f; int grp = 0;
#pragma unroll
            for (int j = 0; j < 4; ++j) { lg[j] += F.b_group()[l * 4 + j]; if (lg[j] > gmax) { gmax = lg[j]; grp = j; } }
            float den = 0.f;
#pragma unroll
            for (int j = 0; j < 4; ++j) den += fexp(lg[j] - gmax);
            const float pg = 1.f / den; float m0 = -3.0e38f, m1 = -3.0e38f; int i0 = 0, i1 = 0;
#pragma unroll
            for (int j = 0; j < 8; ++j) { float v = 0.f;
#pragma unroll
                for (int gq = 0; gq < 4; ++gq) if (grp == gq) v = lg[4 + gq * 8 + j];
                v += F.b_router()[l * 32 + grp * 8 + j];
                if (v > m0) { m1 = m0; i1 = i0; m0 = v; i0 = j; } else if (v > m1) { m1 = v; i1 = j; } }
            const float ex = fexp(m1 - m0); w0 = pg / (1.f + ex); w1 = pg * ex / (1.f + ex); e0 = grp * 8 + i0; e1 = grp * 8 + i1;
            ls0 = __hip_atomic_fetch_add(sCnt + e0, 1, __ATOMIC_RELAXED, __HIP_MEMORY_SCOPE_WORKGROUP); ls1 = __hip_atomic_fetch_add(sCnt + e1, 1, __ATOMIC_RELAXED, __HIP_MEMORY_SCOPE_WORKGROUP);
        }
        __syncthreads();
        if (tid < 32) { const int cc = sCnt[tid]; sBase[tid] = cc ? __hip_atomic_fetch_add(F.CNT() + l * 32 + tid, cc, __ATOMIC_RELAXED, __HIP_MEMORY_SCOPE_AGENT) : 0; }
        __syncthreads();
        if (lane < 16) { const int s0 = sBase[e0] + ls0, s1 = sBase[e1] + ls1;
            F.TOKOF()[(size_t)e0 * 32768 + s0] = tr_; F.TOKOF()[(size_t)e1 * 32768 + s1] = tr_;
            *(i32x4*)(F.ROUTE() + (size_t)tr_ * 8) = (i32x4){e0, s0, __float_as_int(w0), e1}; *(i32x4*)(F.ROUTE() + (size_t)tr_ * 8 + 4) = (i32x4){s1, __float_as_int(w1), 0, 0}; }
        __syncthreads();
    }
}
__global__ void __launch_bounds__(512, 2) mega_fwd(Params p) {
    extern __shared__ __attribute__((aligned(16))) unsigned char lds_raw[];
    const FP F{p, (LAS unsigned char*)lds_raw, 0, __builtin_amdgcn_readfirstlane((int)(threadIdx.x >> 6))};
    for (int i = F.tid(); i < SCR_OFF / 4; i += 512) ((LAS unsigned*)F.lds)[i] = 0u;
    __syncthreads();
    (void)xcd_barrier_post((unsigned*)(p.ws + WS_CTL), (volatile LAS unsigned*)F.lds, F.tid() == 0);
#define bar XcdBarrier{(unsigned*)(p.ws + WS_CTL), xb_xcc_id(), (volatile LAS unsigned*)F.lds}, F.tid() == 0
    const int G = gridDim.x, c = blockIdx.x;
    LAS unsigned char* stage = F.lds + SCR_OFF;
    const LAS int* blk = (const LAS int*)(F.lds + L_BLK); const LAS int* cnt = (const LAS int*)(F.lds + L_CNT); const LAS int* nbp = (const LAS int*)(F.lds + L_NB);
    constexpr int QUOTA_P2 = 8, QUOTA_P9 = 4;

    convert_pull(F, 0, 1 << 30); p0_mod(F); p0_small(F);
    xcd_barrier(bar);
    for (int l = 0; l < NL; ++l) {
        p1_rows(F, l);
        xcd_barrier(bar);
        {
            const FP Fq = F.fresh();
            DenseSched S; S.nM = T / 256; S.nN = NIN / 256; S.nwg = S.nM * S.nN; S.G = G; S.c = c; S.Kb = 1024; S.Bt = (const char*)(Fq.WQ() + (size_t)l * NIN * 1024);
            EpiInProj E{Fq.PROJ(), Fq.GATE(), Fq.bba() + l * 256, Fq.AVSQ(), Fq.HS(), Fq.WQS() + l * NIN};
            pg8::gemm_phase<2>(stage, (const char*)Fq.H8I(), 1024, S, E, Fq.wv);
            if (l + 1 < NL && c >= S.nwg % G && (S.nwg % G) != 0) convert_pull(F, l + 1, QUOTA_P2);
        }
        xcd_barrier(bar);
        p3_agg_sgu(F, l);
        xcd_barrier(bar);
        p5_gla_seq(F, l);
        xcd_barrier(bar);
        {
            const FP Fq = F.fresh();
            DenseSched S; S.nM = T / 256; S.nN = 4; S.nwg = S.nM * 4; S.G = G; S.c = c; S.Kb = 2048; S.Bt = (const char*)(Fq.WOUT() + (size_t)l * 1024 * 1024);
            EpiOutProj E{l == 0 ? Fq.x_in() : nullptr, Fq.XB(), Fq.XB(), Fq.MOD() + (size_t)l * 8 * 6144 + 2048, Fq.PSQ()};
            pg8::gemm_phase<0>(stage, (const char*)Fq.Y(), 2048, S, E, Fq.wv);
        }
        xcd_barrier(bar);
        p7_norm_route(F, l);
        xcd_barrier(bar);
        moe_tables(F, l);
        {
            const FP Fq = F.fresh();
            MoeSched<true> S; S.nunits = nbp[0] * 4; S.G = G; S.c = c; S.Kb = 1024; S.blk = blk; S.cnt = cnt; S.tokof = Fq.TOKOF();
            S.W = (const char*)(Fq.W13B() + (size_t)l * 32 * 1024 * 1024); S.estride = (size_t)1024 * 1024; S.tstride = (size_t)256 * 1024;
            EpiMoe1 E{Fq.HID()};
            pg8::gemm_phase<1>(stage, (const char*)Fq.H8(), 1024, S, E, Fq.wv);
            if (l + 1 < NL && c >= S.nunits % G && (S.nunits % G) != 0) convert_pull(F, l + 1, QUOTA_P9);
        }
        xcd_barrier(bar);
        {
            const FP Fq = F.fresh();
            MoeSched<false> S; S.nunits = nbp[0] * 4; S.G = G; S.c = c; S.Kb = 512; S.blk = blk; S.cnt = cnt; S.tokof = Fq.TOKOF();
            S.W = (const char*)(Fq.W2B() + (size_t)l * 32 * 1024 * 512); S.estride = (size_t)1024 * 512; S.tstride = (size_t)256 * 512;
            EpiMoe2 E{Fq.YPAD()};
            pg8::gemm_phase<1>(stage, (const char*)Fq.HID(), 512, S, E, Fq.wv);
            if (l + 1 < NL) convert_pull(F, l + 1, 1 << 30);
        }
        xcd_barrier(bar);
    }
    p1_rows(F, NL);
}

extern "C" void kernel_launch(void* const* d_in, const int* in_sizes, int n_in, void* d_out, int out_size, void* d_ws, size_t ws_size, hipStream_t stream) {
    static int grid = 0;
    if (grid == 0) {
        if (n_in != 22 || out_size != T * D || ws_size < WS_END) { fprintf(stderr, "kernel_launch: unexpected shapes (n_in %d out %d ws %zu need %zu)\n", n_in, out_size, ws_size, (size_t)WS_END); grid = -1; return; }
        int dev = 0, cus = 0, per_cu = 0;
        if (hipGetDevice(&dev) != hipSuccess || hipDeviceGetAttribute(&cus, hipDeviceAttributeMultiprocessorCount, dev) != hipSuccess) { grid = -1; return; }
        if (hipFuncSetAttribute((const void*)mega_fwd, hipFuncAttributeMaxDynamicSharedMemorySize, LDS_BYTES) != hipSuccess) { fprintf(stderr, "kernel_launch: hipFuncSetAttribute failed\n"); grid = -1; return; }
        if (hipOccupancyMaxActiveBlocksPerMultiprocessor(&per_cu, (const void*)mega_fwd, 512, LDS_BYTES) != hipSuccess || per_cu < 1) { fprintf(stderr, "kernel_launch: occupancy query says %d\n", per_cu); }
        (void)hipGetLastError();
        grid = cus;
    }
    if (grid < 0) return;
    (void)hipMemsetAsync((char*)d_ws + WS_CTL, 0, CTL_BYTES, stream);
    Params p{};
    for (int i = 0; i < 22; ++i) p.in[i] = (const float*)d_in[i];
    p.out = (float*)d_out; p.ws = (unsigned char*)d_ws;
    hipLaunchKernelGGL(mega_fwd, dim3(grid), dim3(512), LDS_BYTES, stream, p);
}
```

```cpp
#include <hip/hip_runtime.h>
#include <stdint.h>
#include <stdio.h>

#define LAS __attribute__((address_space(3)))
typedef unsigned short bf16_t;
typedef short bf16x8 __attribute__((ext_vector_type(8)));
typedef short s16x4 __attribute__((ext_vector_type(4)));
typedef float f32x4 __attribute__((ext_vector_type(4)));
typedef float f32x2 __attribute__((ext_vector_type(2)));
typedef unsigned u32x4 __attribute__((ext_vector_type(4)));
typedef unsigned u32x2 __attribute__((ext_vector_type(2)));
typedef int i32x4 __attribute__((ext_vector_type(4)));
typedef int i32x8 __attribute__((ext_vector_type(8)));

constexpr int T = 32768, D = 1024, SEQ = 4096, NL = 4, PIN = 2576, NPJ = 2560, NIN = 2816;
constexpr int LDS_BYTES = 147456, SCR_OFF = 1024;
constexpr int L_BLK = 64, L_CNT = 256, L_NB = 384, L_QW = 448;
constexpr float EPS = 1e-6f;
constexpr size_t al256(size_t x) { return (x + 255) & ~(size_t)255; }
constexpr size_t WS_CTL = 0, CTL_BYTES = 1 << 20, CTL_CNT = 16384, CTL_Q = 20480;
constexpr size_t WS_MOD = WS_CTL + CTL_BYTES;
constexpr size_t WS_WIN = WS_MOD + al256((size_t)4 * 8 * 6144 * 4);
constexpr size_t WS_WOUT = WS_WIN + (size_t)4 * 2816 * 1024 * 2;
constexpr size_t WS_W13 = WS_WOUT + (size_t)4 * 1024 * 1024 * 2;
constexpr size_t WS_W2 = WS_W13 + (size_t)4 * 32 * 1024 * 1024 * 2;
constexpr size_t WS_WS = WS_W2 + (size_t)4 * 32 * 1024 * 512 * 2;
constexpr size_t WS_WR = WS_WS + (size_t)4 * 4 * 128 * 128 * 2;
constexpr size_t WS_H = WS_WR + (size_t)4 * 48 * 1024 * 2;
constexpr size_t WS_PROJ = WS_H + (size_t)T * 1024 * 2;
constexpr size_t WS_GATE = WS_PROJ + (size_t)T * 2560 * 2;
constexpr size_t WS_KV = WS_GATE + (size_t)T * 256 * 4;
constexpr size_t WS_SST = WS_KV + (size_t)2048 * 8192 * 4;
constexpr size_t WS_DEC = WS_SST + (size_t)2048 * 8192 * 2;
constexpr size_t WS_Y = WS_DEC + (size_t)2048 * 64 * 4;
constexpr size_t WS_ROUTE = WS_Y + (size_t)T * 1024 * 2;
constexpr size_t WS_TOKOF = WS_ROUTE + (size_t)T * 32;
constexpr size_t WS_XB = WS_TOKOF + (size_t)32 * 32768 * 4;
constexpr size_t WS_PSQ = WS_XB + (size_t)T * 1024 * 2;
constexpr size_t WS_AVSQ = WS_PSQ + (size_t)T * 16 * 4;
constexpr size_t WS_HS = WS_AVSQ + (size_t)T * 8 * 4;
constexpr size_t WS_WQ = WS_HS + (size_t)T * 8 * 4;
constexpr size_t WS_WQS = WS_WQ + (size_t)4 * 2816 * 1024;
constexpr size_t WS_END = WS_WQS + al256((size_t)4 * 2816 * 4);
static_assert((size_t)73728 * 1024 * 2 <= (size_t)T * 2560 * 2, "YPAD alias");
static_assert((size_t)73728 * 512 * 2 <= (size_t)2048 * 8192 * 6, "HID alias");

__device__ __forceinline__ int lane_id() { int r; asm volatile("v_mbcnt_lo_u32_b32 %0, -1, 0\n\tv_mbcnt_hi_u32_b32 %0, -1, %0" : "=v"(r)); return r; }
__device__ __forceinline__ unsigned pk2(float lo, float hi) { unsigned r; asm("v_cvt_pk_bf16_f32 %0, %1, %2" : "=v"(r) : "v"(lo), "v"(hi)); return r; }
__device__ __forceinline__ float bflo(unsigned u) { return __uint_as_float(u << 16); }
__device__ __forceinline__ float bfhi(unsigned u) { return __uint_as_float(u & 0xffff0000u); }
__device__ __forceinline__ float bf1(bf16_t u) { return __uint_as_float(((unsigned)u) << 16); }
__device__ __forceinline__ float fexp(float x) { return __builtin_amdgcn_exp2f(x * 1.4426950408889634f); }
__device__ __forceinline__ float frcp(float x) { return __builtin_amdgcn_rcpf(x); }
__device__ __forceinline__ float frsq(float x) { return __builtin_amdgcn_rsqf(x); }
__device__ __forceinline__ float silu_f(float x) { return x * frcp(1.f + fexp(-x)); }
__device__ __forceinline__ float gelu_f(float x) { const float u = 1.5957691216057308f * (x + 0.044715f * x * x * x); return x * frcp(1.f + fexp(-u)); }
__device__ __forceinline__ f32x2 silu_pk(f32x2 x) { const f32x2 t = x * (-1.4426950408889634f); f32x2 e; e.x = __builtin_amdgcn_exp2f(t.x); e.y = __builtin_amdgcn_exp2f(t.y);
    const f32x2 d = e + 1.0f; f32x2 r; r.x = __builtin_amdgcn_rcpf(d.x); r.y = __builtin_amdgcn_rcpf(d.y); return x * r; }
__device__ __forceinline__ f32x2 gelu_pk(f32x2 x) { const f32x2 t = (x * x * (-0.10294324f) + (-2.3022082f)) * x; f32x2 e; e.x = __builtin_amdgcn_exp2f(t.x); e.y = __builtin_amdgcn_exp2f(t.y);
    const f32x2 d = e + 1.0f; f32x2 r; r.x = __builtin_amdgcn_rcpf(d.x); r.y = __builtin_amdgcn_rcpf(d.y); return x * r; }
__device__ __forceinline__ f32x4 silu4(f32x4 v) { const f32x2 a = silu_pk((f32x2){v[0], v[1]}), b = silu_pk((f32x2){v[2], v[3]}); return (f32x4){a.x, a.y, b.x, b.y}; }
__device__ __forceinline__ f32x4 gelu4(f32x4 v) { const f32x2 a = gelu_pk((f32x2){v[0], v[1]}), b = gelu_pk((f32x2){v[2], v[3]}); return (f32x4){a.x, a.y, b.x, b.y}; }
__device__ __forceinline__ float logsig_f(float x) { return fminf(x, 0.f) - 0.6931471805599453f * __builtin_amdgcn_logf(1.f + fexp(-fabsf(x))); }

#define XB_TMO      128
#define XB_XCNT(j)  (256  + 64 * (j))
#define XB_XSUB(j)  (1280 + 64 * (j))
#define XB_XGEN(j)  (2304 + 64 * (j))
#define XB_TOP      3328
#define XB_TOPGEN   3392
#define XCD_BAR_WORDS 3456
#define XB_SPIN_CAP (1u << 18)
__device__ __forceinline__ unsigned xb_ld(unsigned* p)              { return __hip_atomic_load(p, __ATOMIC_RELAXED, __HIP_MEMORY_SCOPE_AGENT); }
__device__ __forceinline__ unsigned xb_add(unsigned* p, unsigned v) { return __hip_atomic_fetch_add(p, v, __ATOMIC_RELAXED, __HIP_MEMORY_SCOPE_AGENT); }
__device__ __forceinline__ unsigned xb_xcc_id() { return (unsigned)__builtin_amdgcn_s_getreg((3 << 11) | 20) & 0xFu; }
#define XB_SPIN(cond, bar) do { unsigned _sp = 0; while (cond) { __builtin_amdgcn_s_sleep(1); \
    if ((++_sp & 255u) == 0u) { if (xb_ld(&(bar)[XB_TMO])) break; if (_sp > XB_SPIN_CAP) { atomicAdd(&(bar)[XB_TMO], 1u); break; } } } } while (0)
struct XcdBarrier { unsigned* bar; unsigned x; volatile LAS unsigned* st; };
__device__ __forceinline__ XcdBarrier xcd_barrier_post(unsigned* bar, volatile LAS unsigned* st, bool leader) {
    XcdBarrier b; b.bar = bar; b.x = xb_xcc_id(); b.st = st;
    if (leader) (void)xb_add(&bar[XB_XCNT(b.x)], 1u);
    return b;
}
__device__ __forceinline__ void xcd_barrier_complete(unsigned* bar, unsigned x, unsigned& nloc, unsigned& nx) {
    const unsigned G = gridDim.x * gridDim.y * gridDim.z;
    unsigned sum, cnt, mine, sp = 0u;
    for (;;) {
        sum = 0u; cnt = 0u; mine = 0u;
#pragma unroll
        for (unsigned j = 0; j < 16; ++j) { const unsigned c = xb_ld(&bar[XB_XCNT(j)]); sum += c; cnt += (c > 0u) ? 1u : 0u; mine = (j == x) ? c : mine; }
        if (sum == G) break;
        __builtin_amdgcn_s_sleep(1);
        if ((++sp & 255u) == 0u) { if (xb_ld(&bar[XB_TMO])) break; if (sp > XB_SPIN_CAP) { atomicAdd(&bar[XB_TMO], 1u); break; } }
    }
    nloc = mine > 0u ? mine : 1u; nx = cnt > 0u ? cnt : 1u;
}
__device__ __forceinline__ void xcd_barrier(const XcdBarrier& b, bool leader) {
    asm volatile("s_waitcnt vmcnt(0)" ::: "memory");
    __syncthreads();
    if (leader) {
        unsigned* bar = b.bar;
        __builtin_amdgcn_s_waitcnt(0);
        unsigned nloc = b.st[0], nx = b.st[1];
        if (nloc == 0u) { xcd_barrier_complete(bar, b.x, nloc, nx); b.st[0] = nloc; b.st[1] = nx; }
        const unsigned old = xb_add(&bar[XB_XSUB(b.x)], 1u);
        const unsigned gen = old / nloc;
        if (old + 1u == (gen + 1u) * nloc) {
            __builtin_amdgcn_fence(__ATOMIC_RELEASE, "agent");
            asm volatile("s_waitcnt vmcnt(0)" ::: "memory");
            const unsigned og = xb_add(&bar[XB_TOP], 1u);
            const unsigned tg = og / nx;
            if (og + 1u == (tg + 1u) * nx) xb_add(&bar[XB_TOPGEN], 1u);
            else XB_SPIN(xb_ld(&bar[XB_TOPGEN]) == tg, bar);
            __builtin_amdgcn_fence(__ATOMIC_ACQUIRE, "agent");
            xb_add(&bar[XB_XGEN(b.x)], 1u);
            asm volatile("s_waitcnt vmcnt(0)" ::: "memory");
        } else {
            XB_SPIN(xb_ld(&bar[XB_XGEN(b.x)]) == gen, bar);
            __builtin_amdgcn_fence(__ATOMIC_ACQUIRE, "agent");
            asm volatile("s_waitcnt vmcnt(0)" ::: "memory");
        }
    }
    __syncthreads();
}

namespace pg8 {
__device__ __forceinline__ bf16x8 as_bf16x8(i32x4 v) { return __builtin_bit_cast(bf16x8, v); }
__device__ __forceinline__ i32x4 lo4(i32x8 v) { return v.lo; }
__device__ __forceinline__ i32x4 hi4(i32x8 v) { return v.hi; }
constexpr int BM = 256, BK = 64, HALF = 128, HTB = HALF * BK * 2, STAGE_BYTES = 8 * HTB, NXCD = 8, WGM = 4;
__device__ __forceinline__ int lds_byte(int r, int c) { const int st = (r >> 4) * 2 + (c >> 5), rr = r & 15, cc = c & 31, ob = rr * 64 + cc * 2; return st * 1024 + (ob ^ (((ob >> 9) & 1) << 5)); }
__device__ __forceinline__ void stage_rc(int b, int& R, int& C) { const int st = b / 1024, sb = b % 1024, swz = sb ^ (((sb >> 9) & 1) << 5); R = (st >> 1) * 16 + swz / 64; C = (st & 1) * 32 + (swz % 64) / 2; }
__device__ __forceinline__ int perm32(int rho) { const int n = rho >> 4, i = rho & 15; return 8 * (i >> 2) + 4 * n + (i & 3); }
struct Unit { int pm, pn, e; };
__device__ __forceinline__ int xcd_remap(int L, int nwg) { const int q = nwg / NXCD, r = nwg % NXCD, xcd = L % NXCD, off = L / NXCD; return (xcd < r ? xcd * (q + 1) : r * (q + 1) + (xcd - r) * q) + off; }

template <int MODE, class Epi, class Sched>
__device__ __forceinline__ void gemm_phase(LAS unsigned char* lds, const char* Abase, const int Kb, const Sched& S, const Epi& E, const int wv) {
    int tid_ = wv * 64 + lane_id(); asm volatile("" : "+v"(tid_));
    const int tid = tid_, wid = __builtin_amdgcn_readfirstlane(tid >> 6), lane = tid & 63, wr = wid >> 2, wc = wid & 3, fr = lane & 15, fq = lane >> 4;
    constexpr bool GATHER = Sched::GATHER;
    const int nt = Kb / 128;
    int Ri[2], Ci[2]; unsigned voffB[2], voffA[2];
#pragma unroll
    for (int i = 0; i < 2; ++i) { int R, C; stage_rc(tid * 16 + i * 8192, R, C); Ri[i] = R; Ci[i] = C; const int Rb = Epi::PERM ? ((R & ~31) + perm32(R & 31)) : R; voffB[i] = (unsigned)(Rb * Kb + C * 2); voffA[i] = (unsigned)(R * Kb + C * 2); }
    const unsigned kstep = (unsigned)(BK * 2);
    const unsigned hstep = (unsigned)(HALF * Kb);
    const unsigned tstep = 2u * hstep;
    const unsigned ldsw = (unsigned)wid * 1024u;
    const int aoff = lds_byte(wr * 64 + fr, fq * 8), boff = lds_byte(wc * 32 + fr, fq * 8);
#define PG8_SA(b, h) (((b) * 2 + (h)) * HTB)
#define PG8_SB(b, h) ((4 + (b) * 2 + (h)) * HTB)
#define PG8_STAGE(bufoff, gbase, voff) do { _Pragma("unroll") for (int _i = 0; _i < 2; ++_i) \
        __builtin_amdgcn_global_load_lds((const unsigned*)((const char*)(gbase) + (voff)[_i]), (LAS unsigned*)(lds + (bufoff) + ldsw + _i * 8192), 16, 0, 0); } while (0)
#define PG8_LDA(dst, b, h) do { _Pragma("unroll") for (int m = 0; m < 4; ++m) { dst[m].lo = *(const LAS i32x4*)(lds + PG8_SA(b, h) + aoff + m * 2048); dst[m].hi = *(const LAS i32x4*)(lds + PG8_SA(b, h) + aoff + m * 2048 + 1024); } } while (0)
#define PG8_LDB(dst, b, h) do { _Pragma("unroll") for (int n = 0; n < 2; ++n) { dst[n].lo = *(const LAS i32x4*)(lds + PG8_SB(b, h) + boff + n * 2048); dst[n].hi = *(const LAS i32x4*)(lds + PG8_SB(b, h) + boff + n * 2048 + 1024); } } while (0)
#define PG8_MMA(ai, bj, At, Bt) do { __builtin_amdgcn_s_setprio(1); \
        if constexpr (MODE == 2) {   \
            _Pragma("unroll") for (int m = 0; m < 4; ++m) _Pragma("unroll") for (int n = 0; n < 2; ++n) asm volatile("v_mfma_i32_16x16x64_i8 %0, %1, %2, %0" : "+v"(acc[ai][bj][m][n]) : "v"(lo4(Bt[n])), "v"(lo4(At[m]))); \
            _Pragma("unroll") for (int m = 0; m < 4; ++m) _Pragma("unroll") for (int n = 0; n < 2; ++n) asm volatile("v_mfma_i32_16x16x64_i8 %0, %1, %2, %0" : "+v"(acc[ai][bj][m][n]) : "v"(hi4(Bt[n])), "v"(hi4(At[m]))); } \
        else _Pragma("unroll") for (int m = 0; m < 4; ++m) _Pragma("unroll") for (int n = 0; n < 2; ++n) { \
        if constexpr (MODE == 1) asm volatile("v_mfma_scale_f32_16x16x128_f8f6f4 %0, %1, %2, %0, %3, %3 op_sel_hi:[0,0,0]" : "+v"(acc[ai][bj][m][n]) : "v"(Bt[n]), "v"(At[m]), "v"(one_scale)); \
        else { acc[ai][bj][m][n] = __builtin_amdgcn_mfma_f32_16x16x32_bf16(as_bf16x8(Bt[n].lo), as_bf16x8(At[m].lo), acc[ai][bj][m][n], 0, 0, 0); \
               acc[ai][bj][m][n] = __builtin_amdgcn_mfma_f32_16x16x32_bf16(as_bf16x8(Bt[n].hi), as_bf16x8(At[m].hi), acc[ai][bj][m][n], 0, 0, 0); } } \
        __builtin_amdgcn_s_setprio(0); } while (0)
#define PG8_WAIT_V(n) asm volatile("s_waitcnt vmcnt(" #n ")" ::: "memory")
#define PG8_WAIT_L(n) asm volatile("s_waitcnt lgkmcnt(" #n ")" ::: "memory")
#define PG8_BAR __builtin_amdgcn_s_barrier()
#define PG8_SCHED __builtin_amdgcn_sched_barrier(0)
    Unit cur, nxt; int ui = 0;
    if (!S.next(0, cur)) return;
    f32x4 acc[2][2][4][2];
#pragma unroll
    for (int a = 0; a < 2; ++a)
#pragma unroll
        for (int b = 0; b < 2; ++b)
#pragma unroll
            for (int m = 0; m < 4; ++m)
#pragma unroll
                for (int n = 0; n < 2; ++n) acc[a][b][m][n] = (f32x4){0.f, 0.f, 0.f, 0.f};
    i32x8 At[4], B0[2], B1[2];
    const int one_scale = 0x7f7f7f7f;
    unsigned ao0[2], ao1[2], an0[2], an1[2];
    const char* cA0; const char* cA1;
    if constexpr (GATHER) { S.a_off(cur, Ri[0], Ci[0], ao0[0], ao1[0]); S.a_off(cur, Ri[1], Ci[1], ao0[1], ao1[1]); cA0 = Abase; cA1 = Abase; }
    else { ao0[0] = ao1[0] = an0[0] = an1[0] = voffA[0]; ao0[1] = ao1[1] = an0[1] = an1[1] = voffA[1]; cA0 = Abase + (size_t)((unsigned)cur.pm * tstep); cA1 = cA0 + hstep; }
    const char* cB = S.b_ptr(cur);
    PG8_STAGE(PG8_SB(0, 0), cB, voffB); PG8_STAGE(PG8_SB(0, 1), cB + hstep, voffB); PG8_STAGE(PG8_SA(0, 0), cA0, ao0); PG8_STAGE(PG8_SA(0, 1), cA1, ao1);
    if (wr == 1) PG8_BAR;
    PG8_WAIT_V(2); PG8_BAR;
    PG8_STAGE(PG8_SB(1, 0), cB + kstep, voffB); PG8_STAGE(PG8_SA(1, 0), cA0 + kstep, ao0); PG8_STAGE(PG8_SB(1, 1), cB + hstep + kstep, voffB);
    PG8_WAIT_V(6); PG8_BAR;
    for (;;) {
        const bool has_next = S.next(ui + 1, nxt);
        const char* nB = cB; const char* nA0 = cA0; const char* nA1 = cA1;
        if (has_next) { nB = S.b_ptr(nxt);
            if constexpr (GATHER) { S.a_off(nxt, Ri[0], Ci[0], an0[0], an1[0]); S.a_off(nxt, Ri[1], Ci[1], an0[1], an1[1]); }
            else { nA0 = Abase + (size_t)((unsigned)nxt.pm * tstep); nA1 = nA0 + hstep; } }
        else if constexpr (GATHER) { an0[0] = ao0[0]; an0[1] = ao0[1]; an1[0] = ao1[0]; an1[1] = ao1[1]; }
        if constexpr (MODE == 2) E.stage(cur, lds + STAGE_BYTES + (ui & 1) * 2048, tid, wid);
        for (int t = 0; t < nt; t += 2) {
            const bool last = (t == nt - 2);
            const char* a1h1 = cA1 + (unsigned)(t + 1) * kstep;
            const char* a2h0 = last ? nA0 : cA0 + (unsigned)(t + 2) * kstep; const char* a2h1 = last ? nA1 : cA1 + (unsigned)(t + 2) * kstep;
            const char* b2 = last ? nB : cB + (unsigned)(t + 2) * kstep;
            const char* a3h0 = a2h0 + kstep; const char* b3 = b2 + kstep;
            unsigned x0[2], x1[2];
            if constexpr (GATHER) { x0[0] = last ? an0[0] : ao0[0]; x0[1] = last ? an0[1] : ao0[1]; x1[0] = last ? an1[0] : ao1[0]; x1[1] = last ? an1[1] : ao1[1]; }
            else { x0[0] = x1[0] = voffA[0]; x0[1] = x1[1] = voffA[1]; }
            PG8_LDB(B0, 0, 0); PG8_LDB(B1, 0, 1); PG8_SCHED; PG8_LDA(At, 0, 0); PG8_STAGE(PG8_SA(1, 1), a1h1, ao1);
            PG8_WAIT_V(8); PG8_WAIT_L(0); PG8_BAR; PG8_MMA(0, 0, At, B0); PG8_MMA(0, 1, At, B1); PG8_BAR; PG8_SCHED;
            PG8_LDA(At, 0, 1); PG8_STAGE(PG8_SB(0, 0), b2, voffB); PG8_STAGE(PG8_SB(0, 1), b2 + hstep, voffB); PG8_STAGE(PG8_SA(0, 0), a2h0, x0);
            PG8_WAIT_V(8); PG8_WAIT_L(0); PG8_BAR; PG8_MMA(1, 0, At, B0); PG8_MMA(1, 1, At, B1); PG8_BAR; PG8_SCHED;
            PG8_LDB(B0, 1, 0); PG8_LDB(B1, 1, 1); PG8_SCHED; PG8_LDA(At, 1, 0); PG8_STAGE(PG8_SA(0, 1), a2h1, x1);
            PG8_WAIT_V(8); PG8_WAIT_L(0); PG8_BAR; PG8_MMA(0, 0, At, B0); PG8_MMA(0, 1, At, B1); PG8_BAR; PG8_SCHED;
            PG8_LDA(At, 1, 1); PG8_STAGE(PG8_SB(1, 0), b3, voffB); PG8_STAGE(PG8_SB(1, 1), b3 + hstep, voffB); PG8_STAGE(PG8_SA(1, 0), a3h0, x0);
            PG8_WAIT_V(8); PG8_WAIT_L(0); PG8_BAR; PG8_MMA(1, 0, At, B0); PG8_MMA(1, 1, At, B1); PG8_BAR; PG8_SCHED;
        }
        if (wr == 0) PG8_BAR;
        if constexpr (MODE != 0) asm volatile("s_nop 15" ::: "memory");
        if constexpr (MODE == 2) E(acc, cur, wr, wc, fr, fq, (const LAS float*)(lds + STAGE_BYTES + (ui & 1) * 2048)); else E(acc, cur, wr, wc, fr, fq);
        if (!has_next) break;
#pragma unroll
        for (int a = 0; a < 2; ++a)
#pragma unroll
            for (int b = 0; b < 2; ++b)
#pragma unroll
                for (int m = 0; m < 4; ++m)
#pragma unroll
                    for (int n = 0; n < 2; ++n) acc[a][b][m][n] = (f32x4){0.f, 0.f, 0.f, 0.f};
        cur = nxt; cB = nB; cA0 = nA0; cA1 = nA1; ++ui; if constexpr (GATHER) { ao0[0] = an0[0]; ao0[1] = an0[1]; ao1[0] = an1[0]; ao1[1] = an1[1]; }
        if (wr == 1) PG8_BAR;
    }
    PG8_WAIT_V(0);
    PG8_BAR;
#undef PG8_SA
#undef PG8_SB
#undef PG8_STAGE
#undef PG8_LDA
#undef PG8_LDB
#undef PG8_MMA
#undef PG8_WAIT_V
#undef PG8_WAIT_L
#undef PG8_BAR
#undef PG8_SCHED
}
}
#define LDS_BAR() do { asm volatile("s_waitcnt lgkmcnt(0)" ::: "memory"); __builtin_amdgcn_s_barrier(); asm volatile("" ::: "memory"); } while (0)
struct Params { const float* in[22]; float* out; unsigned char* ws; };
struct FP {
    const Params& P; LAS unsigned char* lds; int zi; int wv;
    __device__ __forceinline__ FP fresh() const { int q; asm volatile("s_mov_b32 %0, 0" : "=s"(q)); return FP{P, lds, q, wv}; }
#define FP_IN(name, idx) __device__ __forceinline__ const float* name() const { return P.in[idx + zi]; }
    FP_IN(x_in, 0) FP_IN(c, 1) FP_IN(w_ada, 2) FP_IN(b_ada, 3) FP_IN(n1g, 4) FP_IN(n2g, 5) FP_IN(w_in, 6) FP_IN(avg, 7) FP_IN(aws, 8) FP_IN(abs_, 9) FP_IN(bwa, 10) FP_IN(bba, 11)
    FP_IN(bog, 12) FP_IN(w_out, 13) FP_IN(w_group, 14) FP_IN(b_group, 15) FP_IN(w_router, 16) FP_IN(b_router, 17) FP_IN(w1, 18) FP_IN(w3, 19) FP_IN(w2, 20) FP_IN(fgain, 21)
#undef FP_IN
#define FP_WS(type, name, off) __device__ __forceinline__ type* name() const { return (type*)((&P.ws)[zi] + (off)); }
    FP_WS(float, MOD, WS_MOD) FP_WS(bf16_t, WIN, WS_WIN) FP_WS(bf16_t, WOUT, WS_WOUT) FP_WS(bf16_t, W13, WS_W13) FP_WS(bf16_t, W2, WS_W2) FP_WS(bf16_t, WSB, WS_WS) FP_WS(bf16_t, WR, WS_WR)
    FP_WS(bf16_t, H, WS_H) FP_WS(bf16_t, PROJ, WS_PROJ) FP_WS(unsigned char, YPAD, WS_PROJ) FP_WS(unsigned char, HID, WS_KV) FP_WS(unsigned char, H8, WS_H) FP_WS(unsigned char, H8I, WS_H + (size_t)T * 1024) FP_WS(float, HS, WS_HS) FP_WS(unsigned char, WQ, WS_WQ) FP_WS(float, WQS, WS_WQS) FP_WS(unsigned char, W13B, WS_W13) FP_WS(unsigned char, W2B, WS_W2) FP_WS(bf16_t, SST, WS_SST) FP_WS(bf16_t, Y, WS_Y) FP_WS(bf16_t, GATE, WS_GATE)
    FP_WS(float, KV, WS_KV) FP_WS(float, DEC, WS_DEC) FP_WS(int, ROUTE, WS_ROUTE) FP_WS(int, TOKOF, WS_TOKOF) FP_WS(int, CNT, WS_CTL + CTL_CNT) FP_WS(int, QH, WS_CTL + CTL_Q) FP_WS(bf16_t, XB, WS_XB) FP_WS(float, PSQ, WS_PSQ) FP_WS(float, AVSQ, WS_AVSQ)
#undef FP_WS
    __device__ __forceinline__ float* xcur() const { return (&P.out)[zi]; }
    __device__ __forceinline__ int tid() const { return wv * 64 + lane_id(); }
};

struct DenseSched {
    static constexpr bool GATHER = false;
    int nM, nN, nwg, G, c, Kb; const char* Bt;
    __device__ __forceinline__ bool next(int i, pg8::Unit& u) const {
        const int L = i * G + c; if (L >= nwg) return false;
        const int wgid = pg8::xcd_remap(L, nwg);
        const int nig = pg8::WGM * nN, gid = wgid / nig, fm = gid * pg8::WGM, gsz = (nM - fm) < pg8::WGM ? (nM - fm) : pg8::WGM;
        u.pm = fm + ((wgid % nig) % gsz); u.pn = (wgid % nig) / gsz; u.e = 0; return true;
    }
    __device__ __forceinline__ void a_off(const pg8::Unit&, int, int, unsigned&, unsigned&) const {}
    __device__ __forceinline__ const char* b_ptr(const pg8::Unit& u) const { return Bt + (size_t)u.pn * 256 * Kb; }
};
template <bool GATHER_> struct MoeSched {
    static constexpr bool GATHER = GATHER_;
    int nunits, G, c, Kb; const LAS int* blk; const LAS int* cnt; const int* tokof; const char* W; size_t estride, tstride;
    __device__ __forceinline__ bool next(int i, pg8::Unit& u) const {
        const int L = i * G + c; if (L >= nunits) return false;
        const int wgid = pg8::xcd_remap(L, nunits);
        u.pm = wgid >> 2; u.pn = wgid & 3; int e = 0; while (e < 31 && blk[e + 1] <= u.pm) ++e; u.e = e; return true;
    }
    __device__ __forceinline__ void a_off(const pg8::Unit& u, int R, int C, unsigned& o0, unsigned& o1) const {
        const int s0 = (u.pm - blk[u.e]) * 256 + R, s1 = s0 + 128, n = cnt[u.e];
        const int t0 = s0 < n ? tokof[u.e * 32768 + s0] : 0, t1 = s1 < n ? tokof[u.e * 32768 + s1] : 0;
        o0 = (unsigned)(t0 * Kb + C * 2); o1 = (unsigned)(t1 * Kb + C * 2);
    }
    __device__ __forceinline__ const char* b_ptr(const pg8::Unit& u) const { return W + (size_t)u.e * estride + (size_t)u.pn * tstride; }
};

#define THIN_ST(p, v) (*(p) = (v))
#define EPI_ST(p, v) (*(p) = (v))
struct EpiInProj {
    static constexpr bool PERM = true;
    bf16_t* PROJ; bf16_t* GATE; const float* b_alpha; float* avsq; const float* hs; const float* wqs;
    __device__ __forceinline__ void stage(const pg8::Unit& u, LAS unsigned char* dst, int tid, int wid) const {
        const float* src = tid < 256 ? hs + (size_t)(u.pm * 256 + tid) * 8 : wqs + u.pn * 256 + (tid - 256);
        __builtin_amdgcn_global_load_lds((const unsigned*)src, (LAS unsigned*)(dst + wid * 256), 4, 0, 0);
    }
    __device__ __forceinline__ void operator()(const f32x4 (&acc)[2][2][4][2], const pg8::Unit& u, int wr, int wc, int fr, int fq, const LAS float* sc) const {
        int rl_ = wr * 64 + fr, cl_ = wc * 32 + 8 * fq; asm volatile("" : "+v"(rl_), "+v"(cl_));
        const int row0 = u.pm * 256 + rl_, cl = cl_;
        float rsv[2][4]; f32x4 csv[2][2];
#pragma unroll
        for (int ai = 0; ai < 2; ++ai)
#pragma unroll
            for (int m = 0; m < 4; ++m) rsv[ai][m] = sc[rl_ + ai * 128 + m * 16];
#pragma unroll
        for (int bj = 0; bj < 2; ++bj)
#pragma unroll
            for (int n = 0; n < 2; ++n) csv[bj][n] = *(const LAS f32x4*)(sc + 256 + bj * 128 + cl + 4 * n);
#define EIP_ACC(ai, bj, m, n) (__builtin_convertvector(__builtin_bit_cast(i32x4, acc[ai][bj][m][n]), f32x4) * csv[bj][n] * rsv[ai][m])
        if (u.pn == 10) {
#pragma unroll
            for (int bj = 0; bj < 2; ++bj) { const f32x4 b0 = *(const f32x4*)(b_alpha + bj * 128 + cl), b1 = *(const f32x4*)(b_alpha + bj * 128 + cl + 4);
#pragma unroll
                for (int ai = 0; ai < 2; ++ai)
#pragma unroll
                    for (int m = 0; m < 4; ++m) { bf16_t* gp = GATE + (size_t)(row0 + ai * 128 + m * 16) * 256 + bj * 128 + cl; f32x4 v0 = EIP_ACC(ai, bj, m, 0) + b0, v1 = EIP_ACC(ai, bj, m, 1) + b1;
#pragma unroll
                        for (int j = 0; j < 4; ++j) { v0[j] = logsig_f(v0[j]) * 0.0625f; v1[j] = logsig_f(v1[j]) * 0.0625f; }
                        u32x4 w; w.x = pk2(v0[0], v0[1]); w.y = pk2(v0[2], v0[3]); w.z = pk2(v1[0], v1[1]); w.w = pk2(v1[2], v1[3]);
                        EPI_ST((u32x4*)gp, w); } }
        } else {
            const int mode = u.pn < 4 ? 0 : (u.pn == 4 ? 1 : (u.pn < 8 ? 2 : 3));
#pragma unroll
            for (int ai = 0; ai < 2; ++ai)
#pragma unroll
                for (int m = 0; m < 4; ++m) { bf16_t* rp = PROJ + (size_t)(row0 + ai * 128 + m * 16) * NPJ + u.pn * 256 + cl; float ssq = 0.f;
#pragma unroll
                    for (int bj = 0; bj < 2; ++bj) { f32x4 v0 = EIP_ACC(ai, bj, m, 0), v1 = EIP_ACC(ai, bj, m, 1);
                        if (mode == 0) {
                            v0 = gelu4(v0); v1 = gelu4(v1);
                            ssq += v0[0] * v0[0] + v0[1] * v0[1] + v0[2] * v0[2] + v0[3] * v0[3] + v1[0] * v1[0] + v1[1] * v1[1] + v1[2] * v1[2] + v1[3] * v1[3]; }
                        else if (mode == 1) { v0 = v0 * 0.125f; v1 = v1 * 0.125f; }
                        else if (mode == 3) {
                            v0 = silu4(v0); v1 = silu4(v1); }
                        u32x4 w; w.x = pk2(v0[0], v0[1]); w.y = pk2(v0[2], v0[3]); w.z = pk2(v1[0], v1[1]); w.w = pk2(v1[2], v1[3]);
                        EPI_ST((u32x4*)(rp + bj * 128), w); }
                    if (u.pn == 2 || u.pn == 3) { ssq += __shfl_xor(ssq, 16); ssq += __shfl_xor(ssq, 32);
                        if (fq == 0) avsq[(size_t)(row0 + ai * 128 + m * 16) * 8 + (u.pn - 2) * 4 + wc] = ssq; } }
        }
    }
};
#undef EIP_ACC
struct EpiOutProj {
    static constexpr bool PERM = true;
    const float* xin32; const bf16_t* xin16; bf16_t* xout; const float* g1; float* psq;
    __device__ __forceinline__ void operator()(const f32x4 (&acc)[2][2][4][2], const pg8::Unit& u, int wr, int wc, int fr, int fq) const {
        const int row0 = u.pm * 256 + wr * 64 + fr, col0 = u.pn * 256 + wc * 32 + 8 * fq; const float* gb = g1 + (size_t)(u.pm >> 4) * 6144 + col0;
        f32x4 gv[2][2];
#pragma unroll
        for (int bj = 0; bj < 2; ++bj)
#pragma unroll
            for (int n = 0; n < 2; ++n) gv[bj][n] = *(const f32x4*)(gb + bj * 128 + n * 4);
#define EOP_ROW(X0, X1, ai, m, bj) do { f32x4 x0 = (X0), x1 = (X1); x0 += gv[bj][0] * acc[ai][bj][m][0]; x1 += gv[bj][1] * acc[ai][bj][m][1]; \
            ssq += x0[0] * x0[0] + x0[1] * x0[1] + x0[2] * x0[2] + x0[3] * x0[3] + x1[0] * x1[0] + x1[1] * x1[1] + x1[2] * x1[2] + x1[3] * x1[3]; \
            u32x4 w; w.x = pk2(x0[0], x0[1]); w.y = pk2(x0[2], x0[3]); w.z = pk2(x1[0], x1[1]); w.w = pk2(x1[2], x1[3]); \
            EPI_ST((u32x4*)(xout + (size_t)(row0 + ai * 128 + m * 16) * D + col0 + bj * 128), w); } while (0)
#define EOP_PSQ(ai, m) do { ssq += __shfl_xor(ssq, 16); ssq += __shfl_xor(ssq, 32); if (fq == 0) psq[(size_t)(row0 + ai * 128 + m * 16) * 16 + u.pn * 4 + wc] = ssq; } while (0)
        if (xin32 == nullptr) {
#pragma unroll
            for (int ai = 0; ai < 2; ++ai) { u32x4 xv[4][2];
#pragma unroll
                for (int m = 0; m < 4; ++m)
#pragma unroll
                    for (int bj = 0; bj < 2; ++bj) xv[m][bj] = *(const u32x4*)(xin16 + (size_t)(row0 + ai * 128 + m * 16) * D + col0 + bj * 128);
                asm volatile("" : "+v"(xv[0][0]), "+v"(xv[0][1]), "+v"(xv[1][0]), "+v"(xv[1][1]), "+v"(xv[2][0]), "+v"(xv[2][1]), "+v"(xv[3][0]), "+v"(xv[3][1]));
#pragma unroll
                for (int m = 0; m < 4; ++m) { float ssq = 0.f;
#pragma unroll
                    for (int bj = 0; bj < 2; ++bj) { const u32x4 q = xv[m][bj];
                        EOP_ROW(((f32x4){bflo(q[0]), bfhi(q[0]), bflo(q[1]), bfhi(q[1])}), ((f32x4){bflo(q[2]), bfhi(q[2]), bflo(q[3]), bfhi(q[3])}), ai, m, bj); }
                    EOP_PSQ(ai, m); } }
        } else {
#pragma unroll
            for (int ai = 0; ai < 2; ++ai)
#pragma unroll
                for (int mh = 0; mh < 2; ++mh) { f32x4 xf[2][2][2];
#pragma unroll
                    for (int m = 0; m < 2; ++m)
#pragma unroll
                        for (int bj = 0; bj < 2; ++bj) { const float* xp = xin32 + (size_t)(row0 + ai * 128 + (2 * mh + m) * 16) * D + col0 + bj * 128; xf[m][bj][0] = *(const f32x4*)xp; xf[m][bj][1] = *(const f32x4*)(xp + 4); }
                    asm volatile("" : "+v"(xf[0][0][0]), "+v"(xf[0][0][1]), "+v"(xf[0][1][0]), "+v"(xf[0][1][1]), "+v"(xf[1][0][0]), "+v"(xf[1][0][1]), "+v"(xf[1][1][0]), "+v"(xf[1][1][1]));
#pragma unroll
                    for (int m = 0; m < 2; ++m) { float ssq = 0.f;
#pragma unroll
                        for (int bj = 0; bj < 2; ++bj) EOP_ROW(xf[m][bj][0], xf[m][bj][1], ai, (2 * mh + m), bj);
                        EOP_PSQ(ai, (2 * mh + m)); } }
        }
#undef EOP_ROW
#undef EOP_PSQ
    }
};
__device__ __forceinline__ unsigned pk4_fp8(float a, float b, float c, float d) { int r = __builtin_amdgcn_cvt_pk_fp8_f32(a, b, 0, false); r = __builtin_amdgcn_cvt_pk_fp8_f32(c, d, r, true); return (unsigned)r; }
__device__ __forceinline__ f32x4 up4_fp8(unsigned u) { const f32x2 a = __builtin_amdgcn_cvt_pk_f32_fp8((int)u, false), b = __builtin_amdgcn_cvt_pk_f32_fp8((int)u, true); return (f32x4){a[0], a[1], b[0], b[1]}; }
constexpr float W8_SCALE = 32.f, W8_INV = 1.f / 32.f;
struct EpiMoe1 {
    static constexpr bool PERM = true;
    unsigned char* HID;
    __device__ __forceinline__ void operator()(const f32x4 (&acc)[2][2][4][2], const pg8::Unit& u, int wr, int wc, int fr, int fq) const {
        const int row0 = u.pm * 256 + wr * 64 + fr, col0 = u.pn * 128 + wc * 32 + 8 * fq;
#pragma unroll
        for (int ai = 0; ai < 2; ++ai)
#pragma unroll
            for (int m = 0; m < 4; ++m) { f32x4 v0 = acc[ai][0][m][0] * W8_INV, v1 = acc[ai][0][m][1] * W8_INV; const f32x4 g0 = acc[ai][1][m][0] * W8_INV, g1 = acc[ai][1][m][1] * W8_INV;
                v0 = silu4(v0) * g0; v1 = silu4(v1) * g1;
                u32x2 w; w.x = pk4_fp8(v0[0], v0[1], v0[2], v0[3]); w.y = pk4_fp8(v1[0], v1[1], v1[2], v1[3]);
                EPI_ST((u32x2*)(HID + (size_t)(row0 + ai * 128 + m * 16) * 512 + col0), w); }
    }
};
struct EpiMoe2 {
    static constexpr bool PERM = true;
    unsigned char* YPAD;
    __device__ __forceinline__ void operator()(const f32x4 (&acc)[2][2][4][2], const pg8::Unit& u, int wr, int wc, int fr, int fq) const {
        const int row0 = u.pm * 256 + wr * 64 + fr, col0 = u.pn * 256 + wc * 32 + 8 * fq;
#pragma unroll
        for (int ai = 0; ai < 2; ++ai)
#pragma unroll
            for (int m = 0; m < 4; ++m)
#pragma unroll
                for (int bj = 0; bj < 2; ++bj) { const f32x4 v0 = acc[ai][bj][m][0] * W8_INV, v1 = acc[ai][bj][m][1] * W8_INV;
                    u32x2 w; w.x = pk4_fp8(v0[0], v0[1], v0[2], v0[3]); w.y = pk4_fp8(v1[0], v1[1], v1[2], v1[3]);
                    EPI_ST((u32x2*)(YPAD + (size_t)(row0 + ai * 128 + m * 16) * 1024 + col0 + bj * 128), w); }
    }
};

__device__ __forceinline__ bf16x8 tr_frag(LAS const unsigned char* img, int pitch, int k0, int x0, int lane) {
    LAS const unsigned char* p = img + (k0 + 8 * (lane >> 4) + ((lane & 15) >> 2)) * pitch + (x0 + 4 * (lane & 3)) * 2;
    const s16x4 a = __builtin_amdgcn_ds_read_tr16_b64_v4i16((LAS s16x4*)p), b = __builtin_amdgcn_ds_read_tr16_b64_v4i16((LAS s16x4*)(p + 4 * pitch));
    return (bf16x8){a[0], a[1], a[2], a[3], b[0], b[1], b[2], b[3]};
}
__device__ __forceinline__ bf16x8 tr_frag_p8(LAS const unsigned char* img, int pitch, int k0, int m, int lane) {
    LAS const unsigned char* p = img + (k0 + 8 * (lane >> 4) + ((lane & 15) >> 2)) * pitch + (32 * (m >> 1) + 8 * (lane & 3) + 4 * (m & 1)) * 2;
    const s16x4 a = __builtin_amdgcn_ds_read_tr16_b64_v4i16((LAS s16x4*)p), b = __builtin_amdgcn_ds_read_tr16_b64_v4i16((LAS s16x4*)(p + 4 * pitch));
    return (bf16x8){a[0], a[1], a[2], a[3], b[0], b[1], b[2], b[3]};
}
__device__ __forceinline__ int perm_p8(int m, int i) { return 32 * (m >> 1) + 8 * (i >> 2) + 4 * (m & 1) + (i & 3); }
__device__ __forceinline__ f32x4 mfma16(bf16x8 a, bf16x8 b, f32x4 c) { return __builtin_amdgcn_mfma_f32_16x16x32_bf16(a, b, c, 0, 0, 0); }
#define PIN4(x) asm volatile("" : "+v"((x)[0]), "+v"((x)[1]), "+v"((x)[2]), "+v"((x)[3]))
#define PIN8(x) asm volatile("" : "+v"((x)[0]), "+v"((x)[1]), "+v"((x)[2]), "+v"((x)[3]), "+v"((x)[4]), "+v"((x)[5]), "+v"((x)[6]), "+v"((x)[7]))
struct TrTile { const float* src; unsigned char* dst; int ldn, K, kind, k0, n0; };
__device__ __forceinline__ TrTile tr_desc(const FP& F, int l, int r) {
    TrTile t;
    if (r < 160) { t.src = F.w_in() + (size_t)l * 1024 * PIN; t.ldn = PIN; t.K = 1024; t.kind = 0; t.dst = (unsigned char*)(F.WIN() + (size_t)l * NIN * 1024); t.k0 = (r / 10) * 64; t.n0 = (r % 10) * 256; }
    else if (r < 224) { r -= 160; t.src = F.w_out() + (size_t)l * 1024 * 1024; t.ldn = 1024; t.K = 1024; t.kind = 0; t.dst = (unsigned char*)(F.WOUT() + (size_t)l * 1024 * 1024); t.k0 = (r / 4) * 64; t.n0 = (r % 4) * 256; }
    else if (r < 1248) { r -= 224; const int e = r >> 5; r &= 31; t.src = F.w1() + ((size_t)l * 32 + e) * 1024 * 512; t.ldn = 512; t.K = 1024; t.kind = 1; t.dst = F.W13B() + ((size_t)l * 32 + e) * 1024 * 1024; t.k0 = (r >> 1) * 64; t.n0 = (r & 1) * 256; }
    else if (r < 2272) { r -= 1248; const int e = r >> 5; r &= 31; t.src = F.w3() + ((size_t)l * 32 + e) * 1024 * 512; t.ldn = 512; t.K = 1024; t.kind = 2; t.dst = F.W13B() + ((size_t)l * 32 + e) * 1024 * 1024; t.k0 = (r >> 1) * 64; t.n0 = (r & 1) * 256; }
    else { r -= 2272; const int e = r >> 5; r &= 31; t.src = F.w2() + ((size_t)l * 32 + e) * 512 * 1024; t.ldn = 1024; t.K = 512; t.kind = 3; t.dst = F.W2B() + ((size_t)l * 32 + e) * 1024 * 512; t.k0 = (r >> 2) * 64; t.n0 = (r & 3) * 256; }
    return t;
}
__device__ __forceinline__ void tr_load(const TrTile& t, f32x4 (&v)[8], int tid) {
    if (t.kind == 0) { const int kp = tid >> 4, nq = (tid & 15) * 4;
#pragma unroll
        for (int i = 0; i < 4; ++i) { const float* p = t.src + (size_t)(t.k0 + 2 * kp) * t.ldn + t.n0 + nq + 64 * i; v[i] = *(const f32x4*)p; v[4 + i] = *(const f32x4*)(p + t.ldn); } }
    else { const int kq = tid >> 5, nq = (tid & 31) * 4;
#pragma unroll
        for (int i = 0; i < 2; ++i)
#pragma unroll
            for (int rr = 0; rr < 4; ++rr) v[4 * i + rr] = *(const f32x4*)(t.src + (size_t)(t.k0 + 4 * kq + rr) * t.ldn + t.n0 + nq + 128 * i); }
}
__device__ __forceinline__ void convert_pull(const FP& F0, int l, int quota) {
    const FP F = F0.fresh();
    int tid_ = F.tid(); asm volatile("" : "+v"(tid_)); const int tid = tid_; volatile LAS int* qw = (volatile LAS int*)(F.lds + L_QW);
    LAS unsigned* sT = (LAS unsigned*)(F.lds + SCR_OFF);
    __syncthreads();
    if (tid == 0) qw[0] = quota > 0 ? __hip_atomic_fetch_add(F.QH() + l * 64, 1, __ATOMIC_RELAXED, __HIP_MEMORY_SCOPE_AGENT) : 3296;
    __syncthreads();
    int r = qw[0]; f32x4 v[8]; TrTile cur;
    if (r < 3296) { cur = tr_desc(F, l, r); tr_load(cur, v, tid); }
    for (int n = 1; r < 3296; ++n) {
        if (tid == 0) qw[1] = n < quota ? __hip_atomic_fetch_add(F.QH() + l * 64, 1, __ATOMIC_RELAXED, __HIP_MEMORY_SCOPE_AGENT) : 3296;
        if (cur.kind == 0) { const int kp = tid >> 4, nq = (tid & 15) * 4;
#pragma unroll
            for (int i = 0; i < 4; ++i)
#pragma unroll
                for (int j = 0; j < 4; ++j) sT[(nq + 64 * i + j) * 33 + kp] = pk2(v[i][j], v[4 + i][j]); }
        else { const int kq = tid >> 5, nq = (tid & 31) * 4;
#pragma unroll
            for (int i = 0; i < 2; ++i)
#pragma unroll
                for (int j = 0; j < 4; ++j) sT[(nq + 128 * i + j) * 17 + kq] = pk4_fp8(v[4 * i][j] * W8_SCALE, v[4 * i + 1][j] * W8_SCALE, v[4 * i + 2][j] * W8_SCALE, v[4 * i + 3][j] * W8_SCALE); }
        LDS_BAR();
        const int rn = qw[1]; const TrTile t = cur;
        if (rn < 3296) { cur = tr_desc(F, l, rn); tr_load(cur, v, tid); }
        if (t.kind == 0) {
#pragma unroll
            for (int i = 0; i < 4; ++i) { const int id = tid + 512 * i, nl = id >> 3, kc = id & 7;
                u32x4 w; w.x = sT[nl * 33 + kc * 4]; w.y = sT[nl * 33 + kc * 4 + 1]; w.z = sT[nl * 33 + kc * 4 + 2]; w.w = sT[nl * 33 + kc * 4 + 3];
                *(u32x4*)(t.dst + ((size_t)(t.n0 + nl) * t.K + t.k0 + kc * 8) * 2) = w; } }
        else {
#pragma unroll
            for (int i = 0; i < 2; ++i) { const int id = tid + 512 * i, nl = id >> 2, kc = id & 3; const int nn = t.n0 + nl;
                const int drow = t.kind == 3 ? nn : ((nn >> 7) * 256 + (nn & 127) + (t.kind == 2 ? 128 : 0));
                u32x4 w; w.x = sT[nl * 17 + kc * 4]; w.y = sT[nl * 17 + kc * 4 + 1]; w.z = sT[nl * 17 + kc * 4 + 2]; w.w = sT[nl * 17 + kc * 4 + 3];
                *(u32x4*)(t.dst + (size_t)drow * t.K + t.k0 + kc * 16) = w; } }
        LDS_BAR();
        r = rn;
    }
    __syncthreads();
}
__device__ __forceinline__ void p0_mod(const FP& F0) {
    const FP F = F0.fresh();
    int tid_ = F.tid(); asm volatile("" : "+v"(tid_)); const int tid = tid_; LAS float* sC = (LAS float*)(F.lds + SCR_OFF); LAS float* sR = sC + 8192;
    for (int j = tid; j < 8192; j += 512) sC[j] = silu_f(F.c()[j]);
    __syncthreads();
    const int cg = tid & 31, ks = tid >> 5;
    for (int it = blockIdx.x; it < 192; it += gridDim.x) {
        const int l = it / 48, j0 = (it % 48) * 128 + cg * 4; const float* wp = F.w_ada() + ((size_t)l * 1024 + ks * 64) * 6144 + j0;
        f32x4 acc[8];
#pragma unroll
        for (int b = 0; b < 8; ++b) acc[b] = (f32x4){0.f, 0.f, 0.f, 0.f};
#pragma unroll 4
        for (int k = 0; k < 64; ++k) { const f32x4 w = *(const f32x4*)(wp + (size_t)k * 6144);
#pragma unroll
            for (int b = 0; b < 8; ++b) acc[b] += w * sC[b * 1024 + ks * 64 + k]; }
#pragma unroll
        for (int b = 0; b < 8; ++b) *(LAS f32x4*)(sR + (ks * 8 + b) * 128 + cg * 4) = acc[b];
        __syncthreads();
        for (int o = tid; o < 1024; o += 512) { const int b = o >> 7, j = o & 127; float s = F.b_ada()[l * 6144 + (it % 48) * 128 + j];
#pragma unroll
            for (int q = 0; q < 16; ++q) s += sR[(q * 8 + b) * 128 + j];
            F.MOD()[((size_t)l * 8 + b) * 6144 + (it % 48) * 128 + j] = s; }
        __syncthreads();
    }
}
__device__ __forceinline__ void p0_small(const FP& F0) {
    const FP F = F0.fresh();
    int tid_ = F.tid(); asm volatile("" : "+v"(tid_));
    const size_t gsz = (size_t)gridDim.x * 512, g0 = (size_t)blockIdx.x * 512 + tid_;
    for (size_t i = g0; i < (size_t)4 * 256 * 1024; i += gsz) { const int l = (int)(i >> 18), n = (int)((i >> 10) & 255), k = (int)(i & 1023);
        const float* wl = F.w_in() + ((size_t)l * 1024 + k) * PIN + 2560; const float* wa = F.bwa() + (size_t)l * 16 * 256 + n; float s = 0.f;
#pragma unroll
        for (int r = 0; r < 16; ++r) s += wl[r] * wa[r * 256];
        F.WIN()[((size_t)l * NIN + 2560 + n) * 1024 + k] = (bf16_t)(pk2(s, 0.f) & 0xffffu); }
    for (size_t i = g0; i < (size_t)4 * 4 * 128 * 128; i += gsz) { const int t = (int)((i >> 7) & 127), s = (int)(i & 127); F.WSB()[i] = (bf16_t)(pk2(s <= t ? F.aws()[i] : 0.f, 0.f) & 0xffffu); }
    for (size_t i = g0; i < (size_t)4 * 48 * 1024; i += gsz) { const int l = (int)(i / (48 * 1024)), n = (int)((i >> 10) % 48), k = (int)(i & 1023);
        const float v = n < 4 ? F.w_group()[((size_t)l * 1024 + k) * 4 + n] : (n < 36 ? F.w_router()[((size_t)l * 1024 + k) * 32 + (n - 4)] : 0.f);
        F.WR()[i] = (bf16_t)(pk2(v, 0.f) & 0xffffu); }
}

__device__ __forceinline__ void moe_tables(const FP& F0, int l) {
    const FP F = F0.fresh();
    LAS int* blk = (LAS int*)(F.lds + L_BLK); LAS int* cnt = (LAS int*)(F.lds + L_CNT); LAS int* nb = (LAS int*)(F.lds + L_NB);
    __syncthreads();
    const int tx = F.tid();
    if (tx < 32) cnt[tx] = __hip_atomic_load(F.CNT() + l * 32 + tx, __ATOMIC_RELAXED, __HIP_MEMORY_SCOPE_AGENT);
    __syncthreads();
    if (tx == 0) { int s = 0; for (int e = 0; e < 32; ++e) { blk[e] = s; s += (cnt[e] + 255) >> 8; } blk[32] = s; nb[0] = s; }
    __syncthreads();
}

struct P1Row { u32x2 xb[4]; unsigned ya[4], yc[4]; float w0, w1; };
__device__ __forceinline__ void p1_issue(const FP& F, P1Row& R, const i32x4& r0, const i32x4& r1, const LAS int* blk, int t, int lane) {
    R.w0 = __int_as_float(r0[2]); R.w1 = __int_as_float(r1[1]);
    const unsigned char* y0 = F.YPAD() + ((size_t)blk[r0[0]] * 256 + r0[1]) * 1024; const unsigned char* y1 = F.YPAD() + ((size_t)blk[r0[3]] * 256 + r1[0]) * 1024;
#pragma unroll
    for (int j = 0; j < 4; ++j) { R.xb[j] = *(const u32x2*)(F.XB() + (size_t)t * D + lane * 4 + 256 * j); R.ya[j] = *(const unsigned*)(y0 + lane * 4 + 256 * j); R.yc[j] = *(const unsigned*)(y1 + lane * 4 + 256 * j); }
}
__device__ __forceinline__ void p1_finish(const FP& F, int l, int t, int lane, f32x4 (&x)[4], const f32x4 (&gv)[4], const f32x4 (&sv)[4]) {
    float ss = 0.f;
#pragma unroll
    for (int j = 0; j < 4; ++j) ss += x[j][0] * x[j][0] + x[j][1] * x[j][1] + x[j][2] * x[j][2] + x[j][3] * x[j][3];
#pragma unroll
    for (int o = 32; o >= 1; o >>= 1) ss += __shfl_xor(ss, o);
    const float rstd = frsq(ss * (1.f / D) + EPS);
    if (l < NL) {
        f32x4 hv[4]; float am = 0.f;
#pragma unroll
        for (int j = 0; j < 4; ++j) { hv[j] = x[j] * rstd * gv[j] + sv[j]; am = fmaxf(fmaxf(am, fmaxf(fabsf(hv[j][0]), fabsf(hv[j][1]))), fmaxf(fabsf(hv[j][2]), fabsf(hv[j][3]))); }
#pragma unroll
        for (int o = 32; o >= 1; o >>= 1) am = fmaxf(am, __shfl_xor(am, o));
        const float inv = am > 0.f ? 127.f / am : 0.f;
#pragma unroll
        for (int j = 0; j < 4; ++j) { const f32x4 q = hv[j] * inv + 12582912.f;
            const unsigned o = (__float_as_uint(q[0]) & 0xffu) | ((__float_as_uint(q[1]) & 0xffu) << 8) | ((__float_as_uint(q[2]) & 0xffu) << 16) | (__float_as_uint(q[3]) << 24);
            THIN_ST((unsigned*)(F.H8I() + (size_t)t * D + lane * 4 + 256 * j), o); }
        if (lane == 0) F.HS()[(size_t)t * 8] = am * (1.f / 127.f);
    } else {
#pragma unroll
        for (int j = 0; j < 4; ++j) { const f32x4 hv = x[j] * rstd * gv[j] + sv[j]; THIN_ST((f32x4*)(F.xcur() + (size_t)t * D + lane * 4 + 256 * j), hv); }
    }
}
__device__ __forceinline__ void win_requant(const FP& F, int l, int w, int lane) {
    for (int r = blockIdx.x * 8 + w; r < NIN; r += gridDim.x * 8) {
        const bf16_t* src = F.WIN() + ((size_t)l * NIN + r) * 1024 + lane * 16;
        const u32x4 a = *(const u32x4*)src, b = *(const u32x4*)(src + 8);
        float v[16];
#pragma unroll
        for (int i = 0; i < 4; ++i) { v[2 * i] = bflo(a[i]); v[2 * i + 1] = bfhi(a[i]); v[8 + 2 * i] = bflo(b[i]); v[8 + 2 * i + 1] = bfhi(b[i]); }
        float am = 0.f;
#pragma unroll
        for (int i = 0; i < 16; ++i) am = fmaxf(am, fabsf(v[i]));
#pragma unroll
        for (int o = 32; o >= 1; o >>= 1) am = fmaxf(am, __shfl_xor(am, o));
        const float inv = am > 0.f ? 127.f / am : 0.f;
        u32x4 o;
#pragma unroll
        for (int i = 0; i < 4; ++i) { unsigned q[4];
#pragma unroll
            for (int e = 0; e < 4; ++e) q[e] = __float_as_uint(v[4 * i + e] * inv + 12582912.f);
            o[i] = (q[0] & 0xffu) | ((q[1] & 0xffu) << 8) | ((q[2] & 0xffu) << 16) | (q[3] << 24); }
        *(u32x4*)(F.WQ() + ((size_t)l * NIN + r) * 1024 + lane * 16) = o;
        if (lane == 0) F.WQS()[l * NIN + r] = am * (1.f / 127.f);
    }
}
__device__ __forceinline__ void p1_rows(const FP& F0, int l) {
    const FP F = F0.fresh();
    int tid_ = F.tid(); asm volatile("" : "+v"(tid_)); const int tid = tid_, w = tid >> 6, lane = tid & 63; const LAS int* blk = (const LAS int*)(F.lds + L_BLK);
    if (l < NL) win_requant(F, l, w, lane);
    for (int u = blockIdx.x; u < 256; u += gridDim.x) {
        const int b = u >> 5, tok0 = u * 128 + w * 16;
        f32x4 gv[4], sv[4], g2v[4];
#pragma unroll
        for (int j = 0; j < 4; ++j) { const int col = lane * 4 + 256 * j;
            if (l < NL) { const float* m = F.MOD() + ((size_t)l * 8 + b) * 6144; const f32x4 g = *(const f32x4*)(F.n1g() + l * 1024 + col), sc = *(const f32x4*)(m + 1024 + col); gv[j] = g * (sc + 1.0f); sv[j] = *(const f32x4*)(m + col); }
            else { gv[j] = *(const f32x4*)(F.fgain() + col); sv[j] = (f32x4){0.f, 0.f, 0.f, 0.f}; }
            g2v[j] = l > 0 ? *(const f32x4*)(F.MOD() + ((size_t)(l - 1) * 8 + b) * 6144 + 5120 + col) : (f32x4){0.f, 0.f, 0.f, 0.f}; }
        if (l == 0) {
            f32x4 xn[4];
#pragma unroll
            for (int j = 0; j < 4; ++j) xn[j] = *(const f32x4*)(F.x_in() + (size_t)tok0 * D + lane * 4 + 256 * j);
#pragma unroll 1
            for (int i = 0; i < 16; ++i) { f32x4 x[4];
#pragma unroll
                for (int j = 0; j < 4; ++j) x[j] = xn[j];
                if (i < 15) {
#pragma unroll
                    for (int j = 0; j < 4; ++j) xn[j] = *(const f32x4*)(F.x_in() + (size_t)(tok0 + i + 1) * D + lane * 4 + 256 * j); }
                p1_finish(F, l, tok0 + i, lane, x, gv, sv); }
        } else {
            i32x4 ra = *(const i32x4*)(F.ROUTE() + (size_t)tok0 * 8), rb = *(const i32x4*)(F.ROUTE() + (size_t)tok0 * 8 + 4);
            P1Row nx; p1_issue(F, nx, ra, rb, blk, tok0, lane);
            ra = *(const i32x4*)(F.ROUTE() + (size_t)(tok0 + 1) * 8); rb = *(const i32x4*)(F.ROUTE() + (size_t)(tok0 + 1) * 8 + 4);
#pragma unroll 1
            for (int i = 0; i < 16; ++i) { const int t = tok0 + i; const P1Row cu = nx;
                if (i < 15) { p1_issue(F, nx, ra, rb, blk, t + 1, lane);
                    if (i < 14) { ra = *(const i32x4*)(F.ROUTE() + (size_t)(t + 2) * 8); rb = *(const i32x4*)(F.ROUTE() + (size_t)(t + 2) * 8 + 4); } }
                f32x4 x[4];
#pragma unroll
                for (int j = 0; j < 4; ++j) { const u32x2 xv = cu.xb[j]; const f32x4 a = up4_fp8(cu.ya[j]), c = up4_fp8(cu.yc[j]);
                    const f32x4 m = a * cu.w0 + c * cu.w1;
                    x[j] = (f32x4){bflo(xv[0]), bfhi(xv[0]), bflo(xv[1]), bfhi(xv[1])} + g2v[j] * m;
                    if (l < NL) { u32x2 xo; xo[0] = pk2(x[j][0], x[j][1]); xo[1] = pk2(x[j][2], x[j][3]); THIN_ST((u32x2*)(F.XB() + (size_t)t * D + lane * 4 + 256 * j), xo); } }
                p1_finish(F, l, t, lane, x, gv, sv); }
        }
    }
}

struct ChunkRegs { u32x4 v[4]; f32x2 g[8]; unsigned q[8], k[8]; };
template <bool WITH_Q> __device__ __forceinline__ void chunk_load(const FP& F, ChunkRegs& R, int tok0, int h, int tid) {
    const int kp = tid & 31, seg = tid >> 5;
#pragma unroll
    for (int i = 0; i < 4; ++i) { const int id = tid + 512 * i, row = id >> 4, ch = id & 15; R.v[i] = *(const u32x4*)(F.PROJ() + (size_t)(tok0 + row) * NPJ + 1536 + h * 128 + ch * 8); }
#pragma unroll
    for (int i = 0; i < 8; ++i) { const size_t t = (size_t)(tok0 + seg * 8 + i); { const unsigned gg = *(const unsigned*)(F.GATE() + t * 256 + h * 64 + 2 * kp); R.g[i] = (f32x2){bflo(gg), bfhi(gg)}; } const bf16_t* pr = F.PROJ() + t * NPJ + h * 64 + 2 * kp; R.k[i] = *(const unsigned*)(pr + 1280); if (WITH_Q) R.q[i] = *(const unsigned*)(pr + 1024); }
}
struct ChunkPre { u32x4 v[4]; f32x2 g[8]; };
__device__ __forceinline__ void chunk_pre(const FP& F, ChunkPre& R, int tok0, int h, int tid) {
    const int kp = tid & 31, seg = tid >> 5;
#pragma unroll
    for (int i = 0; i < 4; ++i) { const int id = tid + 512 * i, row = id >> 4, ch = id & 15; R.v[i] = *(const u32x4*)(F.PROJ() + (size_t)(tok0 + row) * NPJ + 1536 + h * 128 + ch * 8); }
#pragma unroll
    for (int i = 0; i < 8; ++i) { const unsigned gg = *(const unsigned*)(F.GATE() + (size_t)(tok0 + seg * 8 + i) * 256 + h * 64 + 2 * kp); R.g[i] = (f32x2){bflo(gg), bfhi(gg)}; }
}
__device__ __forceinline__ void chunk_cumsum(LAS float* sSeg, f32x2 (&g)[8], f32x2& pre, f32x2& tot, f32x2& ref, int tid) {
    const int kp = tid & 31, seg = tid >> 5;
#pragma unroll
    for (int i = 1; i < 8; ++i) g[i] += g[i - 1];
    *(LAS f32x2*)(sSeg + seg * 64 + 2 * kp) = g[7];
    LDS_BAR();
    pre = (f32x2){0.f, 0.f}; tot = pre; ref = pre;
#pragma unroll
    for (int s = 0; s < 16; ++s) { const f32x2 v = *(const LAS f32x2*)(sSeg + s * 64 + 2 * kp); tot += v; if (s < seg) pre += v; if (s < 8) ref += v; }
}

__device__ __forceinline__ void p3_agg_sgu(const FP& F0, int l) {
    const FP F = F0.fresh();
    int tid_ = F.tid(); asm volatile("" : "+v"(tid_)); const int tid = tid_, w = tid >> 6, lane = tid & 63; LAS unsigned char* sc = F.lds + SCR_OFF;
    LAS unsigned char* sV = sc; LAS unsigned char* sK = sc + 36864; LAS float* sSeg = (LAS float*)(sc + 57344); LAS float* sDec = sSeg + 1024;
    LAS unsigned char* sVn = sc + 61696; LAS float* sRstd = (LAS float*)(sc + 98560);
    LAS float* sAvg = (LAS float*)(sc + 99072); LAS float* sBs = (LAS float*)(sc + 101120);
    { const float ga = F.avg()[l * 512 + tid], gb = F.abs_()[l * 512 + tid]; sAvg[tid] = ga; sBs[tid] = gb; }
    const int tt = 16 * w + (lane & 15);
    for (int unit = blockIdx.x; unit < 256; unit += gridDim.x) {
        const int bh = unit >> 3, j = unit & 7, b = bh >> 2, h = bh & 3, tokb = b * SEQ + j * 512, tok0 = unit * 128;
        f32x4 acc[4]; f32x2 bsum = (f32x2){0.f, 0.f};
#pragma unroll
        for (int n = 0; n < 4; ++n) acc[n] = (f32x4){0.f, 0.f, 0.f, 0.f};
        ChunkPre nx; chunk_pre(F, nx, tokb, h, tid);
        unsigned nk[8];
        { const int kp = tid & 31, seg = tid >> 5;
#pragma unroll
          for (int i = 0; i < 8; ++i) nk[i] = *(const unsigned*)(F.PROJ() + (size_t)(tokb + seg * 8 + i) * NPJ + 1280 + h * 64 + 2 * kp); }
        u32x4 vc[4];
#pragma unroll
        for (int i = 0; i < 4; ++i) { const int id = tid + 512 * i, row = id >> 4, ch = id & 15; vc[i] = *(const u32x4*)(F.PROJ() + (size_t)(tok0 + row) * NPJ + 512 + ch * 8); }
        if (tid < 128) { const f32x4 p0 = *(const f32x4*)(F.AVSQ() + (size_t)(tok0 + tid) * 8), p1 = *(const f32x4*)(F.AVSQ() + (size_t)(tok0 + tid) * 8 + 4);
            sRstd[tid] = frsq((((p0[0] + p0[1]) + (p0[2] + p0[3])) + ((p1[0] + p1[1]) + (p1[2] + p1[3]))) * (1.f / 512.f) + EPS); }
        LDS_BAR();
#pragma unroll 1
        for (int it = 0; it < 4; ++it) {
            ChunkRegs cu;
#pragma unroll
            for (int i = 0; i < 4; ++i) cu.v[i] = nx.v[i];
#pragma unroll
            for (int i = 0; i < 8; ++i) cu.g[i] = nx.g[i];
#pragma unroll
            for (int i = 0; i < 8; ++i) cu.k[i] = nk[i];
            if (it < 3) chunk_pre(F, nx, tokb + (it + 1) * 128, h, tid);
            const bf16_t* wrow = F.WSB() + ((size_t)(l * 4 + it) * 128 + tt) * 128 + 8 * (lane >> 4);
            u32x4 au[4];
#pragma unroll
            for (int a = 0; a < 4; ++a) au[a] = *(const u32x4*)(F.PROJ() + (size_t)(tok0 + tt) * NPJ + it * 128 + 32 * a + 8 * (lane >> 4));
            const float bs = sBs[it * 128 + tt];
#pragma unroll
            for (int i = 0; i < 4; ++i) { const int id = tid + 512 * i, row = id >> 4, ch = id & 15; *(LAS u32x4*)(sV + row * 288 + ch * 16) = cu.v[i]; }
#pragma unroll
            for (int i = 0; i < 4; ++i) { const int id = tid + 512 * i, row = id >> 4, ch = id & 15; const u32x4 v = vc[i]; const float rs = sRstd[row];
                const f32x4 g0 = *(const LAS f32x4*)(sAvg + it * 128 + ch * 8), g1 = *(const LAS f32x4*)(sAvg + it * 128 + ch * 8 + 4);
                u32x4 o; o[0] = pk2(bflo(v[0]) * rs * g0[0], bfhi(v[0]) * rs * g0[1]); o[1] = pk2(bflo(v[1]) * rs * g0[2], bfhi(v[1]) * rs * g0[3]);
                o[2] = pk2(bflo(v[2]) * rs * g1[0], bfhi(v[2]) * rs * g1[1]); o[3] = pk2(bflo(v[3]) * rs * g1[2], bfhi(v[3]) * rs * g1[3]);
                *(LAS u32x4*)(sVn + row * 288 + ch * 16) = o; }
            if (it < 3) {
#pragma unroll
                for (int i = 0; i < 4; ++i) { const int id = tid + 512 * i, row = id >> 4, ch = id & 15; vc[i] = *(const u32x4*)(F.PROJ() + (size_t)(tok0 + row) * NPJ + 512 + (it + 1) * 128 + ch * 8); } }
            f32x2 pre, tot, ref; chunk_cumsum(sSeg, cu.g, pre, tot, ref, tid);
            bf16x8 wf[4];
#pragma unroll
            for (int ks = 0; ks < 4; ++ks) wf[ks] = *(const bf16x8*)(wrow + 32 * ks);
            { const int kp = tid & 31, seg = tid >> 5;
#pragma unroll
              for (int i = 0; i < 8; ++i) { const int t = seg * 8 + i; const f32x2 bc = pre + cu.g[i];
                  *(LAS unsigned*)(sK + t * 160 + kp * 4) = pk2(bflo(cu.k[i]) * fexp(tot[0] - bc[0]), bfhi(cu.k[i]) * fexp(tot[1] - bc[1])); }
              if (seg == 0) *(LAS f32x2*)(sDec + 2 * kp) = (f32x2){fexp(tot[0]), fexp(tot[1])};
              if (it < 3) {
#pragma unroll
                  for (int i = 0; i < 8; ++i) nk[i] = *(const unsigned*)(F.PROJ() + (size_t)(tokb + (it + 1) * 128 + seg * 8 + i) * NPJ + 1280 + h * 64 + 2 * kp); } }
            bsum += tot;
            { f32x4 z[8];
#pragma unroll
              for (int m = 0; m < 8; ++m) z[m] = (f32x4){0.f, 0.f, 0.f, 0.f};
#pragma unroll
              for (int ks = 0; ks < 4; ++ks) if (32 * ks <= 16 * w + 15) {
#pragma unroll
                  for (int hf = 0; hf < 2; ++hf) { bf16x8 vf[4];
#pragma unroll
                      for (int m = 0; m < 4; ++m) vf[m] = tr_frag_p8(sVn, 288, 32 * ks, 4 * hf + m, lane);
                      PIN4(vf);
#pragma unroll
                      for (int m = 0; m < 4; ++m) z[4 * hf + m] = mfma16(vf[m], wf[ks], z[4 * hf + m]); } }
#pragma unroll
              for (int a = 0; a < 4; ++a) { const int col = it * 128 + 32 * a + 8 * (lane >> 4);
                  u32x4 o; o[0] = pk2(bflo(au[a][0]) * (z[2 * a][0] + bs), bfhi(au[a][0]) * (z[2 * a][1] + bs)); o[1] = pk2(bflo(au[a][1]) * (z[2 * a][2] + bs), bfhi(au[a][1]) * (z[2 * a][3] + bs));
                  o[2] = pk2(bflo(au[a][2]) * (z[2 * a + 1][0] + bs), bfhi(au[a][2]) * (z[2 * a + 1][1] + bs)); o[3] = pk2(bflo(au[a][3]) * (z[2 * a + 1][2] + bs), bfhi(au[a][3]) * (z[2 * a + 1][3] + bs));
                  THIN_ST((u32x4*)(F.Y() + (size_t)(tok0 + tt) * D + col), o); } }
            LDS_BAR();
#pragma unroll
            for (int n = 0; n < 4; ++n) acc[n] = acc[n] * sDec[16 * n + (lane & 15)];
#pragma unroll
            for (int ks = 0; ks < 4; ++ks) { bf16x8 a = tr_frag(sV, 288, 32 * ks, 16 * w, lane), kb[4];
#pragma unroll
                for (int n = 0; n < 4; ++n) kb[n] = tr_frag(sK, 160, 32 * ks, 16 * n, lane);
                asm volatile("" : "+v"(a), "+v"(kb[0]), "+v"(kb[1]), "+v"(kb[2]), "+v"(kb[3]));
#pragma unroll
                for (int n = 0; n < 4; ++n) acc[n] = mfma16(a, kb[n], acc[n]); }
            LDS_BAR();
        }
        float* kv = F.KV() + (size_t)unit * 8192 + (16 * w + 4 * (lane >> 4)) * 64 + (lane & 15);
#pragma unroll
        for (int n = 0; n < 4; ++n)
#pragma unroll
            for (int r = 0; r < 4; ++r) kv[r * 64 + 16 * n] = acc[n][r];
        if (tid < 32) *(f32x2*)(F.DEC() + (size_t)unit * 64 + 2 * tid) = (f32x2){fexp(bsum[0]), fexp(bsum[1])};
    }
}

__device__ __forceinline__ void p5_gla_seq(const FP& F0, int l) {
    const FP F = F0.fresh();
    int tid_ = F.tid(); asm volatile("" : "+v"(tid_)); const int tid = tid_, w = tid >> 6, lane = tid & 63, fr = lane & 15, fg = lane >> 4; LAS unsigned char* sc = F.lds + SCR_OFF;
    LAS unsigned char* sV = sc; LAS unsigned char* sQ = sc + 36864; LAS unsigned char* sKt = sc + 55296; LAS unsigned char* sS = sc + 73728; LAS unsigned char* sP = sc + 92160;
    LAS float* sSeg = (LAS float*)(sc + 126976);
    LAS float* sBog = (LAS float*)(sc + 131072);
    const int tt = 16 * w + fr;
    for (int unit = blockIdx.x; unit < 256; unit += gridDim.x) {
        const int bh = unit >> 3, j = unit & 7, b = bh >> 2, h = bh & 3, tokb = b * SEQ + j * 512;
        const float bgv = F.bog()[l * 512 + h * 128 + (tid & 127)];
        ChunkPre nx; chunk_pre(F, nx, tokb, h, tid);
        f32x4 st[4];
#pragma unroll
        for (int n = 0; n < 4; ++n) st[n] = (f32x4){0.f, 0.f, 0.f, 0.f};
#pragma unroll 1
        for (int i0 = 0; i0 < j; i0 += 4) {
            f32x4 kq[4][4], dq[4];
#pragma unroll
            for (int u = 0; u < 4; ++u) { const int ui = bh * 8 + (i0 + u < j ? i0 + u : i0); const float* kv = F.KV() + (size_t)ui * 8192 + (16 * w + 4 * fg) * 64 + fr;
#pragma unroll
                for (int n = 0; n < 4; ++n) { dq[u][n] = F.DEC()[ui * 64 + 16 * n + fr];
#pragma unroll
                    for (int r = 0; r < 4; ++r) kq[u][n][r] = kv[r * 64 + 16 * n]; } }
            asm volatile("" : "+v"(kq[0][0]), "+v"(kq[0][1]), "+v"(kq[0][2]), "+v"(kq[0][3]), "+v"(kq[1][0]), "+v"(kq[1][1]), "+v"(kq[1][2]), "+v"(kq[1][3]), "+v"(kq[2][0]), "+v"(kq[2][1]), "+v"(kq[2][2]), "+v"(kq[2][3]),
                              "+v"(kq[3][0]), "+v"(kq[3][1]), "+v"(kq[3][2]), "+v"(kq[3][3]), "+v"(dq[0]), "+v"(dq[1]), "+v"(dq[2]), "+v"(dq[3]));
#pragma unroll
            for (int u = 0; u < 4; ++u) if (i0 + u < j) {
#pragma unroll
                for (int n = 0; n < 4; ++n) st[n] = st[n] * dq[u][n] + kq[u][n]; } }
        if (tid < 128) sBog[tid] = bgv;
#pragma unroll 1
        for (int c = 0; c < 4; ++c) {
            const int tok0 = tokb + c * 128;
            ChunkRegs cu; u32x4 rr[4];
#pragma unroll
            for (int i = 0; i < 4; ++i) cu.v[i] = nx.v[i];
#pragma unroll
            for (int i = 0; i < 8; ++i) cu.g[i] = nx.g[i];
            { const int kp = tid & 31, seg = tid >> 5;
#pragma unroll
              for (int i = 0; i < 8; ++i) { const bf16_t* pr = F.PROJ() + (size_t)(tok0 + seg * 8 + i) * NPJ + h * 64 + 2 * kp; cu.k[i] = *(const unsigned*)(pr + 1280); cu.q[i] = *(const unsigned*)(pr + 1024); } }
            if (c < 3) chunk_pre(F, nx, tok0 + 128, h, tid);
#pragma unroll
            for (int a = 0; a < 4; ++a) rr[a] = *(const u32x4*)(F.PROJ() + (size_t)(tok0 + tt) * NPJ + 2048 + h * 128 + 32 * a + 8 * fg);
#pragma unroll
            for (int i = 0; i < 4; ++i) { const int id = tid + 512 * i, row = id >> 4, ch = id & 15; *(LAS u32x4*)(sV + row * 288 + ch * 16) = cu.v[i]; }
            f32x2 pre, tot, ref; chunk_cumsum(sSeg, cu.g, pre, tot, ref, tid);
            float escl[4];
#pragma unroll
            for (int n = 0; n < 4; ++n) { float t2 = 0.f, r2 = 0.f;
#pragma unroll
                for (int s = 0; s < 16; ++s) { const float v = sSeg[s * 64 + 16 * n + fr]; t2 += v; if (s < 8) r2 += v; }
                escl[n] = fexp(t2 - r2); st[n] = st[n] * fexp(r2);
#pragma unroll
                for (int r = 0; r < 4; ++r) *(LAS bf16_t*)(sS + (16 * w + 4 * fg + r) * 144 + (16 * n + fr) * 2) = (bf16_t)(pk2(st[n][r], 0.f) & 0xffffu); }
            { const int kp = tid & 31, seg = tid >> 5;
#pragma unroll
              for (int i = 0; i < 8; ++i) { const int t = seg * 8 + i; const f32x2 bc = pre + cu.g[i];
                  *(LAS unsigned*)(sQ + t * 144 + kp * 4) = pk2(bflo(cu.q[i]) * fexp(bc[0] - ref[0]), bfhi(cu.q[i]) * fexp(bc[1] - ref[1]));
                  *(LAS unsigned*)(sKt + t * 144 + kp * 4) = pk2(bflo(cu.k[i]) * fexp(ref[0] - bc[0]), bfhi(cu.k[i]) * fexp(ref[1] - bc[1])); } }
            LDS_BAR();
            const bf16x8 bq0 = *(const LAS bf16x8*)(sQ + tt * 144 + (8 * fg) * 2), bq1 = *(const LAS bf16x8*)(sQ + tt * 144 + (32 + 8 * fg) * 2);
#pragma unroll
            for (int g = 0; g < 2; ++g) if (4 * g <= (w | 1)) {
                bf16x8 kf[8];
#pragma unroll
                for (int q = 0; q < 4; ++q) { kf[2 * q] = *(const LAS bf16x8*)(sKt + (16 * (4 * g + q) + fr) * 144 + (8 * fg) * 2); kf[2 * q + 1] = *(const LAS bf16x8*)(sKt + (16 * (4 * g + q) + fr) * 144 + (32 + 8 * fg) * 2); }
                PIN8(kf);
#pragma unroll
                for (int q = 0; q < 4; ++q) { f32x4 a = mfma16(kf[2 * q], bq0, (f32x4){0.f, 0.f, 0.f, 0.f}); a = mfma16(kf[2 * q + 1], bq1, a);
                    const int s0 = 16 * (4 * g + q) + 4 * fg;
                    u32x2 o; o[0] = pk2(s0 <= tt ? a[0] : 0.f, s0 + 1 <= tt ? a[1] : 0.f); o[1] = pk2(s0 + 2 <= tt ? a[2] : 0.f, s0 + 3 <= tt ? a[3] : 0.f);
                    *(LAS u32x2*)(sP + tt * 272 + s0 * 2) = o; } }
            asm volatile("s_waitcnt lgkmcnt(0)" ::: "memory");
#pragma unroll 1
            for (int ks = 0; ks < 4; ++ks) { bf16x8 a = tr_frag(sV, 288, 32 * ks, 16 * w, lane), kb[4];
#pragma unroll
                for (int n = 0; n < 4; ++n) kb[n] = tr_frag(sKt, 144, 32 * ks, 16 * n, lane);
                asm volatile("" : "+v"(a), "+v"(kb[0]), "+v"(kb[1]), "+v"(kb[2]), "+v"(kb[3]));
#pragma unroll
                for (int n = 0; n < 4; ++n) st[n] = mfma16(a, kb[n], st[n]); }
#pragma unroll
            for (int n = 0; n < 4; ++n) st[n] = st[n] * escl[n];
            f32x4 acc[8];
#pragma unroll
            for (int m = 0; m < 8; ++m) acc[m] = (f32x4){0.f, 0.f, 0.f, 0.f};
#pragma unroll 1
            for (int ks = 0; ks < 4; ++ks) if (32 * ks <= 16 * w + 15) { bf16x8 bfr = *(const LAS bf16x8*)(sP + tt * 272 + (32 * ks + 8 * fg) * 2), vf[8];
#pragma unroll
                for (int m = 0; m < 8; ++m) vf[m] = tr_frag_p8(sV, 288, 32 * ks, m, lane);
                PIN8(vf); asm volatile("" : "+v"(bfr));
#pragma unroll
                for (int m = 0; m < 8; ++m) acc[m] = mfma16(vf[m], bfr, acc[m]); }
#pragma unroll
            for (int hf = 0; hf < 2; ++hf) { bf16x8 sf[8];
#pragma unroll
                for (int q = 0; q < 4; ++q) { const int vr = perm_p8(4 * hf + q, fr); sf[2 * q] = *(const LAS bf16x8*)(sS + vr * 144 + (8 * fg) * 2); sf[2 * q + 1] = *(const LAS bf16x8*)(sS + vr * 144 + (32 + 8 * fg) * 2); }
                PIN8(sf);
#pragma unroll
                for (int q = 0; q < 4; ++q) { acc[4 * hf + q] = mfma16(sf[2 * q], bq0, acc[4 * hf + q]); acc[4 * hf + q] = mfma16(sf[2 * q + 1], bq1, acc[4 * hf + q]); } }
            float ss = 0.f;
#pragma unroll
            for (int m = 0; m < 8; ++m) ss += acc[m][0] * acc[m][0] + acc[m][1] * acc[m][1] + acc[m][2] * acc[m][2] + acc[m][3] * acc[m][3];
            ss += __shfl_xor(ss, 16); ss += __shfl_xor(ss, 32);
            const float rstd = frsq(ss * (1.f / 128.f) + EPS);
#pragma unroll
            for (int a = 0; a < 4; ++a) { const int col = h * 128 + 32 * a + 8 * fg; const f32x4 g0 = *(const LAS f32x4*)(sBog + 32 * a + 8 * fg), g1 = *(const LAS f32x4*)(sBog + 32 * a + 8 * fg + 4);
                u32x4 o; o[0] = pk2(acc[2 * a][0] * rstd * g0[0] * bflo(rr[a][0]), acc[2 * a][1] * rstd * g0[1] * bfhi(rr[a][0])); o[1] = pk2(acc[2 * a][2] * rstd * g0[2] * bflo(rr[a][1]), acc[2 * a][3] * rstd * g0[3] * bfhi(rr[a][1]));
                o[2] = pk2(acc[2 * a + 1][0] * rstd * g1[0] * bflo(rr[a][2]), acc[2 * a + 1][1] * rstd * g1[1] * bfhi(rr[a][2])); o[3] = pk2(acc[2 * a + 1][2] * rstd * g1[2] * bflo(rr[a][3]), acc[2 * a + 1][3] * rstd * g1[3] * bfhi(rr[a][3]));
                THIN_ST((u32x4*)(F.Y() + (size_t)(tok0 + tt) * D + 512 + col), o); }
            LDS_BAR();
        }
    }
}

__device__ __forceinline__ void p7_norm_route(const FP& F0, int l) {
    const FP F = F0.fresh();
    int tid_ = F.tid(); asm volatile("" : "+v"(tid_)); const int tid = tid_, w = tid >> 6, lane = tid & 63, fr = lane & 15, fq = lane >> 4; LAS unsigned char* sc = F.lds + SCR_OFF;
    LAS unsigned char* sW = sc; LAS float* sG = (LAS float*)(sc + 99072); LAS float* sS = (LAS float*)(sc + 103168); LAS float* sLog = (LAS float*)(sc + 107264);
    LAS int* sCnt = (LAS int*)(sc + 131840); LAS int* sBase = sCnt + 32;
    for (int u = blockIdx.x; u < 256; u += gridDim.x) {
        const int b = u >> 5, tok0 = u * 128; const float* m = F.MOD() + ((size_t)l * 8 + b) * 6144;
        u32x4 wreg[12];
#pragma unroll
        for (int i = 0; i < 12; ++i) { const int id = tid + 512 * i, row = id >> 7, ch = id & 127; wreg[i] = *(const u32x4*)(F.WR() + ((size_t)l * 48 + row) * 1024 + ch * 8); }
        float gvv[2], svv[2];
#pragma unroll
        for (int jj = 0; jj < 2; ++jj) { const int j = tid + 512 * jj; gvv[jj] = F.n2g()[l * 1024 + j] * (1.f + m[4096 + j]); svv[jj] = m[3072 + j]; }
        const int t = tok0 + 16 * w + fr; const bf16_t* xr = F.XB() + (size_t)t * D + 16 * fq; float ss = 0.f;
#pragma unroll
        for (int q = 0; q < 4; ++q) { const f32x4 v = *(const f32x4*)(F.PSQ() + (size_t)t * 16 + 4 * q); ss += (v[0] + v[1]) + (v[2] + v[3]); }
        const float rstd = frsq(ss * (1.f / D) + EPS);
#pragma unroll
        for (int i = 0; i < 12; ++i) { const int id = tid + 512 * i, row = id >> 7, ch = id & 127; *(LAS u32x4*)(sW + row * 2064 + ch * 16) = wreg[i]; }
#pragma unroll
        for (int jj = 0; jj < 2; ++jj) { sG[tid + 512 * jj] = gvv[jj]; sS[tid + 512 * jj] = svv[jj]; }
        if (tid < 32) sCnt[tid] = 0;
        __syncthreads();
        f32x4 acc[3];
#pragma unroll
        for (int n = 0; n < 3; ++n) acc[n] = (f32x4){0.f, 0.f, 0.f, 0.f};
#pragma unroll 2
        for (int kc = 0; kc < 16; ++kc) { const int k0 = 64 * kc + 16 * fq; unsigned pk[8]; u32x4 h8;
#pragma unroll
            for (int q = 0; q < 2; ++q) { const u32x4 xv = *(const u32x4*)(xr + 64 * kc + 8 * q);
#pragma unroll
                for (int hh = 0; hh < 2; ++hh) { const f32x4 v = (f32x4){bflo(xv[2 * hh]), bfhi(xv[2 * hh]), bflo(xv[2 * hh + 1]), bfhi(xv[2 * hh + 1])};
                    const f32x4 gg = *(const LAS f32x4*)(sG + k0 + 8 * q + 4 * hh), sh = *(const LAS f32x4*)(sS + k0 + 8 * q + 4 * hh);
                    const f32x4 hv = v * rstd * gg + sh; pk[4 * q + 2 * hh] = pk2(hv[0], hv[1]); pk[4 * q + 2 * hh + 1] = pk2(hv[2], hv[3]); h8[2 * q + hh] = pk4_fp8(hv[0], hv[1], hv[2], hv[3]); } }
            u32x4 o0 = {pk[0], pk[1], pk[2], pk[3]}, o1 = {pk[4], pk[5], pk[6], pk[7]};
            THIN_ST((u32x4*)(F.H8() + (size_t)t * D + k0), h8);
            const bf16x8 a0 = __builtin_bit_cast(bf16x8, o0), a1 = __builtin_bit_cast(bf16x8, o1);
#pragma unroll
            for (int n = 0; n < 3; ++n) { LAS const unsigned char* bp = sW + (n * 16 + fr) * 2064 + k0 * 2;
                acc[n] = mfma16(a0, *(const LAS bf16x8*)bp, acc[n]); acc[n] = mfma16(a1, *(const LAS bf16x8*)(bp + 16), acc[n]); } }
#pragma unroll
        for (int n = 0; n < 3; ++n)
#pragma unroll
            for (int r = 0; r < 4; ++r) sLog[(w * 16 + 4 * fq + r) * 48 + n * 16 + fr] = acc[n][r];
        __syncthreads();
        int e0 = 0, e1 = 0, ls0 = 0, ls1 = 0; float w0 = 0.f, w1 = 0.f; const int tr_ = tok0 + 16 * w + lane;
        if (lane < 16) {
            float lg[36];
#pragma unroll
            for (int j = 0; j < 36; ++j) lg[j] = sLog[(w * 16 + lane) * 48 + j];
            float gmax = -3.0e38f; int grp = 0;
#pragma unroll
            for (int j = 0; j < 4; ++j) { lg[j] += F.b_group()[l * 4 + j]; if (lg[j] > gmax) { gmax = lg[j]; grp = j; } }
            float den = 0.f;
#pragma unroll
            for (int j = 0; j < 4; ++j) den += fexp(lg[j] - gmax);
            const float pg = 1.f / den; float m0 = -3.0e38f, m1 = -3.0e38f; int i0 = 0, i1 = 0;
#pragma unroll
            for (int j = 0; j < 8; ++j) { float v = 0.f;
#pragma unroll
                for (int gq = 0; gq < 4; ++gq) if (grp == gq) v = lg[4 + gq * 8 + j];
                v += F.b_router()[l * 32 + grp * 8 + j];
                if (v > m0) { m1 = m0; i1 = i0; m0 = v; i0 = j; } else if (v > m1) { m1 = v; i1 = j; } }
            const float ex = fexp(m1 - m0); w0 = pg / (1.f + ex); w1 = pg * ex / (1.f + ex); e0 = grp * 8 + i0; e1 = grp * 8 + i1;
            ls0 = __hip_atomic_fetch_add(sCnt + e0, 1, __ATOMIC_RELAXED, __HIP_MEMORY_SCOPE_WORKGROUP); ls1 = __hip_atomic_fetch_add(sCnt + e1, 1, __ATOMIC_RELAXED, __HIP_MEMORY_SCOPE_WORKGROUP);
        }
        __syncthreads();
        if (tid < 32) { const int cc = sCnt[tid]; sBase[tid] = cc ? __hip_atomic_fetch_add(F.CNT() + l * 32 + tid, cc, __ATOMIC_RELAXED, __HIP_MEMORY_SCOPE_AGENT) : 0; }
        __syncthreads();
        if (lane < 16) { const int s0 = sBase[e0] + ls0, s1 = sBase[e1] + ls1;
            F.TOKOF()[(size_t)e0 * 32768 + s0] = tr_; F.TOKOF()[(size_t)e1 * 32768 + s1] = tr_;
            *(i32x4*)(F.ROUTE() + (size_t)tr_ * 8) = (i32x4){e0, s0, __float_as_int(w0), e1}; *(i32x4*)(F.ROUTE() + (size_t)tr_ * 8 + 4) = (i32x4){s1, __float_as_int(w1), 0, 0}; }
        __syncthreads();
    }
}
__global__ void __launch_bounds__(512, 2) mega_fwd(Params p) {
    extern __shared__ __attribute__((aligned(16))) unsigned char lds_raw[];
    const FP F{p, (LAS unsigned char*)lds_raw, 0, __builtin_amdgcn_readfirstlane((int)(threadIdx.x >> 6))};
    for (int i = F.tid(); i < SCR_OFF / 4; i += 512) ((LAS unsigned*)F.lds)[i] = 0u;
    __syncthreads();
    (void)xcd_barrier_post((unsigned*)(p.ws + WS_CTL), (volatile LAS unsigned*)F.lds, F.tid() == 0);
#define bar XcdBarrier{(unsigned*)(p.ws + WS_CTL), xb_xcc_id(), (volatile LAS unsigned*)F.lds}, F.tid() == 0
    const int G = gridDim.x, c = blockIdx.x;
    LAS unsigned char* stage = F.lds + SCR_OFF;
    const LAS int* blk = (const LAS int*)(F.lds + L_BLK); const LAS int* cnt = (const LAS int*)(F.lds + L_CNT); const LAS int* nbp = (const LAS int*)(F.lds + L_NB);
    constexpr int QUOTA_P2 = 8, QUOTA_P9 = 4;

    convert_pull(F, 0, 1 << 30); p0_mod(F); p0_small(F);
    xcd_barrier(bar);
    for (int l = 0; l < NL; ++l) {
        p1_rows(F, l);
        xcd_barrier(bar);
        {
            const FP Fq = F.fresh();
            DenseSched S; S.nM = T / 256; S.nN = NIN / 256; S.nwg = S.nM * S.nN; S.G = G; S.c = c; S.Kb = 1024; S.Bt = (const char*)(Fq.WQ() + (size_t)l * NIN * 1024);
            EpiInProj E{Fq.PROJ(), Fq.GATE(), Fq.bba() + l * 256, Fq.AVSQ(), Fq.HS(), Fq.WQS() + l * NIN};
            pg8::gemm_phase<2>(stage, (const char*)Fq.H8I(), 1024, S, E, Fq.wv);
            if (l + 1 < NL && c >= S.nwg % G && (S.nwg % G) != 0) convert_pull(F, l + 1, QUOTA_P2);
        }
        xcd_barrier(bar);
        p3_agg_sgu(F, l);
        xcd_barrier(bar);
        p5_gla_seq(F, l);
        xcd_barrier(bar);
        {
            const FP Fq = F.fresh();
            DenseSched S; S.nM = T / 256; S.nN = 4; S.nwg = S.nM * 4; S.G = G; S.c = c; S.Kb = 2048; S.Bt = (const char*)(Fq.WOUT() + (size_t)l * 1024 * 1024);
            EpiOutProj E{l == 0 ? Fq.x_in() : nullptr, Fq.XB(), Fq.XB(), Fq.MOD() + (size_t)l * 8 * 6144 + 2048, Fq.PSQ()};
            pg8::gemm_phase<0>(stage, (const char*)Fq.Y(), 2048, S, E, Fq.wv);
        }
        xcd_barrier(bar);
        p7_norm_route(F, l);
        xcd_barrier(bar);
        moe_tables(F, l);
        {
            const FP Fq = F.fresh();
            MoeSched<true> S; S.nunits = nbp[0] * 4; S.G = G; S.c = c; S.Kb = 1024; S.blk = blk; S.cnt = cnt; S.tokof = Fq.TOKOF();
            S.W = (const char*)(Fq.W13B() + (size_t)l * 32 * 1024 * 1024); S.estride = (size_t)1024 * 1024; S.tstride = (size_t)256 * 1024;
            EpiMoe1 E{Fq.HID()};
            pg8::gemm_phase<1>(stage, (const char*)Fq.H8(), 1024, S, E, Fq.wv);
            if (l + 1 < NL && c >= S.nunits % G && (S.nunits % G) != 0) convert_pull(F, l + 1, QUOTA_P9);
        }
        xcd_barrier(bar);
        {
            const FP Fq = F.fresh();
            MoeSched<false> S; S.nunits = nbp[0] * 4; S.G = G; S.c = c; S.Kb = 512; S.blk = blk; S.cnt = cnt; S.tokof = Fq.TOKOF();
            S.W = (const char*)(Fq.W2B() + (size_t)l * 32 * 1024 * 512); S.estride = (size_t)1024 * 512; S.tstride = (size_t)256 * 512;
            EpiMoe2 E{Fq.YPAD()};
            pg8::gemm_phase<1>(stage, (const char*)Fq.HID(), 512, S, E, Fq.wv);
            if (l + 1 < NL) convert_pull(F, l + 1, 1 << 30);
        }
        xcd_barrier(bar);
    }
    p1_rows(F, NL);
}

extern "C" void kernel_launch(void* const* d_in, const int* in_sizes, int n_in, void* d_out, int out_size, void* d_ws, size_t ws_size, hipStream_t stream) {
    static int grid = 0;
    if (grid == 0) {
        if (n_in != 22 || out_size != T * D || ws_size < WS_END) { fprintf(stderr, "kernel_launch: unexpected shapes (n_in %d out %d ws %zu need %zu)\n", n_in, out_size, ws_size, (size_t)WS_END); grid = -1; return; }
        int dev = 0, cus = 0, per_cu = 0;
        if (hipGetDevice(&dev) != hipSuccess || hipDeviceGetAttribute(&cus, hipDeviceAttributeMultiprocessorCount, dev) != hipSuccess) { grid = -1; return; }
        if (hipFuncSetAttribute((const void*)mega_fwd, hipFuncAttributeMaxDynamicSharedMemorySize, LDS_BYTES) != hipSuccess) { fprintf(stderr, "kernel_launch: hipFuncSetAttribute failed\n"); grid = -1; return; }
        if (hipOccupancyMaxActiveBlocksPerMultiprocessor(&per_cu, (const void*)mega_fwd, 512, LDS_BYTES) != hipSuccess || per_cu < 1) { fprintf(stderr, "kernel_launch: occupancy query says %d\n", per_cu); }
        (void)hipGetLastError();
        grid = cus;
    }
    if (grid < 0) return;
    (void)hipMemsetAsync((char*)d_ws + WS_CTL, 0, CTL_BYTES, stream);
    Params p{};
    for (int i = 0; i < 22; ++i) p.in[i] = (const float*)d_in[i];
    p.out = (float*)d_out; p.ws = (unsigned char*)d_ws;
    hipLaunchKernelGGL(mega_fwd, dim3(grid), dim3(512), LDS_BYTES, stream, p);
}
```

```cpp
#include <hip/hip_runtime.h>
#include <stdint.h>
#include <stdio.h>

#define LAS __attribute__((address_space(3)))
typedef unsigned short bf16_t;
typedef short bf16x8 __attribute__((ext_vector_type(8)));
typedef short s16x4 __attribute__((ext_vector_type(4)));
typedef float f32x4 __attribute__((ext_vector_type(4)));
typedef float f32x2 __attribute__((ext_vector_type(2)));
typedef unsigned u32x4 __attribute__((ext_vector_type(4)));
typedef unsigned u32x2 __attribute__((ext_vector_type(2)));
typedef int i32x4 __attribute__((ext_vector_type(4)));
typedef int i32x8 __attribute__((ext_vector_type(8)));

constexpr int T = 32768, D = 1024, SEQ = 4096, NL = 4, PIN = 2576, NPJ = 2560, NIN = 2816;
constexpr int LDS_BYTES = 147456, SCR_OFF = 1024;
constexpr int L_BLK = 64, L_CNT = 256, L_NB = 384, L_QW = 448, L_BEX = 512;
constexpr float EPS = 1e-6f;
constexpr size_t al256(size_t x) { return (x + 255) & ~(size_t)255; }
constexpr size_t WS_CTL = 0, CTL_BYTES = 1 << 20, CTL_CNT = 16384, CTL_Q = 20480;
constexpr size_t WS_MOD = WS_CTL + CTL_BYTES;
constexpr size_t WS_WIN = WS_MOD + al256((size_t)4 * 8 * 6144 * 4);
constexpr size_t WS_WOUT = WS_WIN + (size_t)4 * 2816 * 1024 * 2;
constexpr size_t WS_W13 = WS_WOUT + (size_t)4 * 1024 * 1024 * 2;
constexpr size_t WS_W2 = WS_W13 + (size_t)4 * 32 * 1024 * 1024 * 2;
constexpr size_t WS_WS = WS_W2 + (size_t)4 * 32 * 1024 * 512 * 2;
constexpr size_t WS_WR = WS_WS + (size_t)4 * 4 * 128 * 128 * 2;
constexpr size_t WS_H = WS_WR + (size_t)4 * 48 * 1024 * 2;
constexpr size_t WS_PROJ = WS_H + (size_t)T * 1024 * 2;
constexpr size_t WS_GATE = WS_PROJ + (size_t)T * 2560 * 2;
constexpr size_t WS_KV = WS_GATE + (size_t)T * 256 * 4;
constexpr size_t WS_SST = WS_KV + (size_t)2048 * 8192 * 4;
constexpr size_t WS_DEC = WS_SST + (size_t)2048 * 8192 * 2;
constexpr size_t WS_Y = WS_DEC + (size_t)2048 * 64 * 4;
constexpr size_t WS_ROUTE = WS_Y + (size_t)T * 1024 * 2;
constexpr size_t WS_TOKOF = WS_ROUTE + (size_t)T * 32;
constexpr size_t WS_XB = WS_TOKOF + (size_t)32 * 32768 * 4;
constexpr size_t WS_PSQ = WS_XB + (size_t)T * 1024 * 2;
constexpr size_t WS_AVSQ = WS_PSQ + (size_t)T * 16 * 4;
constexpr size_t WS_HS = WS_AVSQ + (size_t)T * 8 * 4;
constexpr size_t WS_WQ = WS_HS + (size_t)T * 8 * 4;
constexpr size_t WS_WQS = WS_WQ + (size_t)4 * 2816 * 1024;
constexpr size_t WS_END = WS_WQS + al256((size_t)4 * 2816 * 4);
static_assert((size_t)73728 * 1024 * 2 <= (size_t)T * 2560 * 2, "YPAD alias");
static_assert((size_t)73728 * 512 * 2 <= (size_t)2048 * 8192 * 6, "HID alias");

__device__ __forceinline__ int lane_id() { int r; asm volatile("v_mbcnt_lo_u32_b32 %0, -1, 0\n\tv_mbcnt_hi_u32_b32 %0, -1, %0" : "=v"(r)); return r; }
__device__ __forceinline__ unsigned pk2(float lo, float hi) { unsigned r; asm("v_cvt_pk_bf16_f32 %0, %1, %2" : "=v"(r) : "v"(lo), "v"(hi)); return r; }
__device__ __forceinline__ float bflo(unsigned u) { return __uint_as_float(u << 16); }
__device__ __forceinline__ float bfhi(unsigned u) { return __uint_as_float(u & 0xffff0000u); }
__device__ __forceinline__ float bf1(bf16_t u) { return __uint_as_float(((unsigned)u) << 16); }
__device__ __forceinline__ float fexp(float x) { return __builtin_amdgcn_exp2f(x * 1.4426950408889634f); }
__device__ __forceinline__ float frcp(float x) { return __builtin_amdgcn_rcpf(x); }
__device__ __forceinline__ float frsq(float x) { return __builtin_amdgcn_rsqf(x); }
__device__ __forceinline__ float silu_f(float x) { return x * frcp(1.f + fexp(-x)); }
__device__ __forceinline__ float gelu_f(float x) { const float u = 1.5957691216057308f * (x + 0.044715f * x * x * x); return x * frcp(1.f + fexp(-u)); }
__device__ __forceinline__ f32x2 silu_pk(f32x2 x) { const f32x2 t = x * (-1.4426950408889634f); f32x2 e; e.x = __builtin_amdgcn_exp2f(t.x); e.y = __builtin_amdgcn_exp2f(t.y);
    const f32x2 d = e + 1.0f; f32x2 r; r.x = __builtin_amdgcn_rcpf(d.x); r.y = __builtin_amdgcn_rcpf(d.y); return x * r; }
__device__ __forceinline__ f32x2 gelu_pk(f32x2 x) { const f32x2 t = (x * x * (-0.10294324f) + (-2.3022082f)) * x; f32x2 e; e.x = __builtin_amdgcn_exp2f(t.x); e.y = __builtin_amdgcn_exp2f(t.y);
    const f32x2 d = e + 1.0f; f32x2 r; r.x = __builtin_amdgcn_rcpf(d.x); r.y = __builtin_amdgcn_rcpf(d.y); return x * r; }
__device__ __forceinline__ f32x4 silu4(f32x4 v) { const f32x2 a = silu_pk((f32x2){v[0], v[1]}), b = silu_pk((f32x2){v[2], v[3]}); return (f32x4){a.x, a.y, b.x, b.y}; }
__device__ __forceinline__ f32x4 gelu4(f32x4 v) { const f32x2 a = gelu_pk((f32x2){v[0], v[1]}), b = gelu_pk((f32x2){v[2], v[3]}); return (f32x4){a.x, a.y, b.x, b.y}; }
__device__ __forceinline__ float logsig_f(float x) { return fminf(x, 0.f) - 0.6931471805599453f * __builtin_amdgcn_logf(1.f + fexp(-fabsf(x))); }

#define XB_TMO      128
#define XB_XCNT(j)  (256  + 64 * (j))
#define XB_XSUB(j)  (1280 + 64 * (j))
#define XB_XGEN(j)  (2304 + 64 * (j))
#define XB_TOP      3328
#define XB_TOPGEN   3392
#define XCD_BAR_WORDS 3456
#define XB_SPIN_CAP (1u << 18)
__device__ __forceinline__ unsigned xb_ld(unsigned* p)              { return __hip_atomic_load(p, __ATOMIC_RELAXED, __HIP_MEMORY_SCOPE_AGENT); }
__device__ __forceinline__ unsigned xb_add(unsigned* p, unsigned v) { return __hip_atomic_fetch_add(p, v, __ATOMIC_RELAXED, __HIP_MEMORY_SCOPE_AGENT); }
__device__ __forceinline__ unsigned xb_xcc_id() { return (unsigned)__builtin_amdgcn_s_getreg((3 << 11) | 20) & 0xFu; }
#define XB_SPIN(cond, bar) do { unsigned _sp = 0; while (cond) { __builtin_amdgcn_s_sleep(1); \
    if ((++_sp & 255u) == 0u) { if (xb_ld(&(bar)[XB_TMO])) break; if (_sp > XB_SPIN_CAP) { atomicAdd(&(bar)[XB_TMO], 1u); break; } } } } while (0)
struct XcdBarrier { unsigned* bar; unsigned x; volatile LAS unsigned* st; };
__device__ __forceinline__ XcdBarrier xcd_barrier_post(unsigned* bar, volatile LAS unsigned* st, bool leader) {
    XcdBarrier b; b.bar = bar; b.x = xb_xcc_id(); b.st = st;
    if (leader) (void)xb_add(&bar[XB_XCNT(b.x)], 1u);
    return b;
}
__device__ __forceinline__ void xcd_barrier_complete(unsigned* bar, unsigned x, unsigned& nloc, unsigned& nx) {
    const unsigned G = gridDim.x * gridDim.y * gridDim.z;
    unsigned sum, cnt, mine, sp = 0u;
    for (;;) {
        sum = 0u; cnt = 0u; mine = 0u;
#pragma unroll
        for (unsigned j = 0; j < 16; ++j) { const unsigned c = xb_ld(&bar[XB_XCNT(j)]); sum += c; cnt += (c > 0u) ? 1u : 0u; mine = (j == x) ? c : mine; }
        if (sum == G) break;
        __builtin_amdgcn_s_sleep(1);
        if ((++sp & 255u) == 0u) { if (xb_ld(&bar[XB_TMO])) break; if (sp > XB_SPIN_CAP) { atomicAdd(&bar[XB_TMO], 1u); break; } }
    }
    nloc = mine > 0u ? mine : 1u; nx = cnt > 0u ? cnt : 1u;
}
__device__ __forceinline__ void xcd_barrier(const XcdBarrier& b, bool leader) {
    asm volatile("s_waitcnt vmcnt(0)" ::: "memory");
    __syncthreads();
    if (leader) {
        unsigned* bar = b.bar;
        __builtin_amdgcn_s_waitcnt(0);
        unsigned nloc = b.st[0], nx = b.st[1];
        if (nloc == 0u) { xcd_barrier_complete(bar, b.x, nloc, nx); b.st[0] = nloc; b.st[1] = nx; }
        const unsigned old = xb_add(&bar[XB_XSUB(b.x)], 1u);
        const unsigned gen = old / nloc;
        if (old + 1u == (gen + 1u) * nloc) {
            __builtin_amdgcn_fence(__ATOMIC_RELEASE, "agent");
            asm volatile("s_waitcnt vmcnt(0)" ::: "memory");
            const unsigned og = xb_add(&bar[XB_TOP], 1u);
            const unsigned tg = og / nx;
            if (og + 1u == (tg + 1u) * nx) xb_add(&bar[XB_TOPGEN], 1u);
            else XB_SPIN(xb_ld(&bar[XB_TOPGEN]) == tg, bar);
            __builtin_amdgcn_fence(__ATOMIC_ACQUIRE, "agent");
            xb_add(&bar[XB_XGEN(b.x)], 1u);
            asm volatile("s_waitcnt vmcnt(0)" ::: "memory");
        } else {
            XB_SPIN(xb_ld(&bar[XB_XGEN(b.x)]) == gen, bar);
            __builtin_amdgcn_fence(__ATOMIC_ACQUIRE, "agent");
            asm volatile("s_waitcnt vmcnt(0)" ::: "memory");
        }
    }
    __syncthreads();
}

namespace pg8 {
__device__ __forceinline__ bf16x8 as_bf16x8(i32x4 v) { return __builtin_bit_cast(bf16x8, v); }
__device__ __forceinline__ i32x4 lo4(i32x8 v) { return v.lo; }
__device__ __forceinline__ i32x4 hi4(i32x8 v) { return v.hi; }
constexpr int BM = 256, BK = 64, HALF = 128, HTB = HALF * BK * 2, STAGE_BYTES = 8 * HTB, NXCD = 8, WGM = 4;
__device__ __forceinline__ int lds_byte(int r, int c) { const int st = (r >> 4) * 2 + (c >> 5), rr = r & 15, cc = c & 31, ob = rr * 64 + cc * 2; return st * 1024 + (ob ^ (((ob >> 9) & 1) << 5)); }
__device__ __forceinline__ void stage_rc(int b, int& R, int& C) { const int st = b / 1024, sb = b % 1024, swz = sb ^ (((sb >> 9) & 1) << 5); R = (st >> 1) * 16 + swz / 64; C = (st & 1) * 32 + (swz % 64) / 2; }
__device__ __forceinline__ int perm32(int rho) { const int n = rho >> 4, i = rho & 15; return 8 * (i >> 2) + 4 * n + (i & 3); }
struct Unit { int pm, pn, e; };
__device__ __forceinline__ int xcd_remap(int L, int nwg) { const int q = nwg / NXCD, r = nwg % NXCD, xcd = L % NXCD, off = L / NXCD; return (xcd < r ? xcd * (q + 1) : r * (q + 1) + (xcd - r) * q) + off; }

template <int MODE, class Epi, class Sched>
__device__ __forceinline__ void gemm_phase(LAS unsigned char* lds, const char* Abase, const int Kb, const Sched& S, const Epi& E, const int wv) {
    int tid_ = wv * 64 + lane_id(); asm volatile("" : "+v"(tid_));
    const int tid = tid_, wid = __builtin_amdgcn_readfirstlane(tid >> 6), lane = tid & 63, wr = wid >> 2, wc = wid & 3, fr = lane & 15, fq = lane >> 4;
    constexpr bool GATHER = Sched::GATHER;
    const int nt = Kb / 128;
    int Ri[2], Ci[2]; unsigned voffB[2], voffA[2];
#pragma unroll
    for (int i = 0; i < 2; ++i) { int R, C; stage_rc(tid * 16 + i * 8192, R, C); Ri[i] = R; Ci[i] = C; const int Rb = Epi::PERM ? ((R & ~31) + perm32(R & 31)) : R; voffB[i] = (unsigned)(Rb * Kb + C * 2); voffA[i] = (unsigned)(R * Kb + C * 2); }
    const unsigned kstep = (unsigned)(BK * 2);
    const unsigned hstep = (unsigned)(HALF * Kb);
    const unsigned tstep = 2u * hstep;
    const unsigned ldsw = (unsigned)wid * 1024u;
    const int aoff = lds_byte(wr * 64 + fr, fq * 8), boff = lds_byte(wc * 32 + fr, fq * 8);
#define PG8_SA(b, h) (((b) * 2 + (h)) * HTB)
#define PG8_SB(b, h) ((4 + (b) * 2 + (h)) * HTB)
#define PG8_STAGE(bufoff, gbase, voff) do { _Pragma("unroll") for (int _i = 0; _i < 2; ++_i) \
        __builtin_amdgcn_global_load_lds((const unsigned*)((const char*)(gbase) + (voff)[_i]), (LAS unsigned*)(lds + (bufoff) + ldsw + _i * 8192), 16, 0, 0); } while (0)
#define PG8_LDA(dst, b, h) do { _Pragma("unroll") for (int m = 0; m < 4; ++m) { dst[m].lo = *(const LAS i32x4*)(lds + PG8_SA(b, h) + aoff + m * 2048); dst[m].hi = *(const LAS i32x4*)(lds + PG8_SA(b, h) + aoff + m * 2048 + 1024); } } while (0)
#define PG8_LDB(dst, b, h) do { _Pragma("unroll") for (int n = 0; n < 2; ++n) { dst[n].lo = *(const LAS i32x4*)(lds + PG8_SB(b, h) + boff + n * 2048); dst[n].hi = *(const LAS i32x4*)(lds + PG8_SB(b, h) + boff + n * 2048 + 1024); } } while (0)
#define PG8_MMA(ai, bj, At, Bt) do { __builtin_amdgcn_s_setprio(1); \
        if constexpr (MODE == 2) {   \
            _Pragma("unroll") for (int m = 0; m < 4; ++m) _Pragma("unroll") for (int n = 0; n < 2; ++n) asm volatile("v_mfma_i32_16x16x64_i8 %0, %1, %2, %0" : "+v"(acc[ai][bj][m][n]) : "v"(lo4(Bt[n])), "v"(lo4(At[m]))); \
            _Pragma("unroll") for (int m = 0; m < 4; ++m) _Pragma("unroll") for (int n = 0; n < 2; ++n) asm volatile("v_mfma_i32_16x16x64_i8 %0, %1, %2, %0" : "+v"(acc[ai][bj][m][n]) : "v"(hi4(Bt[n])), "v"(hi4(At[m]))); } \
        else _Pragma("unroll") for (int m = 0; m < 4; ++m) _Pragma("unroll") for (int n = 0; n < 2; ++n) { \
        if constexpr (MODE == 1) asm volatile("v_mfma_scale_f32_16x16x128_f8f6f4 %0, %1, %2, %0, %3, %3 op_sel_hi:[0,0,0]" : "+v"(acc[ai][bj][m][n]) : "v"(Bt[n]), "v"(At[m]), "v"(one_scale)); \
        else { acc[ai][bj][m][n] = __builtin_amdgcn_mfma_f32_16x16x32_bf16(as_bf16x8(Bt[n].lo), as_bf16x8(At[m].lo), acc[ai][bj][m][n], 0, 0, 0); \
               acc[ai][bj][m][n] = __builtin_amdgcn_mfma_f32_16x16x32_bf16(as_bf16x8(Bt[n].hi), as_bf16x8(At[m].hi), acc[ai][bj][m][n], 0, 0, 0); } } \
        __builtin_amdgcn_s_setprio(0); } while (0)
#define PG8_WAIT_V(n) asm volatile("s_waitcnt vmcnt(" #n ")" ::: "memory")
#define PG8_WAIT_L(n) asm volatile("s_waitcnt lgkmcnt(" #n ")" ::: "memory")
#define PG8_BAR __builtin_amdgcn_s_barrier()
#define PG8_SCHED __builtin_amdgcn_sched_barrier(0)
    Unit cur, nxt; int ui = 0;
    if (!S.next(0, cur)) return;
    f32x4 acc[2][2][4][2];
#pragma unroll
    for (int a = 0; a < 2; ++a)
#pragma unroll
        for (int b = 0; b < 2; ++b)
#pragma unroll
            for (int m = 0; m < 4; ++m)
#pragma unroll
                for (int n = 0; n < 2; ++n) acc[a][b][m][n] = (f32x4){0.f, 0.f, 0.f, 0.f};
    i32x8 At[4], B0[2], B1[2];
    const int one_scale = 0x7f7f7f7f;
    unsigned ao0[2], ao1[2], an0[2], an1[2];
    const char* cA0; const char* cA1;
    if constexpr (GATHER) { S.a_off(cur, Ri[0], Ci[0], ao0[0], ao1[0]); S.a_off(cur, Ri[1], Ci[1], ao0[1], ao1[1]); cA0 = Abase; cA1 = Abase; }
    else { ao0[0] = ao1[0] = an0[0] = an1[0] = voffA[0]; ao0[1] = ao1[1] = an0[1] = an1[1] = voffA[1]; cA0 = Abase + (size_t)((unsigned)cur.pm * tstep); cA1 = cA0 + hstep; }
    const char* cB = S.b_ptr(cur);
    PG8_STAGE(PG8_SB(0, 0), cB, voffB); PG8_STAGE(PG8_SB(0, 1), cB + hstep, voffB); PG8_STAGE(PG8_SA(0, 0), cA0, ao0); PG8_STAGE(PG8_SA(0, 1), cA1, ao1);
    if (wr == 1) PG8_BAR;
    PG8_WAIT_V(2); PG8_BAR;
    PG8_STAGE(PG8_SB(1, 0), cB + kstep, voffB); PG8_STAGE(PG8_SA(1, 0), cA0 + kstep, ao0); PG8_STAGE(PG8_SB(1, 1), cB + hstep + kstep, voffB);
    PG8_WAIT_V(6); PG8_BAR;
    for (;;) {
        const bool has_next = S.next(ui + 1, nxt);
        const char* nB = cB; const char* nA0 = cA0; const char* nA1 = cA1;
        if (has_next) { nB = S.b_ptr(nxt);
            if constexpr (GATHER) { S.a_off(nxt, Ri[0], Ci[0], an0[0], an1[0]); S.a_off(nxt, Ri[1], Ci[1], an0[1], an1[1]); }
            else { nA0 = Abase + (size_t)((unsigned)nxt.pm * tstep); nA1 = nA0 + hstep; } }
        else if constexpr (GATHER) { an0[0] = ao0[0]; an0[1] = ao0[1]; an1[0] = ao1[0]; an1[1] = ao1[1]; }
        if constexpr (MODE == 2) E.stage(cur, lds + STAGE_BYTES + (ui & 1) * 2048, tid, wid);
        for (int t = 0; t < nt; t += 2) {
            const bool last = (t == nt - 2);
            const char* a1h1 = cA1 + (unsigned)(t + 1) * kstep;
            const char* a2h0 = last ? nA0 : cA0 + (unsigned)(t + 2) * kstep; const char* a2h1 = last ? nA1 : cA1 + (unsigned)(t + 2) * kstep;
            const char* b2 = last ? nB : cB + (unsigned)(t + 2) * kstep;
            const char* a3h0 = a2h0 + kstep; const char* b3 = b2 + kstep;
            unsigned x0[2], x1[2];
            if constexpr (GATHER) { x0[0] = last ? an0[0] : ao0[0]; x0[1] = last ? an0[1] : ao0[1]; x1[0] = last ? an1[0] : ao1[0]; x1[1] = last ? an1[1] : ao1[1]; }
            else { x0[0] = x1[0] = voffA[0]; x0[1] = x1[1] = voffA[1]; }
            PG8_LDB(B0, 0, 0); PG8_LDB(B1, 0, 1); PG8_SCHED; PG8_LDA(At, 0, 0); PG8_STAGE(PG8_SA(1, 1), a1h1, ao1);
            PG8_WAIT_V(8); PG8_WAIT_L(0); PG8_BAR; PG8_MMA(0, 0, At, B0); PG8_MMA(0, 1, At, B1); PG8_BAR; PG8_SCHED;
            PG8_LDA(At, 0, 1); PG8_STAGE(PG8_SB(0, 0), b2, voffB); PG8_STAGE(PG8_SB(0, 1), b2 + hstep, voffB); PG8_STAGE(PG8_SA(0, 0), a2h0, x0);
            PG8_WAIT_V(8); PG8_WAIT_L(0); PG8_BAR; PG8_MMA(1, 0, At, B0); PG8_MMA(1, 1, At, B1); PG8_BAR; PG8_SCHED;
            PG8_LDB(B0, 1, 0); PG8_LDB(B1, 1, 1); PG8_SCHED; PG8_LDA(At, 1, 0); PG8_STAGE(PG8_SA(0, 1), a2h1, x1);
            PG8_WAIT_V(8); PG8_WAIT_L(0); PG8_BAR; PG8_MMA(0, 0, At, B0); PG8_MMA(0, 1, At, B1); PG8_BAR; PG8_SCHED;
            PG8_LDA(At, 1, 1); PG8_STAGE(PG8_SB(1, 0), b3, voffB); PG8_STAGE(PG8_SB(1, 1), b3 + hstep, voffB); PG8_STAGE(PG8_SA(1, 0), a3h0, x0);
            PG8_WAIT_V(8); PG8_WAIT_L(0); PG8_BAR; PG8_MMA(1, 0, At, B0); PG8_MMA(1, 1, At, B1); PG8_BAR; PG8_SCHED;
        }
        if (wr == 0) PG8_BAR;
        if constexpr (MODE != 0) asm volatile("s_nop 15" ::: "memory");
        if constexpr (MODE == 2) E(acc, cur, wr, wc, fr, fq, (const LAS float*)(lds + STAGE_BYTES + (ui & 1) * 2048)); else E(acc, cur, wr, wc, fr, fq);
        if (!has_next) break;
#pragma unroll
        for (int a = 0; a < 2; ++a)
#pragma unroll
            for (int b = 0; b < 2; ++b)
#pragma unroll
                for (int m = 0; m < 4; ++m)
#pragma unroll
                    for (int n = 0; n < 2; ++n) acc[a][b][m][n] = (f32x4){0.f, 0.f, 0.f, 0.f};
        cur = nxt; cB = nB; cA0 = nA0; cA1 = nA1; ++ui; if constexpr (GATHER) { ao0[0] = an0[0]; ao0[1] = an0[1]; ao1[0] = an1[0]; ao1[1] = an1[1]; }
        if (wr == 1) PG8_BAR;
    }
    PG8_WAIT_V(0);
    PG8_BAR;
#undef PG8_SA
#undef PG8_SB
#undef PG8_STAGE
#undef PG8_LDA
#undef PG8_LDB
#undef PG8_MMA
#undef PG8_WAIT_V
#undef PG8_WAIT_L
#undef PG8_BAR
#undef PG8_SCHED
}
}
#define LDS_BAR() do { asm volatile("s_waitcnt lgkmcnt(0)" ::: "memory"); __builtin_amdgcn_s_barrier(); asm volatile("" ::: "memory"); } while (0)
struct Params { const float* in[22]; float* out; unsigned char* ws; };
struct FP {
    const Params& P; LAS unsigned char* lds; int zi; int wv;
    __device__ __forceinline__ FP fresh() const { int q; asm volatile("s_mov_b32 %0, 0" : "=s"(q)); return FP{P, lds, q, wv}; }
#define FP_IN(name, idx) __device__ __forceinline__ const float* name() const { return P.in[idx + zi]; }
    FP_IN(x_in, 0) FP_IN(c, 1) FP_IN(w_ada, 2) FP_IN(b_ada, 3) FP_IN(n1g, 4) FP_IN(n2g, 5) FP_IN(w_in, 6) FP_IN(avg, 7) FP_IN(aws, 8) FP_IN(abs_, 9) FP_IN(bwa, 10) FP_IN(bba, 11)
    FP_IN(bog, 12) FP_IN(w_out, 13) FP_IN(w_group, 14) FP_IN(b_group, 15) FP_IN(w_router, 16) FP_IN(b_router, 17) FP_IN(w1, 18) FP_IN(w3, 19) FP_IN(w2, 20) FP_IN(fgain, 21)
#undef FP_IN
#define FP_WS(type, name, off) __device__ __forceinline__ type* name() const { return (type*)((&P.ws)[zi] + (off)); }
    FP_WS(float, MOD, WS_MOD) FP_WS(bf16_t, WIN, WS_WIN) FP_WS(bf16_t, WOUT, WS_WOUT) FP_WS(bf16_t, W13, WS_W13) FP_WS(bf16_t, W2, WS_W2) FP_WS(bf16_t, WSB, WS_WS) FP_WS(bf16_t, WR, WS_WR)
    FP_WS(bf16_t, H, WS_H) FP_WS(bf16_t, PROJ, WS_PROJ) FP_WS(unsigned char, YPAD, WS_PROJ) FP_WS(unsigned char, HID, WS_KV) FP_WS(unsigned char, H8, WS_H) FP_WS(unsigned char, H8I, WS_H + (size_t)T * 1024) FP_WS(float, HS, WS_HS) FP_WS(unsigned char, WQ, WS_WQ) FP_WS(float, WQS, WS_WQS) FP_WS(unsigned char, W13B, WS_W13) FP_WS(unsigned char, W2B, WS_W2) FP_WS(bf16_t, SST, WS_SST) FP_WS(bf16_t, Y, WS_Y) FP_WS(bf16_t, GATE, WS_GATE)
    FP_WS(float, KV, WS_KV) FP_WS(float, DEC, WS_DEC) FP_WS(int, ROUTE, WS_ROUTE) FP_WS(int, TOKOF, WS_TOKOF) FP_WS(int, CNT, WS_CTL + CTL_CNT) FP_WS(int, QH, WS_CTL + CTL_Q) FP_WS(bf16_t, XB, WS_XB) FP_WS(float, PSQ, WS_PSQ) FP_WS(float, AVSQ, WS_AVSQ)
#undef FP_WS
    __device__ __forceinline__ float* xcur() const { return (&P.out)[zi]; }
    __device__ __forceinline__ int tid() const { return wv * 64 + lane_id(); }
};

struct DenseSched {
    static constexpr bool GATHER = false;
    int nM, nN, nwg, G, c, Kb; const char* Bt;
    __device__ __forceinline__ bool next(int i, pg8::Unit& u) const {
        const int L = i * G + c; if (L >= nwg) return false;
        const int wgid = pg8::xcd_remap(L, nwg);
        const int nig = pg8::WGM * nN, gid = wgid / nig, fm = gid * pg8::WGM, gsz = (nM - fm) < pg8::WGM ? (nM - fm) : pg8::WGM;
        u.pm = fm + ((wgid % nig) % gsz); u.pn = (wgid % nig) / gsz; u.e = 0; return true;
    }
    __device__ __forceinline__ void a_off(const pg8::Unit&, int, int, unsigned&, unsigned&) const {}
    __device__ __forceinline__ const char* b_ptr(const pg8::Unit& u) const { return Bt + (size_t)u.pn * 256 * Kb; }
};
template <bool GATHER_> struct MoeSched {
    static constexpr bool GATHER = GATHER_;
    int nunits, G, c, Kb; const LAS int* blk; const LAS int* cnt; const int* tokof; const char* W; size_t estride, tstride;
    __device__ __forceinline__ bool next(int i, pg8::Unit& u) const {
        const int L = i * G + c; if (L >= nunits) return false;
        const int wgid = pg8::xcd_remap(L, nunits);
        u.pm = wgid >> 2; u.pn = wgid & 3; u.e = (int)((const LAS unsigned char*)blk)[(L_BEX - L_BLK) + u.pm]; return true;
    }
    __device__ __forceinline__ void a_off(const pg8::Unit& u, int R, int C, unsigned& o0, unsigned& o1) const {
        const int s0 = (u.pm - blk[u.e]) * 256 + R, s1 = s0 + 128, n = cnt[u.e];
        const int t0 = s0 < n ? tokof[u.e * 32768 + s0] : 0, t1 = s1 < n ? tokof[u.e * 32768 + s1] : 0;
        o0 = (unsigned)(t0 * Kb + C * 2); o1 = (unsigned)(t1 * Kb + C * 2);
    }
    __device__ __forceinline__ const char* b_ptr(const pg8::Unit& u) const { return W + (size_t)u.e * estride + (size_t)u.pn * tstride; }
};

#define THIN_ST(p, v) (*(p) = (v))
#define EPI_ST(p, v) (*(p) = (v))
struct EpiInProj {
    static constexpr bool PERM = true;
    bf16_t* PROJ; bf16_t* GATE; const float* b_alpha; float* avsq; const float* hs; const float* wqs;
    __device__ __forceinline__ void stage(const pg8::Unit& u, LAS unsigned char* dst, int tid, int wid) const {
        const float* src = tid < 256 ? hs + (size_t)(u.pm * 256 + tid) * 8 : wqs + u.pn * 256 + (tid - 256);
        __builtin_amdgcn_global_load_lds((const unsigned*)src, (LAS unsigned*)(dst + wid * 256), 4, 0, 0);
    }
    __device__ __forceinline__ void operator()(const f32x4 (&acc)[2][2][4][2], const pg8::Unit& u, int wr, int wc, int fr, int fq, const LAS float* sc) const {
        int rl_ = wr * 64 + fr, cl_ = wc * 32 + 8 * fq; asm volatile("" : "+v"(rl_), "+v"(cl_));
        const int row0 = u.pm * 256 + rl_, cl = cl_;
        float rsv[2][4]; f32x4 csv[2][2];
#pragma unroll
        for (int ai = 0; ai < 2; ++ai)
#pragma unroll
            for (int m = 0; m < 4; ++m) rsv[ai][m] = sc[rl_ + ai * 128 + m * 16];
#pragma unroll
        for (int bj = 0; bj < 2; ++bj)
#pragma unroll
            for (int n = 0; n < 2; ++n) csv[bj][n] = *(const LAS f32x4*)(sc + 256 + bj * 128 + cl + 4 * n);
#define EIP_ACC(ai, bj, m, n) (__builtin_convertvector(__builtin_bit_cast(i32x4, acc[ai][bj][m][n]), f32x4) * csv[bj][n] * rsv[ai][m])
        if (u.pn == 10) {
#pragma unroll
            for (int bj = 0; bj < 2; ++bj) { const f32x4 b0 = *(const f32x4*)(b_alpha + bj * 128 + cl), b1 = *(const f32x4*)(b_alpha + bj * 128 + cl + 4);
#pragma unroll
                for (int ai = 0; ai < 2; ++ai)
#pragma unroll
                    for (int m = 0; m < 4; ++m) { bf16_t* gp = GATE + (size_t)(row0 + ai * 128 + m * 16) * 256 + bj * 128 + cl; f32x4 v0 = EIP_ACC(ai, bj, m, 0) + b0, v1 = EIP_ACC(ai, bj, m, 1) + b1;
#pragma unroll
                        for (int j = 0; j < 4; ++j) { v0[j] = logsig_f(v0[j]) * 0.0625f; v1[j] = logsig_f(v1[j]) * 0.0625f; }
                        u32x4 w; w.x = pk2(v0[0], v0[1]); w.y = pk2(v0[2], v0[3]); w.z = pk2(v1[0], v1[1]); w.w = pk2(v1[2], v1[3]);
                        EPI_ST((u32x4*)gp, w); } }
        } else {
            const int mode = u.pn < 4 ? 0 : (u.pn == 4 ? 1 : (u.pn < 8 ? 2 : 3));
#pragma unroll
            for (int ai = 0; ai < 2; ++ai)
#pragma unroll
                for (int m = 0; m < 4; ++m) { bf16_t* rp = PROJ + (size_t)(row0 + ai * 128 + m * 16) * NPJ + u.pn * 256 + cl; float ssq = 0.f;
#pragma unroll
                    for (int bj = 0; bj < 2; ++bj) { f32x4 v0 = EIP_ACC(ai, bj, m, 0), v1 = EIP_ACC(ai, bj, m, 1);
                        if (mode == 0) {
                            v0 = gelu4(v0); v1 = gelu4(v1);
                            ssq += v0[0] * v0[0] + v0[1] * v0[1] + v0[2] * v0[2] + v0[3] * v0[3] + v1[0] * v1[0] + v1[1] * v1[1] + v1[2] * v1[2] + v1[3] * v1[3]; }
                        else if (mode == 1) { v0 = v0 * 0.125f; v1 = v1 * 0.125f; }
                        else if (mode == 3) {
                            v0 = silu4(v0); v1 = silu4(v1); }
                        u32x4 w; w.x = pk2(v0[0], v0[1]); w.y = pk2(v0[2], v0[3]); w.z = pk2(v1[0], v1[1]); w.w = pk2(v1[2], v1[3]);
                        EPI_ST((u32x4*)(rp + bj * 128), w); }
                    if (u.pn == 2 || u.pn == 3) { ssq += __shfl_xor(ssq, 16); ssq += __shfl_xor(ssq, 32);
                        if (fq == 0) avsq[(size_t)(row0 + ai * 128 + m * 16) * 8 + (u.pn - 2) * 4 + wc] = ssq; } }
        }
    }
};
#undef EIP_ACC
struct EpiOutProj {
    static constexpr bool PERM = true;
    const float* xin32; const bf16_t* xin16; bf16_t* xout; const float* g1; float* psq;
    __device__ __forceinline__ void operator()(const f32x4 (&acc)[2][2][4][2], const pg8::Unit& u, int wr, int wc, int fr, int fq) const {
        const int row0 = u.pm * 256 + wr * 64 + fr, col0 = u.pn * 256 + wc * 32 + 8 * fq; const float* gb = g1 + (size_t)(u.pm >> 4) * 6144 + col0;
        f32x4 gv[2][2];
#pragma unroll
        for (int bj = 0; bj < 2; ++bj)
#pragma unroll
            for (int n = 0; n < 2; ++n) gv[bj][n] = *(const f32x4*)(gb + bj * 128 + n * 4);
#define EOP_ROW(X0, X1, ai, m, bj) do { f32x4 x0 = (X0), x1 = (X1); x0 += gv[bj][0] * acc[ai][bj][m][0]; x1 += gv[bj][1] * acc[ai][bj][m][1]; \
            ssq += x0[0] * x0[0] + x0[1] * x0[1] + x0[2] * x0[2] + x0[3] * x0[3] + x1[0] * x1[0] + x1[1] * x1[1] + x1[2] * x1[2] + x1[3] * x1[3]; \
            u32x4 w; w.x = pk2(x0[0], x0[1]); w.y = pk2(x0[2], x0[3]); w.z = pk2(x1[0], x1[1]); w.w = pk2(x1[2], x1[3]); \
            EPI_ST((u32x4*)(xout + (size_t)(row0 + ai * 128 + m * 16) * D + col0 + bj * 128), w); } while (0)
#define EOP_PSQ(ai, m) do { ssq += __shfl_xor(ssq, 16); ssq += __shfl_xor(ssq, 32); if (fq == 0) psq[(size_t)(row0 + ai * 128 + m * 16) * 16 + u.pn * 4 + wc] = ssq; } while (0)
        if (xin32 == nullptr) {
#pragma unroll
            for (int ai = 0; ai < 2; ++ai) { u32x4 xv[4][2];
#pragma unroll
                for (int m = 0; m < 4; ++m)
#pragma unroll
                    for (int bj = 0; bj < 2; ++bj) xv[m][bj] = *(const u32x4*)(xin16 + (size_t)(row0 + ai * 128 + m * 16) * D + col0 + bj * 128);
                asm volatile("" : "+v"(xv[0][0]), "+v"(xv[0][1]), "+v"(xv[1][0]), "+v"(xv[1][1]), "+v"(xv[2][0]), "+v"(xv[2][1]), "+v"(xv[3][0]), "+v"(xv[3][1]));
#pragma unroll
                for (int m = 0; m < 4; ++m) { float ssq = 0.f;
#pragma unroll
                    for (int bj = 0; bj < 2; ++bj) { const u32x4 q = xv[m][bj];
                        EOP_ROW(((f32x4){bflo(q[0]), bfhi(q[0]), bflo(q[1]), bfhi(q[1])}), ((f32x4){bflo(q[2]), bfhi(q[2]), bflo(q[3]), bfhi(q[3])}), ai, m, bj); }
                    EOP_PSQ(ai, m); } }
        } else {
#pragma unroll
            for (int ai = 0; ai < 2; ++ai)
#pragma unroll
                for (int mh = 0; mh < 2; ++mh) { f32x4 xf[2][2][2];
#pragma unroll
                    for (int m = 0; m < 2; ++m)
#pragma unroll
                        for (int bj = 0; bj < 2; ++bj) { const float* xp = xin32 + (size_t)(row0 + ai * 128 + (2 * mh + m) * 16) * D + col0 + bj * 128; xf[m][bj][0] = *(const f32x4*)xp; xf[m][bj][1] = *(const f32x4*)(xp + 4); }
                    asm volatile("" : "+v"(xf[0][0][0]), "+v"(xf[0][0][1]), "+v"(xf[0][1][0]), "+v"(xf[0][1][1]), "+v"(xf[1][0][0]), "+v"(xf[1][0][1]), "+v"(xf[1][1][0]), "+v"(xf[1][1][1]));
#pragma unroll
                    for (int m = 0; m < 2; ++m) { float ssq = 0.f;
#pragma unroll
                        for (int bj = 0; bj < 2; ++bj) EOP_ROW(xf[m][bj][0], xf[m][bj][1], ai, (2 * mh + m), bj);
                        EOP_PSQ(ai, (2 * mh + m)); } }
        }
#undef EOP_ROW
#undef EOP_PSQ
    }
};
__device__ __forceinline__ unsigned pk4_fp8(float a, float b, float c, float d) { int r = __builtin_amdgcn_cvt_pk_fp8_f32(a, b, 0, false); r = __builtin_amdgcn_cvt_pk_fp8_f32(c, d, r, true); return (unsigned)r; }
__device__ __forceinline__ f32x4 up4_fp8(unsigned u) { const f32x2 a = __builtin_amdgcn_cvt_pk_f32_fp8((int)u, false), b = __builtin_amdgcn_cvt_pk_f32_fp8((int)u, true); return (f32x4){a[0], a[1], b[0], b[1]}; }
constexpr float W8_SCALE = 32.f, W8_INV = 1.f / 32.f;
struct EpiMoe1 {
    static constexpr bool PERM = true;
    unsigned char* HID;
    __device__ __forceinline__ void operator()(const f32x4 (&acc)[2][2][4][2], const pg8::Unit& u, int wr, int wc, int fr, int fq) const {
        const int row0 = u.pm * 256 + wr * 64 + fr, col0 = u.pn * 128 + wc * 32 + 8 * fq;
#pragma unroll
        for (int ai = 0; ai < 2; ++ai)
#pragma unroll
            for (int m = 0; m < 4; ++m) { f32x4 v0 = acc[ai][0][m][0] * W8_INV, v1 = acc[ai][0][m][1] * W8_INV; const f32x4 g0 = acc[ai][1][m][0] * W8_INV, g1 = acc[ai][1][m][1] * W8_INV;
                v0 = silu4(v0) * g0; v1 = silu4(v1) * g1;
                u32x2 w; w.x = pk4_fp8(v0[0], v0[1], v0[2], v0[3]); w.y = pk4_fp8(v1[0], v1[1], v1[2], v1[3]);
                EPI_ST((u32x2*)(HID + (size_t)(row0 + ai * 128 + m * 16) * 512 + col0), w); }
    }
};
struct EpiMoe2 {
    static constexpr bool PERM = true;
    unsigned char* YPAD;
    __device__ __forceinline__ void operator()(const f32x4 (&acc)[2][2][4][2], const pg8::Unit& u, int wr, int wc, int fr, int fq) const {
        const int row0 = u.pm * 256 + wr * 64 + fr, col0 = u.pn * 256 + wc * 32 + 8 * fq;
#pragma unroll
        for (int ai = 0; ai < 2; ++ai)
#pragma unroll
            for (int m = 0; m < 4; ++m)
#pragma unroll
                for (int bj = 0; bj < 2; ++bj) { const f32x4 v0 = acc[ai][bj][m][0] * W8_INV, v1 = acc[ai][bj][m][1] * W8_INV;
                    u32x2 w; w.x = pk4_fp8(v0[0], v0[1], v0[2], v0[3]); w.y = pk4_fp8(v1[0], v1[1], v1[2], v1[3]);
                    EPI_ST((u32x2*)(YPAD + (size_t)(row0 + ai * 128 + m * 16) * 1024 + col0 + bj * 128), w); }
    }
};

__device__ __forceinline__ bf16x8 tr_frag(LAS const unsigned char* img, int pitch, int k0, int x0, int lane) {
    LAS const unsigned char* p = img + (k0 + 8 * (lane >> 4) + ((lane & 15) >> 2)) * pitch + (x0 + 4 * (lane & 3)) * 2;
    const s16x4 a = __builtin_amdgcn_ds_read_tr16_b64_v4i16((LAS s16x4*)p), b = __builtin_amdgcn_ds_read_tr16_b64_v4i16((LAS s16x4*)(p + 4 * pitch));
    return (bf16x8){a[0], a[1], a[2], a[3], b[0], b[1], b[2], b[3]};
}
__device__ __forceinline__ bf16x8 tr_frag_p8(LAS const unsigned char* img, int pitch, int k0, int m, int lane) {
    LAS const unsigned char* p = img + (k0 + 8 * (lane >> 4) + ((lane & 15) >> 2)) * pitch + (32 * (m >> 1) + 8 * (lane & 3) + 4 * (m & 1)) * 2;
    const s16x4 a = __builtin_amdgcn_ds_read_tr16_b64_v4i16((LAS s16x4*)p), b = __builtin_amdgcn_ds_read_tr16_b64_v4i16((LAS s16x4*)(p + 4 * pitch));
    return (bf16x8){a[0], a[1], a[2], a[3], b[0], b[1], b[2], b[3]};
}
__device__ __forceinline__ int perm_p8(int m, int i) { return 32 * (m >> 1) + 8 * (i >> 2) + 4 * (m & 1) + (i & 3); }
__device__ __forceinline__ f32x4 mfma16(bf16x8 a, bf16x8 b, f32x4 c) { return __builtin_amdgcn_mfma_f32_16x16x32_bf16(a, b, c, 0, 0, 0); }
#define PIN4(x) asm volatile("" : "+v"((x)[0]), "+v"((x)[1]), "+v"((x)[2]), "+v"((x)[3]))
#define PIN8(x) asm volatile("" : "+v"((x)[0]), "+v"((x)[1]), "+v"((x)[2]), "+v"((x)[3]), "+v"((x)[4]), "+v"((x)[5]), "+v"((x)[6]), "+v"((x)[7]))
struct TrTile { const float* src; unsigned char* dst; int ldn, K, kind, k0, n0; };
__device__ __forceinline__ TrTile tr_desc(const FP& F, int l, int r) {
    TrTile t;
    if (r < 160) { t.src = F.w_in() + (size_t)l * 1024 * PIN; t.ldn = PIN; t.K = 1024; t.kind = 0; t.dst = (unsigned char*)(F.WIN() + (size_t)l * NIN * 1024); t.k0 = (r / 10) * 64; t.n0 = (r % 10) * 256; }
    else if (r < 224) { r -= 160; t.src = F.w_out() + (size_t)l * 1024 * 1024; t.ldn = 1024; t.K = 1024; t.kind = 0; t.dst = (unsigned char*)(F.WOUT() + (size_t)l * 1024 * 1024); t.k0 = (r / 4) * 64; t.n0 = (r % 4) * 256; }
    else if (r < 1248) { r -= 224; const int e = r >> 5; r &= 31; t.src = F.w1() + ((size_t)l * 32 + e) * 1024 * 512; t.ldn = 512; t.K = 1024; t.kind = 1; t.dst = F.W13B() + ((size_t)l * 32 + e) * 1024 * 1024; t.k0 = (r >> 1) * 64; t.n0 = (r & 1) * 256; }
    else if (r < 2272) { r -= 1248; const int e = r >> 5; r &= 31; t.src = F.w3() + ((size_t)l * 32 + e) * 1024 * 512; t.ldn = 512; t.K = 1024; t.kind = 2; t.dst = F.W13B() + ((size_t)l * 32 + e) * 1024 * 1024; t.k0 = (r >> 1) * 64; t.n0 = (r & 1) * 256; }
    else { r -= 2272; const int e = r >> 5; r &= 31; t.src = F.w2() + ((size_t)l * 32 + e) * 512 * 1024; t.ldn = 1024; t.K = 512; t.kind = 3; t.dst = F.W2B() + ((size_t)l * 32 + e) * 1024 * 512; t.k0 = (r >> 2) * 64; t.n0 = (r & 3) * 256; }
    return t;
}
__device__ __forceinline__ void tr_load(const TrTile& t, f32x4 (&v)[8], int tid) {
    if (t.kind == 0) { const int kp = tid >> 4, nq = (tid & 15) * 4;
#pragma unroll
        for (int i = 0; i < 4; ++i) { const float* p = t.src + (size_t)(t.k0 + 2 * kp) * t.ldn + t.n0 + nq + 64 * i; v[i] = *(const f32x4*)p; v[4 + i] = *(const f32x4*)(p + t.ldn); } }
    else { const int kq = tid >> 5, nq = (tid & 31) * 4;
#pragma unroll
        for (int i = 0; i < 2; ++i)
#pragma unroll
            for (int rr = 0; rr < 4; ++rr) v[4 * i + rr] = *(const f32x4*)(t.src + (size_t)(t.k0 + 4 * kq + rr) * t.ldn + t.n0 + nq + 128 * i); }
}
__device__ __forceinline__ void convert_pull(const FP& F0, int l, int quota) {
    const FP F = F0.fresh();
    int tid_ = F.tid(); asm volatile("" : "+v"(tid_)); const int tid = tid_; volatile LAS int* qw = (volatile LAS int*)(F.lds + L_QW);
    LAS unsigned* sT = (LAS unsigned*)(F.lds + SCR_OFF);
    __syncthreads();
    if (tid == 0) qw[0] = quota > 0 ? __hip_atomic_fetch_add(F.QH() + l * 64, 1, __ATOMIC_RELAXED, __HIP_MEMORY_SCOPE_AGENT) : 3296;
    __syncthreads();
    int r = qw[0]; f32x4 v[8]; TrTile cur;
    if (r < 3296) { cur = tr_desc(F, l, r); tr_load(cur, v, tid); }
    for (int n = 1; r < 3296; ++n) {
        if (tid == 0) qw[1] = n < quota ? __hip_atomic_fetch_add(F.QH() + l * 64, 1, __ATOMIC_RELAXED, __HIP_MEMORY_SCOPE_AGENT) : 3296;
        if (cur.kind == 0) { const int kp = tid >> 4, nq = (tid & 15) * 4;
#pragma unroll
            for (int i = 0; i < 4; ++i)
#pragma unroll
                for (int j = 0; j < 4; ++j) sT[(nq + 64 * i + j) * 33 + kp] = pk2(v[i][j], v[4 + i][j]); }
        else { const int kq = tid >> 5, nq = (tid & 31) * 4;
#pragma unroll
            for (int i = 0; i < 2; ++i)
#pragma unroll
                for (int j = 0; j < 4; ++j) sT[(nq + 128 * i + j) * 17 + kq] = pk4_fp8(v[4 * i][j] * W8_SCALE, v[4 * i + 1][j] * W8_SCALE, v[4 * i + 2][j] * W8_SCALE, v[4 * i + 3][j] * W8_SCALE); }
        LDS_BAR();
        const int rn = qw[1]; const TrTile t = cur;
        if (rn < 3296) { cur = tr_desc(F, l, rn); tr_load(cur, v, tid); }
        if (t.kind == 0) {
#pragma unroll
            for (int i = 0; i < 4; ++i) { const int id = tid + 512 * i, nl = id >> 3, kc = id & 7;
                u32x4 w; w.x = sT[nl * 33 + kc * 4]; w.y = sT[nl * 33 + kc * 4 + 1]; w.z = sT[nl * 33 + kc * 4 + 2]; w.w = sT[nl * 33 + kc * 4 + 3];
                *(u32x4*)(t.dst + ((size_t)(t.n0 + nl) * t.K + t.k0 + kc * 8) * 2) = w; } }
        else {
#pragma unroll
            for (int i = 0; i < 2; ++i) { const int id = tid + 512 * i, nl = id >> 2, kc = id & 3; const int nn = t.n0 + nl;
                const int drow = t.kind == 3 ? nn : ((nn >> 7) * 256 + (nn & 127) + (t.kind == 2 ? 128 : 0));
                u32x4 w; w.x = sT[nl * 17 + kc * 4]; w.y = sT[nl * 17 + kc * 4 + 1]; w.z = sT[nl * 17 + kc * 4 + 2]; w.w = sT[nl * 17 + kc * 4 + 3];
                *(u32x4*)(t.dst + (size_t)drow * t.K + t.k0 + kc * 16) = w; } }
        LDS_BAR();
        r = rn;
    }
    __syncthreads();
}
__device__ __forceinline__ void p0_mod(const FP& F0) {
    const FP F = F0.fresh();
    int tid_ = F.tid(); asm volatile("" : "+v"(tid_)); const int tid = tid_; LAS float* sC = (LAS float*)(F.lds + SCR_OFF); LAS float* sR = sC + 8192;
    for (int j = tid; j < 8192; j += 512) sC[j] = silu_f(F.c()[j]);
    __syncthreads();
    const int cg = tid & 31, ks = tid >> 5;
    for (int it = blockIdx.x; it < 192; it += gridDim.x) {
        const int l = it / 48, j0 = (it % 48) * 128 + cg * 4; const float* wp = F.w_ada() + ((size_t)l * 1024 + ks * 64) * 6144 + j0;
        f32x4 acc[8];
#pragma unroll
        for (int b = 0; b < 8; ++b) acc[b] = (f32x4){0.f, 0.f, 0.f, 0.f};
#pragma unroll 4
        for (int k = 0; k < 64; ++k) { const f32x4 w = *(const f32x4*)(wp + (size_t)k * 6144);
#pragma unroll
            for (int b = 0; b < 8; ++b) acc[b] += w * sC[b * 1024 + ks * 64 + k]; }
#pragma unroll
        for (int b = 0; b < 8; ++b) *(LAS f32x4*)(sR + (ks * 8 + b) * 128 + cg * 4) = acc[b];
        __syncthreads();
        for (int o = tid; o < 1024; o += 512) { const int b = o >> 7, j = o & 127; float s = F.b_ada()[l * 6144 + (it % 48) * 128 + j];
#pragma unroll
            for (int q = 0; q < 16; ++q) s += sR[(q * 8 + b) * 128 + j];
            F.MOD()[((size_t)l * 8 + b) * 6144 + (it % 48) * 128 + j] = s; }
        __syncthreads();
    }
}
__device__ __forceinline__ void p0_small(const FP& F0) {
    const FP F = F0.fresh();
    int tid_ = F.tid(); asm volatile("" : "+v"(tid_));
    const size_t gsz = (size_t)gridDim.x * 512, g0 = (size_t)blockIdx.x * 512 + tid_;
    for (size_t i = g0; i < (size_t)4 * 256 * 1024; i += gsz) { const int l = (int)(i >> 18), n = (int)((i >> 10) & 255), k = (int)(i & 1023);
        const float* wl = F.w_in() + ((size_t)l * 1024 + k) * PIN + 2560; const float* wa = F.bwa() + (size_t)l * 16 * 256 + n; float s = 0.f;
#pragma unroll
        for (int r = 0; r < 16; ++r) s += wl[r] * wa[r * 256];
        F.WIN()[((size_t)l * NIN + 2560 + n) * 1024 + k] = (bf16_t)(pk2(s, 0.f) & 0xffffu); }
    for (size_t i = g0; i < (size_t)4 * 4 * 128 * 128; i += gsz) { const int t = (int)((i >> 7) & 127), s = (int)(i & 127); F.WSB()[i] = (bf16_t)(pk2(s <= t ? F.aws()[i] : 0.f, 0.f) & 0xffffu); }
    for (size_t i = g0; i < (size_t)4 * 48 * 1024; i += gsz) { const int l = (int)(i / (48 * 1024)), n = (int)((i >> 10) % 48), k = (int)(i & 1023);
        const float v = n < 4 ? F.w_group()[((size_t)l * 1024 + k) * 4 + n] : (n < 36 ? F.w_router()[((size_t)l * 1024 + k) * 32 + (n - 4)] : 0.f);
        F.WR()[i] = (bf16_t)(pk2(v, 0.f) & 0xffffu); }
}

__device__ __forceinline__ void moe_tables(const FP& F0, int l) {
    const FP F = F0.fresh();
    LAS int* blk = (LAS int*)(F.lds + L_BLK); LAS int* cnt = (LAS int*)(F.lds + L_CNT); LAS int* nb = (LAS int*)(F.lds + L_NB);
    __syncthreads();
    const int tx = F.tid();
    if (tx < 32) cnt[tx] = __hip_atomic_load(F.CNT() + l * 32 + tx, __ATOMIC_RELAXED, __HIP_MEMORY_SCOPE_AGENT);
    __syncthreads();
    if (tx == 0) { int s = 0; for (int e = 0; e < 32; ++e) { blk[e] = s; s += (cnt[e] + 255) >> 8; } blk[32] = s; nb[0] = s; }
    __syncthreads();
    if (tx < 288) { int e = 0; while (e < 31 && blk[e + 1] <= tx) ++e; ((LAS unsigned char*)(F.lds + L_BEX))[tx] = (unsigned char)e; }
    __syncthreads();
}

struct P1Row { u32x2 xb[4]; unsigned ya[4], yc[4]; float w0, w1; };
__device__ __forceinline__ void p1_issue(const FP& F, P1Row& R, const i32x4& r0, const i32x4& r1, const LAS int* blk, int t, int lane) {
    R.w0 = __int_as_float(r0[2]); R.w1 = __int_as_float(r1[1]);
    const unsigned char* y0 = F.YPAD() + ((size_t)blk[r0[0]] * 256 + r0[1]) * 1024; const unsigned char* y1 = F.YPAD() + ((size_t)blk[r0[3]] * 256 + r1[0]) * 1024;
#pragma unroll
    for (int j = 0; j < 4; ++j) { R.xb[j] = *(const u32x2*)(F.XB() + (size_t)t * D + lane * 4 + 256 * j); R.ya[j] = *(const unsigned*)(y0 + lane * 4 + 256 * j); R.yc[j] = *(const unsigned*)(y1 + lane * 4 + 256 * j); }
}
__device__ __forceinline__ void p1_finish(const FP& F, int l, int t, int lane, f32x4 (&x)[4], const f32x4 (&gv)[4], const f32x4 (&sv)[4]) {
    float ss = 0.f;
#pragma unroll
    for (int j = 0; j < 4; ++j) ss += x[j][0] * x[j][0] + x[j][1] * x[j][1] + x[j][2] * x[j][2] + x[j][3] * x[j][3];
#pragma unroll
    for (int o = 32; o >= 1; o >>= 1) ss += __shfl_xor(ss, o);
    const float rstd = frsq(ss * (1.f / D) + EPS);
    if (l < NL) {
        f32x4 hv[4]; float am = 0.f;
#pragma unroll
        for (int j = 0; j < 4; ++j) { hv[j] = x[j] * rstd * gv[j] + sv[j]; am = fmaxf(fmaxf(am, fmaxf(fabsf(hv[j][0]), fabsf(hv[j][1]))), fmaxf(fabsf(hv[j][2]), fabsf(hv[j][3]))); }
#pragma unroll
        for (int o = 32; o >= 1; o >>= 1) am = fmaxf(am, __shfl_xor(am, o));
        const float inv = am > 0.f ? 127.f / am : 0.f;
#pragma unroll
        for (int j = 0; j < 4; ++j) { const f32x4 q = hv[j] * inv + 12582912.f;
            const unsigned o = (__float_as_uint(q[0]) & 0xffu) | ((__float_as_uint(q[1]) & 0xffu) << 8) | ((__float_as_uint(q[2]) & 0xffu) << 16) | (__float_as_uint(q[3]) << 24);
            THIN_ST((unsigned*)(F.H8I() + (size_t)t * D + lane * 4 + 256 * j), o); }
        if (lane == 0) F.HS()[(size_t)t * 8] = am * (1.f / 127.f);
    } else {
#pragma unroll
        for (int j = 0; j < 4; ++j) { const f32x4 hv = x[j] * rstd * gv[j] + sv[j]; THIN_ST((f32x4*)(F.xcur() + (size_t)t * D + lane * 4 + 256 * j), hv); }
    }
}
__device__ __forceinline__ void win_requant(const FP& F, int l, int w, int lane) {
    for (int r = blockIdx.x * 8 + w; r < NIN; r += gridDim.x * 8) {
        const bf16_t* src = F.WIN() + ((size_t)l * NIN + r) * 1024 + lane * 16;
        const u32x4 a = *(const u32x4*)src, b = *(const u32x4*)(src + 8);
        float v[16];
#pragma unroll
        for (int i = 0; i < 4; ++i) { v[2 * i] = bflo(a[i]); v[2 * i + 1] = bfhi(a[i]); v[8 + 2 * i] = bflo(b[i]); v[8 + 2 * i + 1] = bfhi(b[i]); }
        float am = 0.f;
#pragma unroll
        for (int i = 0; i < 16; ++i) am = fmaxf(am, fabsf(v[i]));
#pragma unroll
        for (int o = 32; o >= 1; o >>= 1) am = fmaxf(am, __shfl_xor(am, o));
        const float inv = am > 0.f ? 127.f / am : 0.f;
        u32x4 o;
#pragma unroll
        for (int i = 0; i < 4; ++i) { unsigned q[4];
#pragma unroll
            for (int e = 0; e < 4; ++e) q[e] = __float_as_uint(v[4 * i + e] * inv + 12582912.f);
            o[i] = (q[0] & 0xffu) | ((q[1] & 0xffu) << 8) | ((q[2] & 0xffu) << 16) | (q[3] << 24); }
        *(u32x4*)(F.WQ() + ((size_t)l * NIN + r) * 1024 + lane * 16) = o;
        if (lane == 0) F.WQS()[l * NIN + r] = am * (1.f / 127.f);
    }
}
__device__ __forceinline__ void p1_rows(const FP& F0, int l) {
    const FP F = F0.fresh();
    int tid_ = F.tid(); asm volatile("" : "+v"(tid_)); const int tid = tid_, w = tid >> 6, lane = tid & 63; const LAS int* blk = (const LAS int*)(F.lds + L_BLK);
    if (l < NL) win_requant(F, l, w, lane);
    for (int u = blockIdx.x; u < 256; u += gridDim.x) {
        const int b = u >> 5, tok0 = u * 128 + w * 16;
        f32x4 gv[4], sv[4], g2v[4];
#pragma unroll
        for (int j = 0; j < 4; ++j) { const int col = lane * 4 + 256 * j;
            if (l < NL) { const float* m = F.MOD() + ((size_t)l * 8 + b) * 6144; const f32x4 g = *(const f32x4*)(F.n1g() + l * 1024 + col), sc = *(const f32x4*)(m + 1024 + col); gv[j] = g * (sc + 1.0f); sv[j] = *(const f32x4*)(m + col); }
            else { gv[j] = *(const f32x4*)(F.fgain() + col); sv[j] = (f32x4){0.f, 0.f, 0.f, 0.f}; }
            g2v[j] = l > 0 ? *(const f32x4*)(F.MOD() + ((size_t)(l - 1) * 8 + b) * 6144 + 5120 + col) : (f32x4){0.f, 0.f, 0.f, 0.f}; }
        if (l == 0) {
            f32x4 xn[4];
#pragma unroll
            for (int j = 0; j < 4; ++j) xn[j] = *(const f32x4*)(F.x_in() + (size_t)tok0 * D + lane * 4 + 256 * j);
#pragma unroll 1
            for (int i = 0; i < 16; ++i) { f32x4 x[4];
#pragma unroll
                for (int j = 0; j < 4; ++j) x[j] = xn[j];
                if (i < 15) {
#pragma unroll
                    for (int j = 0; j < 4; ++j) xn[j] = *(const f32x4*)(F.x_in() + (size_t)(tok0 + i + 1) * D + lane * 4 + 256 * j); }
                p1_finish(F, l, tok0 + i, lane, x, gv, sv); }
        } else {
            i32x4 ra = *(const i32x4*)(F.ROUTE() + (size_t)tok0 * 8), rb = *(const i32x4*)(F.ROUTE() + (size_t)tok0 * 8 + 4);
            P1Row nx; p1_issue(F, nx, ra, rb, blk, tok0, lane);
            ra = *(const i32x4*)(F.ROUTE() + (size_t)(tok0 + 1) * 8); rb = *(const i32x4*)(F.ROUTE() + (size_t)(tok0 + 1) * 8 + 4);
#pragma unroll 1
            for (int i = 0; i < 16; ++i) { const int t = tok0 + i; const P1Row cu = nx;
                if (i < 15) { p1_issue(F, nx, ra, rb, blk, t + 1, lane);
                    if (i < 14) { ra = *(const i32x4*)(F.ROUTE() + (size_t)(t + 2) * 8); rb = *(const i32x4*)(F.ROUTE() + (size_t)(t + 2) * 8 + 4); } }
                f32x4 x[4];
#pragma unroll
                for (int j = 0; j < 4; ++j) { const u32x2 xv = cu.xb[j]; const f32x4 a = up4_fp8(cu.ya[j]), c = up4_fp8(cu.yc[j]);
                    const f32x4 m = a * cu.w0 + c * cu.w1;
                    x[j] = (f32x4){bflo(xv[0]), bfhi(xv[0]), bflo(xv[1]), bfhi(xv[1])} + g2v[j] * m;
                    if (l < NL) { u32x2 xo; xo[0] = pk2(x[j][0], x[j][1]); xo[1] = pk2(x[j][2], x[j][3]); THIN_ST((u32x2*)(F.XB() + (size_t)t * D + lane * 4 + 256 * j), xo); } }
                p1_finish(F, l, t, lane, x, gv, sv); }
        }
    }
}

struct ChunkRegs { u32x4 v[4]; f32x2 g[8]; unsigned q[8], k[8]; };
template <bool WITH_Q> __device__ __forceinline__ void chunk_load(const FP& F, ChunkRegs& R, int tok0, int h, int tid) {
    const int kp = tid & 31, seg = tid >> 5;
#pragma unroll
    for (int i = 0; i < 4; ++i) { const int id = tid + 512 * i, row = id >> 4, ch = id & 15; R.v[i] = *(const u32x4*)(F.PROJ() + (size_t)(tok0 + row) * NPJ + 1536 + h * 128 + ch * 8); }
#pragma unroll
    for (int i = 0; i < 8; ++i) { const size_t t = (size_t)(tok0 + seg * 8 + i); { const unsigned gg = *(const unsigned*)(F.GATE() + t * 256 + h * 64 + 2 * kp); R.g[i] = (f32x2){bflo(gg), bfhi(gg)}; } const bf16_t* pr = F.PROJ() + t * NPJ + h * 64 + 2 * kp; R.k[i] = *(const unsigned*)(pr + 1280); if (WITH_Q) R.q[i] = *(const unsigned*)(pr + 1024); }
}
struct ChunkPre { u32x4 v[4]; f32x2 g[8]; };
__device__ __forceinline__ void chunk_pre(const FP& F, ChunkPre& R, int tok0, int h, int tid) {
    const int kp = tid & 31, seg = tid >> 5;
#pragma unroll
    for (int i = 0; i < 4; ++i) { const int id = tid + 512 * i, row = id >> 4, ch = id & 15; R.v[i] = *(const u32x4*)(F.PROJ() + (size_t)(tok0 + row) * NPJ + 1536 + h * 128 + ch * 8); }
#pragma unroll
    for (int i = 0; i < 8; ++i) { const unsigned gg = *(const unsigned*)(F.GATE() + (size_t)(tok0 + seg * 8 + i) * 256 + h * 64 + 2 * kp); R.g[i] = (f32x2){bflo(gg), bfhi(gg)}; }
}
__device__ __forceinline__ void chunk_cumsum(LAS float* sSeg, f32x2 (&g)[8], f32x2& pre, f32x2& tot, f32x2& ref, int tid) {
    const int kp = tid & 31, seg = tid >> 5;
#pragma unroll
    for (int i = 1; i < 8; ++i) g[i] += g[i - 1];
    *(LAS f32x2*)(sSeg + seg * 64 + 2 * kp) = g[7];
    LDS_BAR();
    pre = (f32x2){0.f, 0.f}; tot = pre; ref = pre;
#pragma unroll
    for (int s = 0; s < 16; ++s) { const f32x2 v = *(const LAS f32x2*)(sSeg + s * 64 + 2 * kp); tot += v; if (s < seg) pre += v; if (s < 8) ref += v; }
}

__device__ __forceinline__ void p3_agg_sgu(const FP& F0, int l) {
    const FP F = F0.fresh();
    int tid_ = F.tid(); asm volatile("" : "+v"(tid_)); const int tid = tid_, w = tid >> 6, lane = tid & 63; LAS unsigned char* sc = F.lds + SCR_OFF;
    LAS unsigned char* sV = sc; LAS unsigned char* sK = sc + 36864; LAS float* sSeg = (LAS float*)(sc + 57344); LAS float* sDec = sSeg + 1024;
    LAS unsigned char* sVn = sc + 61696; LAS float* sRstd = (LAS float*)(sc + 98560);
    LAS float* sAvg = (LAS float*)(sc + 99072); LAS float* sBs = (LAS float*)(sc + 101120);
    { const float ga = F.avg()[l * 512 + tid], gb = F.abs_()[l * 512 + tid]; sAvg[tid] = ga; sBs[tid] = gb; }
    const int tt = 16 * w + (lane & 15);
    for (int unit = blockIdx.x; unit < 256; unit += gridDim.x) {
        const int bh = unit >> 3, j = unit & 7, b = bh >> 2, h = bh & 3, tokb = b * SEQ + j * 512, tok0 = unit * 128;
        f32x4 acc[4]; f32x2 bsum = (f32x2){0.f, 0.f};
#pragma unroll
        for (int n = 0; n < 4; ++n) acc[n] = (f32x4){0.f, 0.f, 0.f, 0.f};
        ChunkPre nx; chunk_pre(F, nx, tokb, h, tid);
        unsigned nk[8];
        { const int kp = tid & 31, seg = tid >> 5;
#pragma unroll
          for (int i = 0; i < 8; ++i) nk[i] = *(const unsigned*)(F.PROJ() + (size_t)(tokb + seg * 8 + i) * NPJ + 1280 + h * 64 + 2 * kp); }
        u32x4 vc[4];
#pragma unroll
        for (int i = 0; i < 4; ++i) { const int id = tid + 512 * i, row = id >> 4, ch = id & 15; vc[i] = *(const u32x4*)(F.PROJ() + (size_t)(tok0 + row) * NPJ + 512 + ch * 8); }
        if (tid < 128) { const f32x4 p0 = *(const f32x4*)(F.AVSQ() + (size_t)(tok0 + tid) * 8), p1 = *(const f32x4*)(F.AVSQ() + (size_t)(tok0 + tid) * 8 + 4);
            sRstd[tid] = frsq((((p0[0] + p0[1]) + (p0[2] + p0[3])) + ((p1[0] + p1[1]) + (p1[2] + p1[3]))) * (1.f / 512.f) + EPS); }
        LDS_BAR();
#pragma unroll 1
        for (int it = 0; it < 4; ++it) {
            ChunkRegs cu;
#pragma unroll
            for (int i = 0; i < 4; ++i) cu.v[i] = nx.v[i];
#pragma unroll
            for (int i = 0; i < 8; ++i) cu.g[i] = nx.g[i];
#pragma unroll
            for (int i = 0; i < 8; ++i) cu.k[i] = nk[i];
            if (it < 3) chunk_pre(F, nx, tokb + (it + 1) * 128, h, tid);
            const bf16_t* wrow = F.WSB() + ((size_t)(l * 4 + it) * 128 + tt) * 128 + 8 * (lane >> 4);
            u32x4 au[4];
#pragma unroll
            for (int a = 0; a < 4; ++a) au[a] = *(const u32x4*)(F.PROJ() + (size_t)(tok0 + tt) * NPJ + it * 128 + 32 * a + 8 * (lane >> 4));
            const float bs = sBs[it * 128 + tt];
#pragma unroll
            for (int i = 0; i < 4; ++i) { const int id = tid + 512 * i, row = id >> 4, ch = id & 15; *(LAS u32x4*)(sV + row * 288 + ch * 16) = cu.v[i]; }
#pragma unroll
            for (int i = 0; i < 4; ++i) { const int id = tid + 512 * i, row = id >> 4, ch = id & 15; const u32x4 v = vc[i]; const float rs = sRstd[row];
                const f32x4 g0 = *(const LAS f32x4*)(sAvg + it * 128 + ch * 8), g1 = *(const LAS f32x4*)(sAvg + it * 128 + ch * 8 + 4);
                u32x4 o; o[0] = pk2(bflo(v[0]) * rs * g0[0], bfhi(v[0]) * rs * g0[1]); o[1] = pk2(bflo(v[1]) * rs * g0[2], bfhi(v[1]) * rs * g0[3]);
                o[2] = pk2(bflo(v[2]) * rs * g1[0], bfhi(v[2]) * rs * g1[1]); o[3] = pk2(bflo(v[3]) * rs * g1[2], bfhi(v[3]) * rs * g1[3]);
                *(LAS u32x4*)(sVn + row * 288 + ch * 16) = o; }
            if (it < 3) {
#pragma unroll
                for (int i = 0; i < 4; ++i) { const int id = tid + 512 * i, row = id >> 4, ch = id & 15; vc[i] = *(const u32x4*)(F.PROJ() + (size_t)(tok0 + row) * NPJ + 512 + (it + 1) * 128 + ch * 8); } }
            f32x2 pre, tot, ref; chunk_cumsum(sSeg, cu.g, pre, tot, ref, tid);
            bf16x8 wf[4];
#pragma unroll
            for (int ks = 0; ks < 4; ++ks) wf[ks] = *(const bf16x8*)(wrow + 32 * ks);
            { const int kp = tid & 31, seg = tid >> 5;
#pragma unroll
              for (int i = 0; i < 8; ++i) { const int t = seg * 8 + i; const f32x2 bc = pre + cu.g[i];
                  *(LAS unsigned*)(sK + t * 160 + kp * 4) = pk2(bflo(cu.k[i]) * fexp(tot[0] - bc[0]), bfhi(cu.k[i]) * fexp(tot[1] - bc[1])); }
              if (seg == 0) *(LAS f32x2*)(sDec + 2 * kp) = (f32x2){fexp(tot[0]), fexp(tot[1])};
              if (it < 3) {
#pragma unroll
                  for (int i = 0; i < 8; ++i) nk[i] = *(const unsigned*)(F.PROJ() + (size_t)(tokb + (it + 1) * 128 + seg * 8 + i) * NPJ + 1280 + h * 64 + 2 * kp); } }
            bsum += tot;
            { f32x4 z[8];
#pragma unroll
              for (int m = 0; m < 8; ++m) z[m] = (f32x4){0.f, 0.f, 0.f, 0.f};
#pragma unroll
              for (int ks = 0; ks < 4; ++ks) if (32 * ks <= 16 * w + 15) {
#pragma unroll
                  for (int hf = 0; hf < 2; ++hf) { bf16x8 vf[4];
#pragma unroll
                      for (int m = 0; m < 4; ++m) vf[m] = tr_frag_p8(sVn, 288, 32 * ks, 4 * hf + m, lane);
                      PIN4(vf);
#pragma unroll
                      for (int m = 0; m < 4; ++m) z[4 * hf + m] = mfma16(vf[m], wf[ks], z[4 * hf + m]); } }
#pragma unroll
              for (int a = 0; a < 4; ++a) { const int col = it * 128 + 32 * a + 8 * (lane >> 4);
                  u32x4 o; o[0] = pk2(bflo(au[a][0]) * (z[2 * a][0] + bs), bfhi(au[a][0]) * (z[2 * a][1] + bs)); o[1] = pk2(bflo(au[a][1]) * (z[2 * a][2] + bs), bfhi(au[a][1]) * (z[2 * a][3] + bs));
                  o[2] = pk2(bflo(au[a][2]) * (z[2 * a + 1][0] + bs), bfhi(au[a][2]) * (z[2 * a + 1][1] + bs)); o[3] = pk2(bflo(au[a][3]) * (z[2 * a + 1][2] + bs), bfhi(au[a][3]) * (z[2 * a + 1][3] + bs));
                  THIN_ST((u32x4*)(F.Y() + (size_t)(tok0 + tt) * D + col), o); } }
            LDS_BAR();
#pragma unroll
            for (int n = 0; n < 4; ++n) acc[n] = acc[n] * sDec[16 * n + (lane & 15)];
#pragma unroll
            for (int ks = 0; ks < 4; ++ks) { bf16x8 a = tr_frag(sV, 288, 32 * ks, 16 * w, lane), kb[4];
#pragma unroll
                for (int n = 0; n < 4; ++n) kb[n] = tr_frag(sK, 160, 32 * ks, 16 * n, lane);
                asm volatile("" : "+v"(a), "+v"(kb[0]), "+v"(kb[1]), "+v"(kb[2]), "+v"(kb[3]));
#pragma unroll
                for (int n = 0; n < 4; ++n) acc[n] = mfma16(a, kb[n], acc[n]); }
            LDS_BAR();
        }
        float* kv = F.KV() + (size_t)unit * 8192 + (16 * w + 4 * (lane >> 4)) * 64 + (lane & 15);
#pragma unroll
        for (int n = 0; n < 4; ++n)
#pragma unroll
            for (int r = 0; r < 4; ++r) kv[r * 64 + 16 * n] = acc[n][r];
        if (tid < 32) *(f32x2*)(F.DEC() + (size_t)unit * 64 + 2 * tid) = (f32x2){fexp(bsum[0]), fexp(bsum[1])};
    }
}

__device__ __forceinline__ void p5_gla_seq(const FP& F0, int l) {
    const FP F = F0.fresh();
    int tid_ = F.tid(); asm volatile("" : "+v"(tid_)); const int tid = tid_, w = tid >> 6, lane = tid & 63, fr = lane & 15, fg = lane >> 4; LAS unsigned char* sc = F.lds + SCR_OFF;
    LAS unsigned char* sV = sc; LAS unsigned char* sQ = sc + 36864; LAS unsigned char* sKt = sc + 55296; LAS unsigned char* sS = sc + 73728; LAS unsigned char* sP = sc + 92160;
    LAS float* sSeg = (LAS float*)(sc + 126976);
    LAS float* sBog = (LAS float*)(sc + 131072);
    const int tt = 16 * w + fr;
    for (int unit = blockIdx.x; unit < 256; unit += gridDim.x) {
        const int bh = unit >> 3, j = unit & 7, b = bh >> 2, h = bh & 3, tokb = b * SEQ + j * 512;
        const float bgv = F.bog()[l * 512 + h * 128 + (tid & 127)];
        ChunkPre nx; chunk_pre(F, nx, tokb, h, tid);
        f32x4 st[4];
#pragma unroll
        for (int n = 0; n < 4; ++n) st[n] = (f32x4){0.f, 0.f, 0.f, 0.f};
#pragma unroll 1
        for (int i0 = 0; i0 < j; i0 += 4) {
            f32x4 kq[4][4], dq[4];
#pragma unroll
            for (int u = 0; u < 4; ++u) { const int ui = bh * 8 + (i0 + u < j ? i0 + u : i0); const float* kv = F.KV() + (size_t)ui * 8192 + (16 * w + 4 * fg) * 64 + fr;
#pragma unroll
                for (int n = 0; n < 4; ++n) { dq[u][n] = F.DEC()[ui * 64 + 16 * n + fr];
#pragma unroll
                    for (int r = 0; r < 4; ++r) kq[u][n][r] = kv[r * 64 + 16 * n]; } }
            asm volatile("" : "+v"(kq[0][0]), "+v"(kq[0][1]), "+v"(kq[0][2]), "+v"(kq[0][3]), "+v"(kq[1][0]), "+v"(kq[1][1]), "+v"(kq[1][2]), "+v"(kq[1][3]), "+v"(kq[2][0]), "+v"(kq[2][1]), "+v"(kq[2][2]), "+v"(kq[2][3]),
                              "+v"(kq[3][0]), "+v"(kq[3][1]), "+v"(kq[3][2]), "+v"(kq[3][3]), "+v"(dq[0]), "+v"(dq[1]), "+v"(dq[2]), "+v"(dq[3]));
#pragma unroll
            for (int u = 0; u < 4; ++u) if (i0 + u < j) {
#pragma unroll
                for (int n = 0; n < 4; ++n) st[n] = st[n] * dq[u][n] + kq[u][n]; } }
        if (tid < 128) sBog[tid] = bgv;
#pragma unroll 1
        for (int c = 0; c < 4; ++c) {
            const int tok0 = tokb + c * 128;
            ChunkRegs cu; u32x4 rr[4];
#pragma unroll
            for (int i = 0; i < 4; ++i) cu.v[i] = nx.v[i];
#pragma unroll
            for (int i = 0; i < 8; ++i) cu.g[i] = nx.g[i];
            { const int kp = tid & 31, seg = tid >> 5;
#pragma unroll
              for (int i = 0; i < 8; ++i) { const bf16_t* pr = F.PROJ() + (size_t)(tok0 + seg * 8 + i) * NPJ + h * 64 + 2 * kp; cu.k[i] = *(const unsigned*)(pr + 1280); cu.q[i] = *(const unsigned*)(pr + 1024); } }
            if (c < 3) chunk_pre(F, nx, tok0 + 128, h, tid);
#pragma unroll
            for (int a = 0; a < 4; ++a) rr[a] = *(const u32x4*)(F.PROJ() + (size_t)(tok0 + tt) * NPJ + 2048 + h * 128 + 32 * a + 8 * fg);
#pragma unroll
            for (int i = 0; i < 4; ++i) { const int id = tid + 512 * i, row = id >> 4, ch = id & 15; *(LAS u32x4*)(sV + row * 288 + ch * 16) = cu.v[i]; }
            f32x2 pre, tot, ref; chunk_cumsum(sSeg, cu.g, pre, tot, ref, tid);
            float escl[4];
#pragma unroll
            for (int n = 0; n < 4; ++n) { float t2 = 0.f, r2 = 0.f;
#pragma unroll
                for (int s = 0; s < 16; ++s) { const float v = sSeg[s * 64 + 16 * n + fr]; t2 += v; if (s < 8) r2 += v; }
                escl[n] = fexp(t2 - r2); st[n] = st[n] * fexp(r2);
#pragma unroll
                for (int r = 0; r < 4; ++r) *(LAS bf16_t*)(sS + (16 * w + 4 * fg + r) * 144 + (16 * n + fr) * 2) = (bf16_t)(pk2(st[n][r], 0.f) & 0xffffu); }
            { const int kp = tid & 31, seg = tid >> 5;
#pragma unroll
              for (int i = 0; i < 8; ++i) { const int t = seg * 8 + i; const f32x2 bc = pre + cu.g[i];
                  *(LAS unsigned*)(sQ + t * 144 + kp * 4) = pk2(bflo(cu.q[i]) * fexp(bc[0] - ref[0]), bfhi(cu.q[i]) * fexp(bc[1] - ref[1]));
                  *(LAS unsigned*)(sKt + t * 144 + kp * 4) = pk2(bflo(cu.k[i]) * fexp(ref[0] - bc[0]), bfhi(cu.k[i]) * fexp(ref[1] - bc[1])); } }
            LDS_BAR();
            const bf16x8 bq0 = *(const LAS bf16x8*)(sQ + tt * 144 + (8 * fg) * 2), bq1 = *(const LAS bf16x8*)(sQ + tt * 144 + (32 + 8 * fg) * 2);
#pragma unroll
            for (int g = 0; g < 2; ++g) if (4 * g <= (w | 1)) {
                bf16x8 kf[8];
#pragma unroll
                for (int q = 0; q < 4; ++q) { kf[2 * q] = *(const LAS bf16x8*)(sKt + (16 * (4 * g + q) + fr) * 144 + (8 * fg) * 2); kf[2 * q + 1] = *(const LAS bf16x8*)(sKt + (16 * (4 * g + q) + fr) * 144 + (32 + 8 * fg) * 2); }
                PIN8(kf);
#pragma unroll
                for (int q = 0; q < 4; ++q) { f32x4 a = mfma16(kf[2 * q], bq0, (f32x4){0.f, 0.f, 0.f, 0.f}); a = mfma16(kf[2 * q + 1], bq1, a);
                    const int s0 = 16 * (4 * g + q) + 4 * fg;
                    u32x2 o; o[0] = pk2(s0 <= tt ? a[0] : 0.f, s0 + 1 <= tt ? a[1] : 0.f); o[1] = pk2(s0 + 2 <= tt ? a[2] : 0.f, s0 + 3 <= tt ? a[3] : 0.f);
                    *(LAS u32x2*)(sP + tt * 272 + s0 * 2) = o; } }
            asm volatile("s_waitcnt lgkmcnt(0)" ::: "memory");
#pragma unroll 1
            for (int ks = 0; ks < 4; ++ks) { bf16x8 a = tr_frag(sV, 288, 32 * ks, 16 * w, lane), kb[4];
#pragma unroll
                for (int n = 0; n < 4; ++n) kb[n] = tr_frag(sKt, 144, 32 * ks, 16 * n, lane);
                asm volatile("" : "+v"(a), "+v"(kb[0]), "+v"(kb[1]), "+v"(kb[2]), "+v"(kb[3]));
#pragma unroll
                for (int n = 0; n < 4; ++n) st[n] = mfma16(a, kb[n], st[n]); }
#pragma unroll
            for (int n = 0; n < 4; ++n) st[n] = st[n] * escl[n];
            f32x4 acc[8];
#pragma unroll
            for (int m = 0; m < 8; ++m) acc[m] = (f32x4){0.f, 0.f, 0.f, 0.f};
#pragma unroll 1
            for (int ks = 0; ks < 4; ++ks) if (32 * ks <= 16 * w + 15) { bf16x8 bfr = *(const LAS bf16x8*)(sP + tt * 272 + (32 * ks + 8 * fg) * 2), vf[8];
#pragma unroll
                for (int m = 0; m < 8; ++m) vf[m] = tr_frag_p8(sV, 288, 32 * ks, m, lane);
                PIN8(vf); asm volatile("" : "+v"(bfr));
#pragma unroll
                for (int m = 0; m < 8; ++m) acc[m] = mfma16(vf[m], bfr, acc[m]); }
#pragma unroll
            for (int hf = 0; hf < 2; ++hf) { bf16x8 sf[8];
#pragma unroll
                for (int q = 0; q < 4; ++q) { const int vr = perm_p8(4 * hf + q, fr); sf[2 * q] = *(const LAS bf16x8*)(sS + vr * 144 + (8 * fg) * 2); sf[2 * q + 1] = *(const LAS bf16x8*)(sS + vr * 144 + (32 + 8 * fg) * 2); }
                PIN8(sf);
#pragma unroll
                for (int q = 0; q < 4; ++q) { acc[4 * hf + q] = mfma16(sf[2 * q], bq0, acc[4 * hf + q]); acc[4 * hf + q] = mfma16(sf[2 * q + 1], bq1, acc[4 * hf + q]); } }
            float ss = 0.f;
#pragma unroll
            for (int m = 0; m < 8; ++m) ss += acc[m][0] * acc[m][0] + acc[m][1] * acc[m][1] + acc[m][2] * acc[m][2] + acc[m][3] * acc[m][3];
            ss += __shfl_xor(ss, 16); ss += __shfl_xor(ss, 32);
            const float rstd = frsq(ss * (1.f / 128.f) + EPS);
#pragma unroll
            for (int a = 0; a < 4; ++a) { const int col = h * 128 + 32 * a + 8 * fg; const f32x4 g0 = *(const LAS f32x4*)(sBog + 32 * a + 8 * fg), g1 = *(const LAS f32x4*)(sBog + 32 * a + 8 * fg + 4);
                u32x4 o; o[0] = pk2(acc[2 * a][0] * rstd * g0[0] * bflo(rr[a][0]), acc[2 * a][1] * rstd * g0[1] * bfhi(rr[a][0])); o[1] = pk2(acc[2 * a][2] * rstd * g0[2] * bflo(rr[a][1]), acc[2 * a][3] * rstd * g0[3] * bfhi(rr[a][1]));
                o[2] = pk2(acc[2 * a + 1][0] * rstd * g1[0] * bflo(rr[a][2]), acc[2 * a + 1][1] * rstd * g1[1] * bfhi(rr[a][2])); o[3] = pk2(acc[2 * a + 1][2] * rstd * g1[2] * bflo(rr[a][3]), acc[2 * a + 1][3] * rstd * g1[3] * bfhi(rr[a][3]));
                THIN_ST((u32x4*)(F.Y() + (size_t)(tok0 + tt) * D + 512 + col), o); }
            LDS_BAR();
        }
    }
}

__device__ __forceinline__ void p7_norm_route(const FP& F0, int l) {
    const FP F = F0.fresh();
    int tid_ = F.tid(); asm volatile("" : "+v"(tid_)); const int tid = tid_, w = tid >> 6, lane = tid & 63, fr = lane & 15, fq = lane >> 4; LAS unsigned char* sc = F.lds + SCR_OFF;
    LAS unsigned char* sW = sc; LAS float* sG = (LAS float*)(sc + 99072); LAS float* sS = (LAS float*)(sc + 103168); LAS float* sLog = (LAS float*)(sc + 107264);
    LAS int* sCnt = (LAS int*)(sc + 131840); LAS int* sBase = sCnt + 32;
    for (int u = blockIdx.x; u < 256; u += gridDim.x) {
        const int b = u >> 5, tok0 = u * 128; const float* m = F.MOD() + ((size_t)l * 8 + b) * 6144;
        u32x4 wreg[12];
#pragma unroll
        for (int i = 0; i < 12; ++i) { const int id = tid + 512 * i, row = id >> 7, ch = id & 127; wreg[i] = *(const u32x4*)(F.WR() + ((size_t)l * 48 + row) * 1024 + ch * 8); }
        float gvv[2], svv[2];
#pragma unroll
        for (int jj = 0; jj < 2; ++jj) { const int j = tid + 512 * jj; gvv[jj] = F.n2g()[l * 1024 + j] * (1.f + m[4096 + j]); svv[jj] = m[3072 + j]; }
        const int t = tok0 + 16 * w + fr; const bf16_t* xr = F.XB() + (size_t)t * D + 16 * fq; float ss = 0.f;
#pragma unroll
        for (int q = 0; q < 4; ++q) { const f32x4 v = *(const f32x4*)(F.PSQ() + (size_t)t * 16 + 4 * q); ss += (v[0] + v[1]) + (v[2] + v[3]); }
        const float rstd = frsq(ss * (1.f / D) + EPS);
#pragma unroll
        for (int i = 0; i < 12; ++i) { const int id = tid + 512 * i, row = id >> 7, ch = id & 127; *(LAS u32x4*)(sW + row * 2064 + ch * 16) = wreg[i]; }
#pragma unroll
        for (int jj = 0; jj < 2; ++jj) { sG[tid + 512 * jj] = gvv[jj]; sS[tid + 512 * jj] = svv[jj]; }
        if (tid < 32) sCnt[tid] = 0;
        __syncthreads();
        f32x4 acc[3];
#pragma unroll
        for (int n = 0; n < 3; ++n) acc[n] = (f32x4){0.f, 0.f, 0.f, 0.f};
#pragma unroll 2
        for (int kc = 0; kc < 16; ++kc) { const int k0 = 64 * kc + 16 * fq; unsigned pk[8]; u32x4 h8;
#pragma unroll
            for (int q = 0; q < 2; ++q) { const u32x4 xv = *(const u32x4*)(xr + 64 * kc + 8 * q);
#pragma unroll
                for (int hh = 0; hh < 2; ++hh) { const f32x4 v = (f32x4){bflo(xv[2 * hh]), bfhi(xv[2 * hh]), bflo(xv[2 * hh + 1]), bfhi(xv[2 * hh + 1])};
                    const f32x4 gg = *(const LAS f32x4*)(sG + k0 + 8 * q + 4 * hh), sh = *(const LAS f32x4*)(sS + k0 + 8 * q + 4 * hh);
                    const f32x4 hv = v * rstd * gg + sh; pk[4 * q + 2 * hh] = pk2(hv[0], hv[1]); pk[4 * q + 2 * hh + 1] = pk2(hv[2], hv[3]); h8[2 * q + hh] = pk4_fp8(hv[0], hv[1], hv[2], hv[3]); } }
            u32x4 o0 = {pk[0], pk[1], pk[2], pk[3]}, o1 = {pk[4], pk[5], pk[6], pk[7]};
            THIN_ST((u32x4*)(F.H8() + (size_t)t * D + k0), h8);
            const bf16x8 a0 = __builtin_bit_cast(bf16x8, o0), a1 = __builtin_bit_cast(bf16x8, o1);
#pragma unroll
            for (int n = 0; n < 3; ++n) { LAS const unsigned char* bp = sW + (n * 16 + fr) * 2064 + k0 * 2;
                acc[n] = mfma16(a0, *(const LAS bf16x8*)bp, acc[n]); acc[n] = mfma16(a1, *(const LAS bf16x8*)(bp + 16), acc[n]); } }
#pragma unroll
        for (int n = 0; n < 3; ++n)
#pragma unroll
            for (int r = 0; r < 4; ++r) sLog[(w * 16 + 4 * fq + r) * 48 + n * 16 + fr] = acc[n][r];
        __syncthreads();
        int e0 = 0, e1 = 0, ls0 = 0, ls1 = 0; float w0 = 0.f, w1 = 0.f; const int tr_ = tok0 + 16 * w + lane;
        if (lane < 16) {
            float lg[36];
#pragma unroll
            for (int j = 0; j < 36; ++j) lg[j] = sLog[(w * 16 + lane) * 48 + j];
            float gmax = -3.0e38f; int grp = 0;
#pragma unroll
            for (int j = 0; j < 4; ++j) { lg[j] += F.b_group()[l * 4 + j]; if (lg[j] > gmax) { gmax = lg[j]; grp = j; } }
            float den = 0.f;
#pragma unroll
            for (int j = 0; j < 4; ++j) den += fexp(lg[j] - gmax);
            const float pg = 1.f / den; float m0 = -3.0e38f, m1 = -3.0e38f; int i0 = 0, i1 = 0;
#pragma unroll
            for (int j = 0; j < 8; ++j) { float v = 0.f;
#pragma unroll
                for (int gq = 0; gq < 4; ++gq) if (grp == gq) v = lg[4 + gq * 8 + j];
                v += F.b_router()[l * 32 + grp * 8 + j];
                if (v > m0) { m1 = m0; i1 = i0; m0 = v; i0 = j; } else if (v > m1) { m1 = v; i1 = j; } }
            const float ex = fexp(m1 - m0); w0 = pg / (1.f + ex); w1 = pg * ex / (1.f + ex); e0 = grp * 8 + i0; e1 = grp * 8 + i1;
            ls0 = __hip_atomic_fetch_add(sCnt + e0, 1, __ATOMIC_RELAXED, __HIP_MEMORY_SCOPE_WORKGROUP); ls1 = __hip_atomic_fetch_add(sCnt + e1, 1, __ATOMIC_RELAXED, __HIP_MEMORY_SCOPE_WORKGROUP);
        }
        __syncthreads();
        if (tid < 32) { const int cc = sCnt[tid]; sBase[tid] = cc ? __hip_atomic_fetch_add(F.CNT() + l * 32 + tid, cc, __ATOMIC_RELAXED, __HIP_MEMORY_SCOPE_AGENT) : 0; }
        __syncthreads();
        if (lane < 16) { const int s0 = sBase[e0] + ls0, s1 = sBase[e1] + ls1;
            F.TOKOF()[(size_t)e0 * 32768 + s0] = tr_; F.TOKOF()[(size_t)e1 * 32768 + s1] = tr_;
            *(i32x4*)(F.ROUTE() + (size_t)tr_ * 8) = (i32x4){e0, s0, __float_as_int(w0), e1}; *(i32x4*)(F.ROUTE() + (size_t)tr_ * 8 + 4) = (i32x4){s1, __float_as_int(w1), 0, 0}; }
        __syncthreads();
    }
}
__global__ void __launch_bounds__(512, 2) mega_fwd(Params p) {
    extern __shared__ __attribute__((aligned(16))) unsigned char lds_raw[];
    const FP F{p, (LAS unsigned char*)lds_raw, 0, __builtin_amdgcn_readfirstlane((int)(threadIdx.x >> 6))};
    for (int i = F.tid(); i < SCR_OFF / 4; i += 512) ((LAS unsigned*)F.lds)[i] = 0u;
    __syncthreads();
    (void)xcd_barrier_post((unsigned*)(p.ws + WS_CTL), (volatile LAS unsigned*)F.lds, F.tid() == 0);
#define bar XcdBarrier{(unsigned*)(p.ws + WS_CTL), xb_xcc_id(), (volatile LAS unsigned*)F.lds}, F.tid() == 0
    const int G = gridDim.x, c = blockIdx.x;
    LAS unsigned char* stage = F.lds + SCR_OFF;
    const LAS int* blk = (const LAS int*)(F.lds + L_BLK); const LAS int* cnt = (const LAS int*)(F.lds + L_CNT); const LAS int* nbp = (const LAS int*)(F.lds + L_NB);
    constexpr int QUOTA_P2 = 8, QUOTA_P9 = 4;

    convert_pull(F, 0, 1 << 30); p0_mod(F); p0_small(F);
    xcd_barrier(bar);
    for (int l = 0; l < NL; ++l) {
        p1_rows(F, l);
        xcd_barrier(bar);
        {
            const FP Fq = F.fresh();
            DenseSched S; S.nM = T / 256; S.nN = NIN / 256; S.nwg = S.nM * S.nN; S.G = G; S.c = c; S.Kb = 1024; S.Bt = (const char*)(Fq.WQ() + (size_t)l * NIN * 1024);
            EpiInProj E{Fq.PROJ(), Fq.GATE(), Fq.bba() + l * 256, Fq.AVSQ(), Fq.HS(), Fq.WQS() + l * NIN};
            pg8::gemm_phase<2>(stage, (const char*)Fq.H8I(), 1024, S, E, Fq.wv);
            if (l + 1 < NL && c >= S.nwg % G && (S.nwg % G) != 0) convert_pull(F, l + 1, QUOTA_P2);
        }
        xcd_barrier(bar);
        p3_agg_sgu(F, l);
        xcd_barrier(bar);
        p5_gla_seq(F, l);
        xcd_barrier(bar);
        {
            const FP Fq = F.fresh();
            DenseSched S; S.nM = T / 256; S.nN = 4; S.nwg = S.nM * 4; S.G = G; S.c = c; S.Kb = 2048; S.Bt = (const char*)(Fq.WOUT() + (size_t)l * 1024 * 1024);
            EpiOutProj E{l == 0 ? Fq.x_in() : nullptr, Fq.XB(), Fq.XB(), Fq.MOD() + (size_t)l * 8 * 6144 + 2048, Fq.PSQ()};
            pg8::gemm_phase<0>(stage, (const char*)Fq.Y(), 2048, S, E, Fq.wv);
        }
        xcd_barrier(bar);
        p7_norm_route(F, l);
        xcd_barrier(bar);
        moe_tables(F, l);
        {
            const FP Fq = F.fresh();
            MoeSched<true> S; S.nunits = nbp[0] * 4; S.G = G; S.c = c; S.Kb = 1024; S.blk = blk; S.cnt = cnt; S.tokof = Fq.TOKOF();
            S.W = (const char*)(Fq.W13B() + (size_t)l * 32 * 1024 * 1024); S.estride = (size_t)1024 * 1024; S.tstride = (size_t)256 * 1024;
            EpiMoe1 E{Fq.HID()};
            pg8::gemm_phase<1>(stage, (const char*)Fq.H8(), 1024, S, E, Fq.wv);
            if (l + 1 < NL && c >= S.nunits % G && (S.nunits % G) != 0) convert_pull(F, l + 1, QUOTA_P9);
        }
        xcd_barrier(bar);
        {
            const FP Fq = F.fresh();
            MoeSched<false> S; S.nunits = nbp[0] * 4; S.G = G; S.c = c; S.Kb = 512; S.blk = blk; S.cnt = cnt; S.tokof = Fq.TOKOF();
            S.W = (const char*)(Fq.W2B() + (size_t)l * 32 * 1024 * 512); S.estride = (size_t)1024 * 512; S.tstride = (size_t)256 * 512;
            EpiMoe2 E{Fq.YPAD()};
            pg8::gemm_phase<1>(stage, (const char*)Fq.HID(), 512, S, E, Fq.wv);
            if (l + 1 < NL) convert_pull(F, l + 1, 1 << 30);
        }
        xcd_barrier(bar);
    }
    p1_rows(F, NL);
}

extern "C" void kernel_launch(void* const* d_in, const int* in_sizes, int n_in, void* d_out, int out_size, void* d_ws, size_t ws_size, hipStream_t stream) {
    static int grid = 0;
    if (grid == 0) {
        if (n_in != 22 || out_size != T * D || ws_size < WS_END) { fprintf(stderr, "kernel_launch: unexpected shapes (n_in %d out %d ws %zu need %zu)\n", n_in, out_size, ws_size, (size_t)WS_END); grid = -1; return; }
        int dev = 0, cus = 0, per_cu = 0;
        if (hipGetDevice(&dev) != hipSuccess || hipDeviceGetAttribute(&cus, hipDeviceAttributeMultiprocessorCount, dev) != hipSuccess) { grid = -1; return; }
        if (hipFuncSetAttribute((const void*)mega_fwd, hipFuncAttributeMaxDynamicSharedMemorySize, LDS_BYTES) != hipSuccess) { fprintf(stderr, "kernel_launch: hipFuncSetAttribute failed\n"); grid = -1; return; }
        if (hipOccupancyMaxActiveBlocksPerMultiprocessor(&per_cu, (const void*)mega_fwd, 512, LDS_BYTES) != hipSuccess || per_cu < 1) { fprintf(stderr, "kernel_launch: occupancy query says %d\n", per_cu); }
        (void)hipGetLastError();
        grid = cus;
    }
    if (grid < 0) return;
    (void)hipMemsetAsync((char*)d_ws + WS_CTL, 0, CTL_BYTES, stream);
    Params p{};
    for (int i = 0; i < 22; ++i) p.in[i] = (const float*)d_in[i];
    p.out = (float*)d_out; p.ws = (unsigned char*)d_ws;
    hipLaunchKernelGGL(mega_fwd, dim3(grid), dim3(512), LDS_BYTES, stream, p);
}
```

```cpp
#include <hip/hip_runtime.h>
#include <stdint.h>
#include <stdio.h>

#define LAS __attribute__((address_space(3)))
typedef unsigned short bf16_t;
typedef short bf16x8 __attribute__((ext_vector_type(8)));
typedef short s16x4 __attribute__((ext_vector_type(4)));
typedef float f32x4 __attribute__((ext_vector_type(4)));
typedef float f32x2 __attribute__((ext_vector_type(2)));
typedef unsigned u32x4 __attribute__((ext_vector_type(4)));
typedef unsigned u32x2 __attribute__((ext_vector_type(2)));
typedef int i32x4 __attribute__((ext_vector_type(4)));
typedef int i32x8 __attribute__((ext_vector_type(8)));

constexpr int T = 32768, D = 1024, SEQ = 4096, NL = 4, PIN = 2576, NPJ = 2560, NIN = 2816;
constexpr int LDS_BYTES = 147456, SCR_OFF = 1024;
constexpr int L_BLK = 64, L_CNT = 256, L_NB = 384, L_QW = 448, L_BEX = 512;
constexpr float EPS = 1e-6f;
constexpr size_t al256(size_t x) { return (x + 255) & ~(size_t)255; }
constexpr size_t WS_CTL = 0, CTL_BYTES = 1 << 20, CTL_CNT = 16384, CTL_Q = 20480;
constexpr size_t WS_MOD = WS_CTL + CTL_BYTES;
constexpr size_t WS_WIN = WS_MOD + al256((size_t)4 * 8 * 6144 * 4);
constexpr size_t WS_WOUT = WS_WIN + (size_t)4 * 2816 * 1024 * 2;
constexpr size_t WS_W13 = WS_WOUT + (size_t)4 * 1024 * 1024 * 2;
constexpr size_t WS_W2 = WS_W13 + (size_t)4 * 32 * 1024 * 1024 * 2;
constexpr size_t WS_WS = WS_W2 + (size_t)4 * 32 * 1024 * 512 * 2;
constexpr size_t WS_WR = WS_WS + (size_t)4 * 4 * 128 * 128 * 2;
constexpr size_t WS_H = WS_WR + (size_t)4 * 48 * 1024 * 2;
constexpr size_t WS_PROJ = WS_H + (size_t)T * 1024 * 2;
constexpr size_t WS_GATE = WS_PROJ + (size_t)T * 2560 * 2;
constexpr size_t WS_KV = WS_GATE + (size_t)T * 256 * 4;
constexpr size_t WS_SST = WS_KV + (size_t)2048 * 8192 * 4;
constexpr size_t WS_DEC = WS_SST + (size_t)2048 * 8192 * 2;
constexpr size_t WS_Y = WS_DEC + (size_t)2048 * 64 * 4;
constexpr size_t WS_ROUTE = WS_Y + (size_t)T * 1024 * 2;
constexpr size_t WS_TOKOF = WS_ROUTE + (size_t)T * 32;
constexpr size_t WS_XB = WS_TOKOF + (size_t)32 * 32768 * 4;
constexpr size_t WS_PSQ = WS_XB + (size_t)T * 1024 * 2;
constexpr size_t WS_AVSQ = WS_PSQ + (size_t)T * 16 * 4;
constexpr size_t WS_HS = WS_AVSQ + (size_t)T * 8 * 4;
constexpr size_t WS_WQ = WS_HS + (size_t)T * 8 * 4;
constexpr size_t WS_WQS = WS_WQ + (size_t)4 * 2816 * 1024;
constexpr size_t WS_END = WS_WQS + al256((size_t)4 * 2816 * 4);
static_assert((size_t)73728 * 1024 * 2 <= (size_t)T * 2560 * 2, "YPAD alias");
static_assert((size_t)73728 * 512 * 2 <= (size_t)2048 * 8192 * 6, "HID alias");

__device__ __forceinline__ int lane_id() { int r; asm volatile("v_mbcnt_lo_u32_b32 %0, -1, 0\n\tv_mbcnt_hi_u32_b32 %0, -1, %0" : "=v"(r)); return r; }
__device__ __forceinline__ unsigned pk2(float lo, float hi) { unsigned r; asm("v_cvt_pk_bf16_f32 %0, %1, %2" : "=v"(r) : "v"(lo), "v"(hi)); return r; }
__device__ __forceinline__ float bflo(unsigned u) { return __uint_as_float(u << 16); }
__device__ __forceinline__ float bfhi(unsigned u) { return __uint_as_float(u & 0xffff0000u); }
__device__ __forceinline__ float bf1(bf16_t u) { return __uint_as_float(((unsigned)u) << 16); }
__device__ __forceinline__ float fexp(float x) { return __builtin_amdgcn_exp2f(x * 1.4426950408889634f); }
__device__ __forceinline__ float frcp(float x) { return __builtin_amdgcn_rcpf(x); }
__device__ __forceinline__ float frsq(float x) { return __builtin_amdgcn_rsqf(x); }
__device__ __forceinline__ float silu_f(float x) { return x * frcp(1.f + fexp(-x)); }
__device__ __forceinline__ float gelu_f(float x) { const float u = 1.5957691216057308f * (x + 0.044715f * x * x * x); return x * frcp(1.f + fexp(-u)); }
__device__ __forceinline__ f32x2 silu_pk(f32x2 x) { const f32x2 t = x * (-1.4426950408889634f); f32x2 e; e.x = __builtin_amdgcn_exp2f(t.x); e.y = __builtin_amdgcn_exp2f(t.y);
    const f32x2 d = e + 1.0f; f32x2 r; r.x = __builtin_amdgcn_rcpf(d.x); r.y = __builtin_amdgcn_rcpf(d.y); return x * r; }
__device__ __forceinline__ f32x2 gelu_pk(f32x2 x) { const f32x2 t = (x * x * (-0.10294324f) + (-2.3022082f)) * x; f32x2 e; e.x = __builtin_amdgcn_exp2f(t.x); e.y = __builtin_amdgcn_exp2f(t.y);
    const f32x2 d = e + 1.0f; f32x2 r; r.x = __builtin_amdgcn_rcpf(d.x); r.y = __builtin_amdgcn_rcpf(d.y); return x * r; }
__device__ __forceinline__ f32x4 silu4(f32x4 v) { const f32x2 a = silu_pk((f32x2){v[0], v[1]}), b = silu_pk((f32x2){v[2], v[3]}); return (f32x4){a.x, a.y, b.x, b.y}; }
__device__ __forceinline__ f32x4 gelu4(f32x4 v) { const f32x2 a = gelu_pk((f32x2){v[0], v[1]}), b = gelu_pk((f32x2){v[2], v[3]}); return (f32x4){a.x, a.y, b.x, b.y}; }
__device__ __forceinline__ float logsig_f(float x) { return fminf(x, 0.f) - 0.6931471805599453f * __builtin_amdgcn_logf(1.f + fexp(-fabsf(x))); }

#define XB_TMO      128
#define XB_XCNT(j)  (256  + 64 * (j))
#define XB_XSUB(j)  (1280 + 64 * (j))
#define XB_XGEN(j)  (2304 + 64 * (j))
#define XB_TOP      3328
#define XB_TOPGEN   3392
#define XCD_BAR_WORDS 3456
#define XB_SPIN_CAP (1u << 18)
__device__ __forceinline__ unsigned xb_ld(unsigned* p)              { return __hip_atomic_load(p, __ATOMIC_RELAXED, __HIP_MEMORY_SCOPE_AGENT); }
__device__ __forceinline__ unsigned xb_add(unsigned* p, unsigned v) { return __hip_atomic_fetch_add(p, v, __ATOMIC_RELAXED, __HIP_MEMORY_SCOPE_AGENT); }
__device__ __forceinline__ unsigned xb_xcc_id() { return (unsigned)__builtin_amdgcn_s_getreg((3 << 11) | 20) & 0xFu; }
#define XB_SPIN(cond, bar) do { unsigned _sp = 0; while (cond) { __builtin_amdgcn_s_sleep(1); \
    if ((++_sp & 255u) == 0u) { if (xb_ld(&(bar)[XB_TMO])) break; if (_sp > XB_SPIN_CAP) { atomicAdd(&(bar)[XB_TMO], 1u); break; } } } } while (0)
struct XcdBarrier { unsigned* bar; unsigned x; volatile LAS unsigned* st; };
__device__ __forceinline__ XcdBarrier xcd_barrier_post(unsigned* bar, volatile LAS unsigned* st, bool leader) {
    XcdBarrier b; b.bar = bar; b.x = xb_xcc_id(); b.st = st;
    if (leader) (void)xb_add(&bar[XB_XCNT(b.x)], 1u);
    return b;
}
__device__ __forceinline__ void xcd_barrier_complete(unsigned* bar, unsigned x, unsigned& nloc, unsigned& nx) {
    const unsigned G = gridDim.x * gridDim.y * gridDim.z;
    unsigned sum, cnt, mine, sp = 0u;
    for (;;) {
        sum = 0u; cnt = 0u; mine = 0u;
#pragma unroll
        for (unsigned j = 0; j < 16; ++j) { const unsigned c = xb_ld(&bar[XB_XCNT(j)]); sum += c; cnt += (c > 0u) ? 1u : 0u; mine = (j == x) ? c : mine; }
        if (sum == G) break;
        __builtin_amdgcn_s_sleep(1);
        if ((++sp & 255u) == 0u) { if (xb_ld(&bar[XB_TMO])) break; if (sp > XB_SPIN_CAP) { atomicAdd(&bar[XB_TMO], 1u); break; } }
    }
    nloc = mine > 0u ? mine : 1u; nx = cnt > 0u ? cnt : 1u;
}
__device__ __forceinline__ void xcd_barrier(const XcdBarrier& b, bool leader) {
    asm volatile("s_waitcnt vmcnt(0)" ::: "memory");
    __syncthreads();
    if (leader) {
        unsigned* bar = b.bar;
        __builtin_amdgcn_s_waitcnt(0);
        unsigned nloc = b.st[0], nx = b.st[1];
        if (nloc == 0u) { xcd_barrier_complete(bar, b.x, nloc, nx); b.st[0] = nloc; b.st[1] = nx; }
        const unsigned old = xb_add(&bar[XB_XSUB(b.x)], 1u);
        const unsigned gen = old / nloc;
        if (old + 1u == (gen + 1u) * nloc) {
            __builtin_amdgcn_fence(__ATOMIC_RELEASE, "agent");
            asm volatile("s_waitcnt vmcnt(0)" ::: "memory");
            const unsigned og = xb_add(&bar[XB_TOP], 1u);
            const unsigned tg = og / nx;
            if (og + 1u == (tg + 1u) * nx) xb_add(&bar[XB_TOPGEN], 1u);
            else XB_SPIN(xb_ld(&bar[XB_TOPGEN]) == tg, bar);
            __builtin_amdgcn_fence(__ATOMIC_ACQUIRE, "agent");
            xb_add(&bar[XB_XGEN(b.x)], 1u);
            asm volatile("s_waitcnt vmcnt(0)" ::: "memory");
        } else {
            XB_SPIN(xb_ld(&bar[XB_XGEN(b.x)]) == gen, bar);
            __builtin_amdgcn_fence(__ATOMIC_ACQUIRE, "agent");
            asm volatile("s_waitcnt vmcnt(0)" ::: "memory");
        }
    }
    __syncthreads();
}

namespace pg8 {
__device__ __forceinline__ bf16x8 as_bf16x8(i32x4 v) { return __builtin_bit_cast(bf16x8, v); }
__device__ __forceinline__ i32x4 lo4(i32x8 v) { return v.lo; }
__device__ __forceinline__ i32x4 hi4(i32x8 v) { return v.hi; }
constexpr int BM = 256, BK = 64, HALF = 128, HTB = HALF * BK * 2, STAGE_BYTES = 8 * HTB, NXCD = 8, WGM = 4;
__device__ __forceinline__ int lds_byte(int r, int c) { const int st = (r >> 4) * 2 + (c >> 5), rr = r & 15, cc = c & 31, ob = rr * 64 + cc * 2; return st * 1024 + (ob ^ (((ob >> 9) & 1) << 5)); }
__device__ __forceinline__ void stage_rc(int b, int& R, int& C) { const int st = b / 1024, sb = b % 1024, swz = sb ^ (((sb >> 9) & 1) << 5); R = (st >> 1) * 16 + swz / 64; C = (st & 1) * 32 + (swz % 64) / 2; }
__device__ __forceinline__ int perm32(int rho) { const int n = rho >> 4, i = rho & 15; return 8 * (i >> 2) + 4 * n + (i & 3); }
struct Unit { int pm, pn, e; };
__device__ __forceinline__ int xcd_remap(int L, int nwg) { const int q = nwg / NXCD, r = nwg % NXCD, xcd = L % NXCD, off = L / NXCD; return (xcd < r ? xcd * (q + 1) : r * (q + 1) + (xcd - r) * q) + off; }

template <int MODE, class Epi, class Sched>
__device__ __forceinline__ void gemm_phase(LAS unsigned char* lds, const char* Abase, const int Kb, const Sched& S, const Epi& E, const int wv) {
    int tid_ = wv * 64 + lane_id(); asm volatile("" : "+v"(tid_));
    const int tid = tid_, wid = __builtin_amdgcn_readfirstlane(tid >> 6), lane = tid & 63, wr = wid >> 2, wc = wid & 3, fr = lane & 15, fq = lane >> 4;
    constexpr bool GATHER = Sched::GATHER;
    const int nt = Kb / 128;
    int Ri[2], Ci[2]; unsigned voffB[2], voffA[2];
#pragma unroll
    for (int i = 0; i < 2; ++i) { int R, C; stage_rc(tid * 16 + i * 8192, R, C); Ri[i] = R; Ci[i] = C; const int Rb = Epi::PERM ? ((R & ~31) + perm32(R & 31)) : R; voffB[i] = (unsigned)(Rb * Kb + C * 2); voffA[i] = (unsigned)(R * Kb + C * 2); }
    const unsigned kstep = (unsigned)(BK * 2);
    const unsigned hstep = (unsigned)(HALF * Kb);
    const unsigned tstep = 2u * hstep;
    const unsigned ldsw = (unsigned)wid * 1024u;
    const int aoff = lds_byte(wr * 64 + fr, fq * 8), boff = lds_byte(wc * 32 + fr, fq * 8);
#define PG8_SA(b, h) (((b) * 2 + (h)) * HTB)
#define PG8_SB(b, h) ((4 + (b) * 2 + (h)) * HTB)
#define PG8_STAGE(bufoff, gbase, voff) do { _Pragma("unroll") for (int _i = 0; _i < 2; ++_i) \
        __builtin_amdgcn_global_load_lds((const unsigned*)((const char*)(gbase) + (voff)[_i]), (LAS unsigned*)(lds + (bufoff) + ldsw + _i * 8192), 16, 0, 0); } while (0)
#define PG8_LDA(dst, b, h) do { _Pragma("unroll") for (int m = 0; m < 4; ++m) { dst[m].lo = *(const LAS i32x4*)(lds + PG8_SA(b, h) + aoff + m * 2048); dst[m].hi = *(const LAS i32x4*)(lds + PG8_SA(b, h) + aoff + m * 2048 + 1024); } } while (0)
#define PG8_LDB(dst, b, h) do { _Pragma("unroll") for (int n = 0; n < 2; ++n) { dst[n].lo = *(const LAS i32x4*)(lds + PG8_SB(b, h) + boff + n * 2048); dst[n].hi = *(const LAS i32x4*)(lds + PG8_SB(b, h) + boff + n * 2048 + 1024); } } while (0)
#define PG8_MMA(ai, bj, At, Bt) do { __builtin_amdgcn_s_setprio(1); \
        if constexpr (MODE == 2) {   \
            _Pragma("unroll") for (int m = 0; m < 4; ++m) _Pragma("unroll") for (int n = 0; n < 2; ++n) asm volatile("v_mfma_i32_16x16x64_i8 %0, %1, %2, %0" : "+v"(acc[ai][bj][m][n]) : "v"(lo4(Bt[n])), "v"(lo4(At[m]))); \
            _Pragma("unroll") for (int m = 0; m < 4; ++m) _Pragma("unroll") for (int n = 0; n < 2; ++n) asm volatile("v_mfma_i32_16x16x64_i8 %0, %1, %2, %0" : "+v"(acc[ai][bj][m][n]) : "v"(hi4(Bt[n])), "v"(hi4(At[m]))); } \
        else _Pragma("unroll") for (int m = 0; m < 4; ++m) _Pragma("unroll") for (int n = 0; n < 2; ++n) { \
        if constexpr (MODE == 1) asm volatile("v_mfma_scale_f32_16x16x128_f8f6f4 %0, %1, %2, %0, %3, %3 op_sel_hi:[0,0,0]" : "+v"(acc[ai][bj][m][n]) : "v"(Bt[n]), "v"(At[m]), "v"(one_scale)); \
        else { acc[ai][bj][m][n] = __builtin_amdgcn_mfma_f32_16x16x32_bf16(as_bf16x8(Bt[n].lo), as_bf16x8(At[m].lo), acc[ai][bj][m][n], 0, 0, 0); \
               acc[ai][bj][m][n] = __builtin_amdgcn_mfma_f32_16x16x32_bf16(as_bf16x8(Bt[n].hi), as_bf16x8(At[m].hi), acc[ai][bj][m][n], 0, 0, 0); } } \
        __builtin_amdgcn_s_setprio(0); } while (0)
#define PG8_WAIT_V(n) asm volatile("s_waitcnt vmcnt(" #n ")" ::: "memory")
#define PG8_WAIT_L(n) asm volatile("s_waitcnt lgkmcnt(" #n ")" ::: "memory")
#define PG8_BAR __builtin_amdgcn_s_barrier()
#define PG8_SCHED __builtin_amdgcn_sched_barrier(0)
    Unit cur, nxt; int ui = 0;
    if (!S.next(0, cur)) return;
    f32x4 acc[2][2][4][2];
#pragma unroll
    for (int a = 0; a < 2; ++a)
#pragma unroll
        for (int b = 0; b < 2; ++b)
#pragma unroll
            for (int m = 0; m < 4; ++m)
#pragma unroll
                for (int n = 0; n < 2; ++n) acc[a][b][m][n] = (f32x4){0.f, 0.f, 0.f, 0.f};
    i32x8 At[4], B0[2], B1[2];
    const int one_scale = 0x7f7f7f7f;
    unsigned ao0[2], ao1[2], an0[2], an1[2];
    const char* cA0; const char* cA1;
    if constexpr (GATHER) { S.a_off(cur, Ri[0], Ci[0], ao0[0], ao1[0]); S.a_off(cur, Ri[1], Ci[1], ao0[1], ao1[1]); cA0 = Abase; cA1 = Abase; }
    else { ao0[0] = ao1[0] = an0[0] = an1[0] = voffA[0]; ao0[1] = ao1[1] = an0[1] = an1[1] = voffA[1]; cA0 = Abase + (size_t)((unsigned)cur.pm * tstep); cA1 = cA0 + hstep; }
    const char* cB = S.b_ptr(cur);
    PG8_STAGE(PG8_SB(0, 0), cB, voffB); PG8_STAGE(PG8_SB(0, 1), cB + hstep, voffB); PG8_STAGE(PG8_SA(0, 0), cA0, ao0); PG8_STAGE(PG8_SA(0, 1), cA1, ao1);
    if (wr == 1) PG8_BAR;
    PG8_WAIT_V(2); PG8_BAR;
    PG8_STAGE(PG8_SB(1, 0), cB + kstep, voffB); PG8_STAGE(PG8_SA(1, 0), cA0 + kstep, ao0); PG8_STAGE(PG8_SB(1, 1), cB + hstep + kstep, voffB);
    PG8_WAIT_V(6); PG8_BAR;
    for (;;) {
        const bool has_next = S.next(ui + 1, nxt);
        const char* nB = cB; const char* nA0 = cA0; const char* nA1 = cA1;
        if (has_next) { nB = S.b_ptr(nxt);
            if constexpr (GATHER) S.tok_stage(nxt, lds + STAGE_BYTES + 4096 + ((ui + 1) & 1) * 1024, tid, wid);
            else { nA0 = Abase + (size_t)((unsigned)nxt.pm * tstep); nA1 = nA0 + hstep; } }
        else if constexpr (GATHER) { an0[0] = ao0[0]; an0[1] = ao0[1]; an1[0] = ao1[0]; an1[1] = ao1[1]; }
        if constexpr (MODE == 2) E.stage(cur, lds + STAGE_BYTES + (ui & 1) * 2048, tid, wid);
        for (int t = 0; t < nt; t += 2) {
            const bool last = (t == nt - 2);
            const char* a1h1 = cA1 + (unsigned)(t + 1) * kstep;
            const char* a2h0 = last ? nA0 : cA0 + (unsigned)(t + 2) * kstep; const char* a2h1 = last ? nA1 : cA1 + (unsigned)(t + 2) * kstep;
            const char* b2 = last ? nB : cB + (unsigned)(t + 2) * kstep;
            const char* a3h0 = a2h0 + kstep; const char* b3 = b2 + kstep;
            unsigned x0[2], x1[2];
            if constexpr (GATHER) { if (last && has_next) { const LAS int* tk = (const LAS int*)(lds + STAGE_BYTES + 4096 + ((ui + 1) & 1) * 1024); S.a_off_lds(nxt, tk, Ri[0], Ci[0], an0[0], an1[0]); S.a_off_lds(nxt, tk, Ri[1], Ci[1], an0[1], an1[1]); } }
            if constexpr (GATHER) { x0[0] = last ? an0[0] : ao0[0]; x0[1] = last ? an0[1] : ao0[1]; x1[0] = last ? an1[0] : ao1[0]; x1[1] = last ? an1[1] : ao1[1]; }
            else { x0[0] = x1[0] = voffA[0]; x0[1] = x1[1] = voffA[1]; }
            PG8_LDB(B0, 0, 0); PG8_LDB(B1, 0, 1); PG8_SCHED; PG8_LDA(At, 0, 0); PG8_STAGE(PG8_SA(1, 1), a1h1, ao1);
            PG8_WAIT_V(8); PG8_WAIT_L(0); PG8_BAR; PG8_MMA(0, 0, At, B0); PG8_MMA(0, 1, At, B1); PG8_BAR; PG8_SCHED;
            PG8_LDA(At, 0, 1); PG8_STAGE(PG8_SB(0, 0), b2, voffB); PG8_STAGE(PG8_SB(0, 1), b2 + hstep, voffB); PG8_STAGE(PG8_SA(0, 0), a2h0, x0);
            PG8_WAIT_V(8); PG8_WAIT_L(0); PG8_BAR; PG8_MMA(1, 0, At, B0); PG8_MMA(1, 1, At, B1); PG8_BAR; PG8_SCHED;
            PG8_LDB(B0, 1, 0); PG8_LDB(B1, 1, 1); PG8_SCHED; PG8_LDA(At, 1, 0); PG8_STAGE(PG8_SA(0, 1), a2h1, x1);
            PG8_WAIT_V(8); PG8_WAIT_L(0); PG8_BAR; PG8_MMA(0, 0, At, B0); PG8_MMA(0, 1, At, B1); PG8_BAR; PG8_SCHED;
            PG8_LDA(At, 1, 1); PG8_STAGE(PG8_SB(1, 0), b3, voffB); PG8_STAGE(PG8_SB(1, 1), b3 + hstep, voffB); PG8_STAGE(PG8_SA(1, 0), a3h0, x0);
            PG8_WAIT_V(8); PG8_WAIT_L(0); PG8_BAR; PG8_MMA(1, 0, At, B0); PG8_MMA(1, 1, At, B1); PG8_BAR; PG8_SCHED;
        }
        if (wr == 0) PG8_BAR;
        if constexpr (MODE != 0) asm volatile("s_nop 15" ::: "memory");
        if constexpr (MODE == 2) E(acc, cur, wr, wc, fr, fq, (const LAS float*)(lds + STAGE_BYTES + (ui & 1) * 2048)); else E(acc, cur, wr, wc, fr, fq);
        if (!has_next) break;
#pragma unroll
        for (int a = 0; a < 2; ++a)
#pragma unroll
            for (int b = 0; b < 2; ++b)
#pragma unroll
                for (int m = 0; m < 4; ++m)
#pragma unroll
                    for (int n = 0; n < 2; ++n) acc[a][b][m][n] = (f32x4){0.f, 0.f, 0.f, 0.f};
        cur = nxt; cB = nB; cA0 = nA0; cA1 = nA1; ++ui; if constexpr (GATHER) { ao0[0] = an0[0]; ao0[1] = an0[1]; ao1[0] = an1[0]; ao1[1] = an1[1]; }
        if (wr == 1) PG8_BAR;
    }
    PG8_WAIT_V(0);
    PG8_BAR;
#undef PG8_SA
#undef PG8_SB
#undef PG8_STAGE
#undef PG8_LDA
#undef PG8_LDB
#undef PG8_MMA
#undef PG8_WAIT_V
#undef PG8_WAIT_L
#undef PG8_BAR
#undef PG8_SCHED
}
}
#define LDS_BAR() do { asm volatile("s_waitcnt lgkmcnt(0)" ::: "memory"); __builtin_amdgcn_s_barrier(); asm volatile("" ::: "memory"); } while (0)
struct Params { const float* in[22]; float* out; unsigned char* ws; };
struct FP {
    const Params& P; LAS unsigned char* lds; int zi; int wv;
    __device__ __forceinline__ FP fresh() const { int q; asm volatile("s_mov_b32 %0, 0" : "=s"(q)); return FP{P, lds, q, wv}; }
#define FP_IN(name, idx) __device__ __forceinline__ const float* name() const { return P.in[idx + zi]; }
    FP_IN(x_in, 0) FP_IN(c, 1) FP_IN(w_ada, 2) FP_IN(b_ada, 3) FP_IN(n1g, 4) FP_IN(n2g, 5) FP_IN(w_in, 6) FP_IN(avg, 7) FP_IN(aws, 8) FP_IN(abs_, 9) FP_IN(bwa, 10) FP_IN(bba, 11)
    FP_IN(bog, 12) FP_IN(w_out, 13) FP_IN(w_group, 14) FP_IN(b_group, 15) FP_IN(w_router, 16) FP_IN(b_router, 17) FP_IN(w1, 18) FP_IN(w3, 19) FP_IN(w2, 20) FP_IN(fgain, 21)
#undef FP_IN
#define FP_WS(type, name, off) __device__ __forceinline__ type* name() const { return (type*)((&P.ws)[zi] + (off)); }
    FP_WS(float, MOD, WS_MOD) FP_WS(bf16_t, WIN, WS_WIN) FP_WS(bf16_t, WOUT, WS_WOUT) FP_WS(bf16_t, W13, WS_W13) FP_WS(bf16_t, W2, WS_W2) FP_WS(bf16_t, WSB, WS_WS) FP_WS(bf16_t, WR, WS_WR)
    FP_WS(bf16_t, H, WS_H) FP_WS(bf16_t, PROJ, WS_PROJ) FP_WS(unsigned char, YPAD, WS_PROJ) FP_WS(unsigned char, HID, WS_KV) FP_WS(unsigned char, H8, WS_H) FP_WS(unsigned char, H8I, WS_H + (size_t)T * 1024) FP_WS(float, HS, WS_HS) FP_WS(unsigned char, WQ, WS_WQ) FP_WS(float, WQS, WS_WQS) FP_WS(unsigned char, W13B, WS_W13) FP_WS(unsigned char, W2B, WS_W2) FP_WS(bf16_t, SST, WS_SST) FP_WS(bf16_t, Y, WS_Y) FP_WS(bf16_t, GATE, WS_GATE)
    FP_WS(float, KV, WS_KV) FP_WS(float, DEC, WS_DEC) FP_WS(int, ROUTE, WS_ROUTE) FP_WS(int, TOKOF, WS_TOKOF) FP_WS(int, CNT, WS_CTL + CTL_CNT) FP_WS(int, QH, WS_CTL + CTL_Q) FP_WS(bf16_t, XB, WS_XB) FP_WS(float, PSQ, WS_PSQ) FP_WS(float, AVSQ, WS_AVSQ)
#undef FP_WS
    __device__ __forceinline__ float* xcur() const { return (&P.out)[zi]; }
    __device__ __forceinline__ int tid() const { return wv * 64 + lane_id(); }
};

struct DenseSched {
    static constexpr bool GATHER = false;
    int nM, nN, nwg, G, c, Kb; const char* Bt;
    __device__ __forceinline__ bool next(int i, pg8::Unit& u) const {
        const int L = i * G + c; if (L >= nwg) return false;
        const int wgid = pg8::xcd_remap(L, nwg);
        const int nig = pg8::WGM * nN, gid = wgid / nig, fm = gid * pg8::WGM, gsz = (nM - fm) < pg8::WGM ? (nM - fm) : pg8::WGM;
        u.pm = fm + ((wgid % nig) % gsz); u.pn = (wgid % nig) / gsz; u.e = 0; return true;
    }
    __device__ __forceinline__ void a_off(const pg8::Unit&, int, int, unsigned&, unsigned&) const {}
    __device__ __forceinline__ const char* b_ptr(const pg8::Unit& u) const { return Bt + (size_t)u.pn * 256 * Kb; }
};
template <bool GATHER_> struct MoeSched {
    static constexpr bool GATHER = GATHER_;
    int nunits, G, c, Kb; const LAS int* blk; const LAS int* cnt; const int* tokof; const char* W; size_t estride, tstride;
    __device__ __forceinline__ bool next(int i, pg8::Unit& u) const {
        const int L = i * G + c; if (L >= nunits) return false;
        const int wgid = pg8::xcd_remap(L, nunits);
        u.pm = wgid >> 2; u.pn = wgid & 3; u.e = (int)((const LAS unsigned char*)blk)[(L_BEX - L_BLK) + u.pm]; return true;
    }
    __device__ __forceinline__ void a_off(const pg8::Unit& u, int R, int C, unsigned& o0, unsigned& o1) const {
        const int s0 = (u.pm - blk[u.e]) * 256 + R, s1 = s0 + 128, n = cnt[u.e];
        const int t0 = s0 < n ? tokof[u.e * 32768 + s0] : 0, t1 = s1 < n ? tokof[u.e * 32768 + s1] : 0;
        o0 = (unsigned)(t0 * Kb + C * 2); o1 = (unsigned)(t1 * Kb + C * 2);
    }
    __device__ __forceinline__ void tok_stage(const pg8::Unit& u, LAS unsigned char* dst, int tid, int wid) const {
        if (wid < 4) __builtin_amdgcn_global_load_lds((const unsigned*)(tokof + u.e * 32768 + (u.pm - blk[u.e]) * 256 + tid), (LAS unsigned*)(dst + wid * 256), 4, 0, 0);
    }
    __device__ __forceinline__ void a_off_lds(const pg8::Unit& u, const LAS int* st, int R, int C, unsigned& o0, unsigned& o1) const {
        const int s0 = (u.pm - blk[u.e]) * 256 + R, s1 = s0 + 128, n = cnt[u.e];
        const int t0 = s0 < n ? st[R] : 0, t1 = s1 < n ? st[R + 128] : 0;
        o0 = (unsigned)(t0 * Kb + C * 2); o1 = (unsigned)(t1 * Kb + C * 2);
    }
    __device__ __forceinline__ const char* b_ptr(const pg8::Unit& u) const { return W + (size_t)u.e * estride + (size_t)u.pn * tstride; }
};

#define THIN_ST(p, v) (*(p) = (v))
#define EPI_ST(p, v) (*(p) = (v))
struct EpiInProj {
    static constexpr bool PERM = true;
    bf16_t* PROJ; bf16_t* GATE; const float* b_alpha; float* avsq; const float* hs; const float* wqs;
    __device__ __forceinline__ void stage(const pg8::Unit& u, LAS unsigned char* dst, int tid, int wid) const {
        const float* src = tid < 256 ? hs + (size_t)(u.pm * 256 + tid) * 8 : wqs + u.pn * 256 + (tid - 256);
        __builtin_amdgcn_global_load_lds((const unsigned*)src, (LAS unsigned*)(dst + wid * 256), 4, 0, 0);
    }
    __device__ __forceinline__ void operator()(const f32x4 (&acc)[2][2][4][2], const pg8::Unit& u, int wr, int wc, int fr, int fq, const LAS float* sc) const {
        int rl_ = wr * 64 + fr, cl_ = wc * 32 + 8 * fq; asm volatile("" : "+v"(rl_), "+v"(cl_));
        const int row0 = u.pm * 256 + rl_, cl = cl_;
        float rsv[2][4]; f32x4 csv[2][2];
#pragma unroll
        for (int ai = 0; ai < 2; ++ai)
#pragma unroll
            for (int m = 0; m < 4; ++m) rsv[ai][m] = sc[rl_ + ai * 128 + m * 16];
#pragma unroll
        for (int bj = 0; bj < 2; ++bj)
#pragma unroll
            for (int n = 0; n < 2; ++n) csv[bj][n] = *(const LAS f32x4*)(sc + 256 + bj * 128 + cl + 4 * n);
#define EIP_ACC(ai, bj, m, n) (__builtin_convertvector(__builtin_bit_cast(i32x4, acc[ai][bj][m][n]), f32x4) * csv[bj][n] * rsv[ai][m])
        if (u.pn == 10) {
#pragma unroll
            for (int bj = 0; bj < 2; ++bj) { const f32x4 b0 = *(const f32x4*)(b_alpha + bj * 128 + cl), b1 = *(const f32x4*)(b_alpha + bj * 128 + cl + 4);
#pragma unroll
                for (int ai = 0; ai < 2; ++ai)
#pragma unroll
                    for (int m = 0; m < 4; ++m) { bf16_t* gp = GATE + (size_t)(row0 + ai * 128 + m * 16) * 256 + bj * 128 + cl; f32x4 v0 = EIP_ACC(ai, bj, m, 0) + b0, v1 = EIP_ACC(ai, bj, m, 1) + b1;
#pragma unroll
                        for (int j = 0; j < 4; ++j) { v0[j] = logsig_f(v0[j]) * 0.0625f; v1[j] = logsig_f(v1[j]) * 0.0625f; }
                        u32x4 w; w.x = pk2(v0[0], v0[1]); w.y = pk2(v0[2], v0[3]); w.z = pk2(v1[0], v1[1]); w.w = pk2(v1[2], v1[3]);
                        EPI_ST((u32x4*)gp, w); } }
        } else {
            const int mode = u.pn < 4 ? 0 : (u.pn == 4 ? 1 : (u.pn < 8 ? 2 : 3));
#pragma unroll
            for (int ai = 0; ai < 2; ++ai)
#pragma unroll
                for (int m = 0; m < 4; ++m) { bf16_t* rp = PROJ + (size_t)(row0 + ai * 128 + m * 16) * NPJ + u.pn * 256 + cl; float ssq = 0.f;
#pragma unroll
                    for (int bj = 0; bj < 2; ++bj) { f32x4 v0 = EIP_ACC(ai, bj, m, 0), v1 = EIP_ACC(ai, bj, m, 1);
                        if (mode == 0) {
                            v0 = gelu4(v0); v1 = gelu4(v1);
                            ssq += v0[0] * v0[0] + v0[1] * v0[1] + v0[2] * v0[2] + v0[3] * v0[3] + v1[0] * v1[0] + v1[1] * v1[1] + v1[2] * v1[2] + v1[3] * v1[3]; }
                        else if (mode == 1) { v0 = v0 * 0.125f; v1 = v1 * 0.125f; }
                        else if (mode == 3) {
                            v0 = silu4(v0); v1 = silu4(v1); }
                        u32x4 w; w.x = pk2(v0[0], v0[1]); w.y = pk2(v0[2], v0[3]); w.z = pk2(v1[0], v1[1]); w.w = pk2(v1[2], v1[3]);
                        EPI_ST((u32x4*)(rp + bj * 128), w); }
                    if (u.pn == 2 || u.pn == 3) { ssq += __shfl_xor(ssq, 16); ssq += __shfl_xor(ssq, 32);
                        if (fq == 0) avsq[(size_t)(row0 + ai * 128 + m * 16) * 8 + (u.pn - 2) * 4 + wc] = ssq; } }
        }
    }
};
#undef EIP_ACC
struct EpiOutProj {
    static constexpr bool PERM = true;
    const float* xin32; const bf16_t* xin16; bf16_t* xout; const float* g1; float* psq;
    __device__ __forceinline__ void operator()(const f32x4 (&acc)[2][2][4][2], const pg8::Unit& u, int wr, int wc, int fr, int fq) const {
        const int row0 = u.pm * 256 + wr * 64 + fr, col0 = u.pn * 256 + wc * 32 + 8 * fq; const float* gb = g1 + (size_t)(u.pm >> 4) * 6144 + col0;
        f32x4 gv[2][2];
#pragma unroll
        for (int bj = 0; bj < 2; ++bj)
#pragma unroll
            for (int n = 0; n < 2; ++n) gv[bj][n] = *(const f32x4*)(gb + bj * 128 + n * 4);
#define EOP_ROW(X0, X1, ai, m, bj) do { f32x4 x0 = (X0), x1 = (X1); x0 += gv[bj][0] * acc[ai][bj][m][0]; x1 += gv[bj][1] * acc[ai][bj][m][1]; \
            ssq += x0[0] * x0[0] + x0[1] * x0[1] + x0[2] * x0[2] + x0[3] * x0[3] + x1[0] * x1[0] + x1[1] * x1[1] + x1[2] * x1[2] + x1[3] * x1[3]; \
            u32x4 w; w.x = pk2(x0[0], x0[1]); w.y = pk2(x0[2], x0[3]); w.z = pk2(x1[0], x1[1]); w.w = pk2(x1[2], x1[3]); \
            EPI_ST((u32x4*)(xout + (size_t)(row0 + ai * 128 + m * 16) * D + col0 + bj * 128), w); } while (0)
#define EOP_PSQ(ai, m) do { ssq += __shfl_xor(ssq, 16); ssq += __shfl_xor(ssq, 32); if (fq == 0) psq[(size_t)(row0 + ai * 128 + m * 16) * 16 + u.pn * 4 + wc] = ssq; } while (0)
        if (xin32 == nullptr) {
#pragma unroll
            for (int ai = 0; ai < 2; ++ai) { u32x4 xv[4][2];
#pragma unroll
                for (int m = 0; m < 4; ++m)
#pragma unroll
                    for (int bj = 0; bj < 2; ++bj) xv[m][bj] = *(const u32x4*)(xin16 + (size_t)(row0 + ai * 128 + m * 16) * D + col0 + bj * 128);
                asm volatile("" : "+v"(xv[0][0]), "+v"(xv[0][1]), "+v"(xv[1][0]), "+v"(xv[1][1]), "+v"(xv[2][0]), "+v"(xv[2][1]), "+v"(xv[3][0]), "+v"(xv[3][1]));
#pragma unroll
                for (int m = 0; m < 4; ++m) { float ssq = 0.f;
#pragma unroll
                    for (int bj = 0; bj < 2; ++bj) { const u32x4 q = xv[m][bj];
                        EOP_ROW(((f32x4){bflo(q[0]), bfhi(q[0]), bflo(q[1]), bfhi(q[1])}), ((f32x4){bflo(q[2]), bfhi(q[2]), bflo(q[3]), bfhi(q[3])}), ai, m, bj); }
                    EOP_PSQ(ai, m); } }
        } else {
#pragma unroll
            for (int ai = 0; ai < 2; ++ai)
#pragma unroll
                for (int mh = 0; mh < 2; ++mh) { f32x4 xf[2][2][2];
#pragma unroll
                    for (int m = 0; m < 2; ++m)
#pragma unroll
                        for (int bj = 0; bj < 2; ++bj) { const float* xp = xin32 + (size_t)(row0 + ai * 128 + (2 * mh + m) * 16) * D + col0 + bj * 128; xf[m][bj][0] = *(const f32x4*)xp; xf[m][bj][1] = *(const f32x4*)(xp + 4); }
                    asm volatile("" : "+v"(xf[0][0][0]), "+v"(xf[0][0][1]), "+v"(xf[0][1][0]), "+v"(xf[0][1][1]), "+v"(xf[1][0][0]), "+v"(xf[1][0][1]), "+v"(xf[1][1][0]), "+v"(xf[1][1][1]));
#pragma unroll
                    for (int m = 0; m < 2; ++m) { float ssq = 0.f;
#pragma unroll
                        for (int bj = 0; bj < 2; ++bj) EOP_ROW(xf[m][bj][0], xf[m][bj][1], ai, (2 * mh + m), bj);
                        EOP_PSQ(ai, (2 * mh + m)); } }
        }
#undef EOP_ROW
#undef EOP_PSQ
    }
};
__device__ __forceinline__ unsigned pk4_fp8(float a, float b, float c, float d) { int r = __builtin_amdgcn_cvt_pk_fp8_f32(a, b, 0, false); r = __builtin_amdgcn_cvt_pk_fp8_f32(c, d, r, true); return (unsigned)r; }
__device__ __forceinline__ f32x4 up4_fp8(unsigned u) { const f32x2 a = __builtin_amdgcn_cvt_pk_f32_fp8((int)u, false), b = __builtin_amdgcn_cvt_pk_f32_fp8((int)u, true); return (f32x4){a[0], a[1], b[0], b[1]}; }
constexpr float W8_SCALE = 32.f, W8_INV = 1.f / 32.f;
struct EpiMoe1 {
    static constexpr bool PERM = true;
    unsigned char* HID;
    __device__ __forceinline__ void operator()(const f32x4 (&acc)[2][2][4][2], const pg8::Unit& u, int wr, int wc, int fr, int fq) const {
        const int row0 = u.pm * 256 + wr * 64 + fr, col0 = u.pn * 128 + wc * 32 + 8 * fq;
#pragma unroll
        for (int ai = 0; ai < 2; ++ai)
#pragma unroll
            for (int m = 0; m < 4; ++m) { f32x4 v0 = acc[ai][0][m][0] * W8_INV, v1 = acc[ai][0][m][1] * W8_INV; const f32x4 g0 = acc[ai][1][m][0] * W8_INV, g1 = acc[ai][1][m][1] * W8_INV;
                v0 = silu4(v0) * g0; v1 = silu4(v1) * g1;
                u32x2 w; w.x = pk4_fp8(v0[0], v0[1], v0[2], v0[3]); w.y = pk4_fp8(v1[0], v1[1], v1[2], v1[3]);
                EPI_ST((u32x2*)(HID + (size_t)(row0 + ai * 128 + m * 16) * 512 + col0), w); }
    }
};
struct EpiMoe2 {
    static constexpr bool PERM = true;
    unsigned char* YPAD;
    __device__ __forceinline__ void operator()(const f32x4 (&acc)[2][2][4][2], const pg8::Unit& u, int wr, int wc, int fr, int fq) const {
        const int row0 = u.pm * 256 + wr * 64 + fr, col0 = u.pn * 256 + wc * 32 + 8 * fq;
#pragma unroll
        for (int ai = 0; ai < 2; ++ai)
#pragma unroll
            for (int m = 0; m < 4; ++m)
#pragma unroll
                for (int bj = 0; bj < 2; ++bj) { const f32x4 v0 = acc[ai][bj][m][0] * W8_INV, v1 = acc[ai][bj][m][1] * W8_INV;
                    u32x2 w; w.x = pk4_fp8(v0[0], v0[1], v0[2], v0[3]); w.y = pk4_fp8(v1[0], v1[1], v1[2], v1[3]);
                    EPI_ST((u32x2*)(YPAD + (size_t)(row0 + ai * 128 + m * 16) * 1024 + col0 + bj * 128), w); }
    }
};

__device__ __forceinline__ bf16x8 tr_frag(LAS const unsigned char* img, int pitch, int k0, int x0, int lane) {
    LAS const unsigned char* p = img + (k0 + 8 * (lane >> 4) + ((lane & 15) >> 2)) * pitch + (x0 + 4 * (lane & 3)) * 2;
    const s16x4 a = __builtin_amdgcn_ds_read_tr16_b64_v4i16((LAS s16x4*)p), b = __builtin_amdgcn_ds_read_tr16_b64_v4i16((LAS s16x4*)(p + 4 * pitch));
    return (bf16x8){a[0], a[1], a[2], a[3], b[0], b[1], b[2], b[3]};
}
__device__ __forceinline__ bf16x8 tr_frag_p8(LAS const unsigned char* img, int pitch, int k0, int m, int lane) {
    LAS const unsigned char* p = img + (k0 + 8 * (lane >> 4) + ((lane & 15) >> 2)) * pitch + (32 * (m >> 1) + 8 * (lane & 3) + 4 * (m & 1)) * 2;
    const s16x4 a = __builtin_amdgcn_ds_read_tr16_b64_v4i16((LAS s16x4*)p), b = __builtin_amdgcn_ds_read_tr16_b64_v4i16((LAS s16x4*)(p + 4 * pitch));
    return (bf16x8){a[0], a[1], a[2], a[3], b[0], b[1], b[2], b[3]};
}
__device__ __forceinline__ int perm_p8(int m, int i) { return 32 * (m >> 1) + 8 * (i >> 2) + 4 * (m & 1) + (i & 3); }
__device__ __forceinline__ f32x4 mfma16(bf16x8 a, bf16x8 b, f32x4 c) { return __builtin_amdgcn_mfma_f32_16x16x32_bf16(a, b, c, 0, 0, 0); }
#define PIN4(x) asm volatile("" : "+v"((x)[0]), "+v"((x)[1]), "+v"((x)[2]), "+v"((x)[3]))
#define PIN8(x) asm volatile("" : "+v"((x)[0]), "+v"((x)[1]), "+v"((x)[2]), "+v"((x)[3]), "+v"((x)[4]), "+v"((x)[5]), "+v"((x)[6]), "+v"((x)[7]))
struct TrTile { const float* src; unsigned char* dst; int ldn, K, kind, k0, n0; };
__device__ __forceinline__ TrTile tr_desc(const FP& F, int l, int r) {
    TrTile t;
    if (r < 160) { t.src = F.w_in() + (size_t)l * 1024 * PIN; t.ldn = PIN; t.K = 1024; t.kind = 0; t.dst = (unsigned char*)(F.WIN() + (size_t)l * NIN * 1024); t.k0 = (r / 10) * 64; t.n0 = (r % 10) * 256; }
    else if (r < 224) { r -= 160; t.src = F.w_out() + (size_t)l * 1024 * 1024; t.ldn = 1024; t.K = 1024; t.kind = 0; t.dst = (unsigned char*)(F.WOUT() + (size_t)l * 1024 * 1024); t.k0 = (r / 4) * 64; t.n0 = (r % 4) * 256; }
    else if (r < 1248) { r -= 224; const int e = r >> 5; r &= 31; t.src = F.w1() + ((size_t)l * 32 + e) * 1024 * 512; t.ldn = 512; t.K = 1024; t.kind = 1; t.dst = F.W13B() + ((size_t)l * 32 + e) * 1024 * 1024; t.k0 = (r >> 1) * 64; t.n0 = (r & 1) * 256; }
    else if (r < 2272) { r -= 1248; const int e = r >> 5; r &= 31; t.src = F.w3() + ((size_t)l * 32 + e) * 1024 * 512; t.ldn = 512; t.K = 1024; t.kind = 2; t.dst = F.W13B() + ((size_t)l * 32 + e) * 1024 * 1024; t.k0 = (r >> 1) * 64; t.n0 = (r & 1) * 256; }
    else { r -= 2272; const int e = r >> 5; r &= 31; t.src = F.w2() + ((size_t)l * 32 + e) * 512 * 1024; t.ldn = 1024; t.K = 512; t.kind = 3; t.dst = F.W2B() + ((size_t)l * 32 + e) * 1024 * 512; t.k0 = (r >> 2) * 64; t.n0 = (r & 3) * 256; }
    return t;
}
__device__ __forceinline__ void tr_load(const TrTile& t, f32x4 (&v)[8], int tid) {
    if (t.kind == 0) { const int kp = tid >> 4, nq = (tid & 15) * 4;
#pragma unroll
        for (int i = 0; i < 4; ++i) { const float* p = t.src + (size_t)(t.k0 + 2 * kp) * t.ldn + t.n0 + nq + 64 * i; v[i] = *(const f32x4*)p; v[4 + i] = *(const f32x4*)(p + t.ldn); } }
    else { const int kq = tid >> 5, nq = (tid & 31) * 4;
#pragma unroll
        for (int i = 0; i < 2; ++i)
#pragma unroll
            for (int rr = 0; rr < 4; ++rr) v[4 * i + rr] = *(const f32x4*)(t.src + (size_t)(t.k0 + 4 * kq + rr) * t.ldn + t.n0 + nq + 128 * i); }
}
__device__ __forceinline__ void convert_pull(const FP& F0, int l, int quota) {
    const FP F = F0.fresh();
    int tid_ = F.tid(); asm volatile("" : "+v"(tid_)); const int tid = tid_; volatile LAS int* qw = (volatile LAS int*)(F.lds + L_QW);
    LAS unsigned* sT = (LAS unsigned*)(F.lds + SCR_OFF);
    __syncthreads();
    if (tid == 0) qw[0] = quota > 0 ? __hip_atomic_fetch_add(F.QH() + l * 64, 1, __ATOMIC_RELAXED, __HIP_MEMORY_SCOPE_AGENT) : 3296;
    __syncthreads();
    int r = qw[0]; f32x4 v[8]; TrTile cur;
    if (r < 3296) { cur = tr_desc(F, l, r); tr_load(cur, v, tid); }
    for (int n = 1; r < 3296; ++n) {
        if (tid == 0) qw[1] = n < quota ? __hip_atomic_fetch_add(F.QH() + l * 64, 1, __ATOMIC_RELAXED, __HIP_MEMORY_SCOPE_AGENT) : 3296;
        if (cur.kind == 0) { const int kp = tid >> 4, nq = (tid & 15) * 4;
#pragma unroll
            for (int i = 0; i < 4; ++i)
#pragma unroll
                for (int j = 0; j < 4; ++j) sT[(nq + 64 * i + j) * 33 + kp] = pk2(v[i][j], v[4 + i][j]); }
        else { const int kq = tid >> 5, nq = (tid & 31) * 4;
#pragma unroll
            for (int i = 0; i < 2; ++i)
#pragma unroll
                for (int j = 0; j < 4; ++j) sT[(nq + 128 * i + j) * 17 + kq] = pk4_fp8(v[4 * i][j] * W8_SCALE, v[4 * i + 1][j] * W8_SCALE, v[4 * i + 2][j] * W8_SCALE, v[4 * i + 3][j] * W8_SCALE); }
        LDS_BAR();
        const int rn = qw[1]; const TrTile t = cur;
        if (rn < 3296) { cur = tr_desc(F, l, rn); tr_load(cur, v, tid); }
        if (t.kind == 0) {
#pragma unroll
            for (int i = 0; i < 4; ++i) { const int id = tid + 512 * i, nl = id >> 3, kc = id & 7;
                u32x4 w; w.x = sT[nl * 33 + kc * 4]; w.y = sT[nl * 33 + kc * 4 + 1]; w.z = sT[nl * 33 + kc * 4 + 2]; w.w = sT[nl * 33 + kc * 4 + 3];
                *(u32x4*)(t.dst + ((size_t)(t.n0 + nl) * t.K + t.k0 + kc * 8) * 2) = w; } }
        else {
#pragma unroll
            for (int i = 0; i < 2; ++i) { const int id = tid + 512 * i, nl = id >> 2, kc = id & 3; const int nn = t.n0 + nl;
                const int drow = t.kind == 3 ? nn : ((nn >> 7) * 256 + (nn & 127) + (t.kind == 2 ? 128 : 0));
                u32x4 w; w.x = sT[nl * 17 + kc * 4]; w.y = sT[nl * 17 + kc * 4 + 1]; w.z = sT[nl * 17 + kc * 4 + 2]; w.w = sT[nl * 17 + kc * 4 + 3];
                *(u32x4*)(t.dst + (size_t)drow * t.K + t.k0 + kc * 16) = w; } }
        LDS_BAR();
        r = rn;
    }
    __syncthreads();
}
__device__ __forceinline__ void p0_mod(const FP& F0) {
    const FP F = F0.fresh();
    int tid_ = F.tid(); asm volatile("" : "+v"(tid_)); const int tid = tid_; LAS float* sC = (LAS float*)(F.lds + SCR_OFF); LAS float* sR = sC + 8192;
    for (int j = tid; j < 8192; j += 512) sC[j] = silu_f(F.c()[j]);
    __syncthreads();
    const int cg = tid & 31, ks = tid >> 5;
    for (int it = blockIdx.x; it < 192; it += gridDim.x) {
        const int l = it / 48, j0 = (it % 48) * 128 + cg * 4; const float* wp = F.w_ada() + ((size_t)l * 1024 + ks * 64) * 6144 + j0;
        f32x4 acc[8];
#pragma unroll
        for (int b = 0; b < 8; ++b) acc[b] = (f32x4){0.f, 0.f, 0.f, 0.f};
#pragma unroll 4
        for (int k = 0; k < 64; ++k) { const f32x4 w = *(const f32x4*)(wp + (size_t)k * 6144);
#pragma unroll
            for (int b = 0; b < 8; ++b) acc[b] += w * sC[b * 1024 + ks * 64 + k]; }
#pragma unroll
        for (int b = 0; b < 8; ++b) *(LAS f32x4*)(sR + (ks * 8 + b) * 128 + cg * 4) = acc[b];
        __syncthreads();
        for (int o = tid; o < 1024; o += 512) { const int b = o >> 7, j = o & 127; float s = F.b_ada()[l * 6144 + (it % 48) * 128 + j];
#pragma unroll
            for (int q = 0; q < 16; ++q) s += sR[(q * 8 + b) * 128 + j];
            F.MOD()[((size_t)l * 8 + b) * 6144 + (it % 48) * 128 + j] = s; }
        __syncthreads();
    }
}
__device__ __forceinline__ void p0_small(const FP& F0) {
    const FP F = F0.fresh();
    int tid_ = F.tid(); asm volatile("" : "+v"(tid_));
    const size_t gsz = (size_t)gridDim.x * 512, g0 = (size_t)blockIdx.x * 512 + tid_;
    for (size_t i = g0; i < (size_t)4 * 256 * 1024; i += gsz) { const int l = (int)(i >> 18), n = (int)((i >> 10) & 255), k = (int)(i & 1023);
        const float* wl = F.w_in() + ((size_t)l * 1024 + k) * PIN + 2560; const float* wa = F.bwa() + (size_t)l * 16 * 256 + n; float s = 0.f;
#pragma unroll
        for (int r = 0; r < 16; ++r) s += wl[r] * wa[r * 256];
        F.WIN()[((size_t)l * NIN + 2560 + n) * 1024 + k] = (bf16_t)(pk2(s, 0.f) & 0xffffu); }
    for (size_t i = g0; i < (size_t)4 * 4 * 128 * 128; i += gsz) { const int t = (int)((i >> 7) & 127), s = (int)(i & 127); F.WSB()[i] = (bf16_t)(pk2(s <= t ? F.aws()[i] : 0.f, 0.f) & 0xffffu); }
    for (size_t i = g0; i < (size_t)4 * 48 * 1024; i += gsz) { const int l = (int)(i / (48 * 1024)), n = (int)((i >> 10) % 48), k = (int)(i & 1023);
        const float v = n < 4 ? F.w_group()[((size_t)l * 1024 + k) * 4 + n] : (n < 36 ? F.w_router()[((size_t)l * 1024 + k) * 32 + (n - 4)] : 0.f);
        F.WR()[i] = (bf16_t)(pk2(v, 0.f) & 0xffffu); }
}

__device__ __forceinline__ void moe_tables(const FP& F0, int l) {
    const FP F = F0.fresh();
    LAS int* blk = (LAS int*)(F.lds + L_BLK); LAS int* cnt = (LAS int*)(F.lds + L_CNT); LAS int* nb = (LAS int*)(F.lds + L_NB);
    __syncthreads();
    const int tx = F.tid();
    if (tx < 32) cnt[tx] = __hip_atomic_load(F.CNT() + l * 32 + tx, __ATOMIC_RELAXED, __HIP_MEMORY_SCOPE_AGENT);
    __syncthreads();
    if (tx == 0) { int s = 0; for (int e = 0; e < 32; ++e) { blk[e] = s; s += (cnt[e] + 255) >> 8; } blk[32] = s; nb[0] = s; }
    __syncthreads();
    if (tx < 288) { int e = 0; while (e < 31 && blk[e + 1] <= tx) ++e; ((LAS unsigned char*)(F.lds + L_BEX))[tx] = (unsigned char)e; }
    __syncthreads();
}

struct P1Row { u32x2 xb[4]; unsigned ya[4], yc[4]; float w0, w1; };
__device__ __forceinline__ void p1_issue(const FP& F, P1Row& R, const i32x4& r0, const i32x4& r1, const LAS int* blk, int t, int lane) {
    R.w0 = __int_as_float(r0[2]); R.w1 = __int_as_float(r1[1]);
    const unsigned char* y0 = F.YPAD() + ((size_t)blk[r0[0]] * 256 + r0[1]) * 1024; const unsigned char* y1 = F.YPAD() + ((size_t)blk[r0[3]] * 256 + r1[0]) * 1024;
#pragma unroll
    for (int j = 0; j < 4; ++j) { R.xb[j] = *(const u32x2*)(F.XB() + (size_t)t * D + lane * 4 + 256 * j); R.ya[j] = *(const unsigned*)(y0 + lane * 4 + 256 * j); R.yc[j] = *(const unsigned*)(y1 + lane * 4 + 256 * j); }
}
__device__ __forceinline__ void p1_finish(const FP& F, int l, int t, int lane, f32x4 (&x)[4], const f32x4 (&gv)[4], const f32x4 (&sv)[4]) {
    float ss = 0.f;
#pragma unroll
    for (int j = 0; j < 4; ++j) ss += x[j][0] * x[j][0] + x[j][1] * x[j][1] + x[j][2] * x[j][2] + x[j][3] * x[j][3];
#pragma unroll
    for (int o = 32; o >= 1; o >>= 1) ss += __shfl_xor(ss, o);
    const float rstd = frsq(ss * (1.f / D) + EPS);
    if (l < NL) {
        f32x4 hv[4]; float am = 0.f;
#pragma unroll
        for (int j = 0; j < 4; ++j) { hv[j] = x[j] * rstd * gv[j] + sv[j]; am = fmaxf(fmaxf(am, fmaxf(fabsf(hv[j][0]), fabsf(hv[j][1]))), fmaxf(fabsf(hv[j][2]), fabsf(hv[j][3]))); }
#pragma unroll
        for (int o = 32; o >= 1; o >>= 1) am = fmaxf(am, __shfl_xor(am, o));
        const float inv = am > 0.f ? 127.f / am : 0.f;
#pragma unroll
        for (int j = 0; j < 4; ++j) { const f32x4 q = hv[j] * inv + 12582912.f;
            const unsigned o = (__float_as_uint(q[0]) & 0xffu) | ((__float_as_uint(q[1]) & 0xffu) << 8) | ((__float_as_uint(q[2]) & 0xffu) << 16) | (__float_as_uint(q[3]) << 24);
            THIN_ST((unsigned*)(F.H8I() + (size_t)t * D + lane * 4 + 256 * j), o); }
        if (lane == 0) F.HS()[(size_t)t * 8] = am * (1.f / 127.f);
    } else {
#pragma unroll
        for (int j = 0; j < 4; ++j) { const f32x4 hv = x[j] * rstd * gv[j] + sv[j]; THIN_ST((f32x4*)(F.xcur() + (size_t)t * D + lane * 4 + 256 * j), hv); }
    }
}
__device__ __forceinline__ void win_requant(const FP& F, int l, int w, int lane) {
    for (int r = blockIdx.x * 8 + w; r < NIN; r += gridDim.x * 8) {
        const bf16_t* src = F.WIN() + ((size_t)l * NIN + r) * 1024 + lane * 16;
        const u32x4 a = *(const u32x4*)src, b = *(const u32x4*)(src + 8);
        float v[16];
#pragma unroll
        for (int i = 0; i < 4; ++i) { v[2 * i] = bflo(a[i]); v[2 * i + 1] = bfhi(a[i]); v[8 + 2 * i] = bflo(b[i]); v[8 + 2 * i + 1] = bfhi(b[i]); }
        float am = 0.f;
#pragma unroll
        for (int i = 0; i < 16; ++i) am = fmaxf(am, fabsf(v[i]));
#pragma unroll
        for (int o = 32; o >= 1; o >>= 1) am = fmaxf(am, __shfl_xor(am, o));
        const float inv = am > 0.f ? 127.f / am : 0.f;
        u32x4 o;
#pragma unroll
        for (int i = 0; i < 4; ++i) { unsigned q[4];
#pragma unroll
            for (int e = 0; e < 4; ++e) q[e] = __float_as_uint(v[4 * i + e] * inv + 12582912.f);
            o[i] = (q[0] & 0xffu) | ((q[1] & 0xffu) << 8) | ((q[2] & 0xffu) << 16) | (q[3] << 24); }
        *(u32x4*)(F.WQ() + ((size_t)l * NIN + r) * 1024 + lane * 16) = o;
        if (lane == 0) F.WQS()[l * NIN + r] = am * (1.f / 127.f);
    }
}
__device__ __forceinline__ void p1_rows(const FP& F0, int l) {
    const FP F = F0.fresh();
    int tid_ = F.tid(); asm volatile("" : "+v"(tid_)); const int tid = tid_, w = tid >> 6, lane = tid & 63; const LAS int* blk = (const LAS int*)(F.lds + L_BLK);
    if (l < NL) win_requant(F, l, w, lane);
    for (int u = blockIdx.x; u < 256; u += gridDim.x) {
        const int b = u >> 5, tok0 = u * 128 + w * 16;
        f32x4 gv[4], sv[4], g2v[4];
#pragma unroll
        for (int j = 0; j < 4; ++j) { const int col = lane * 4 + 256 * j;
            if (l < NL) { const float* m = F.MOD() + ((size_t)l * 8 + b) * 6144; const f32x4 g = *(const f32x4*)(F.n1g() + l * 1024 + col), sc = *(const f32x4*)(m + 1024 + col); gv[j] = g * (sc + 1.0f); sv[j] = *(const f32x4*)(m + col); }
            else { gv[j] = *(const f32x4*)(F.fgain() + col); sv[j] = (f32x4){0.f, 0.f, 0.f, 0.f}; }
            g2v[j] = l > 0 ? *(const f32x4*)(F.MOD() + ((size_t)(l - 1) * 8 + b) * 6144 + 5120 + col) : (f32x4){0.f, 0.f, 0.f, 0.f}; }
        if (l == 0) {
            f32x4 xn[4];
#pragma unroll
            for (int j = 0; j < 4; ++j) xn[j] = *(const f32x4*)(F.x_in() + (size_t)tok0 * D + lane * 4 + 256 * j);
#pragma unroll 1
            for (int i = 0; i < 16; ++i) { f32x4 x[4];
#pragma unroll
                for (int j = 0; j < 4; ++j) x[j] = xn[j];
                if (i < 15) {
#pragma unroll
                    for (int j = 0; j < 4; ++j) xn[j] = *(const f32x4*)(F.x_in() + (size_t)(tok0 + i + 1) * D + lane * 4 + 256 * j); }
                p1_finish(F, l, tok0 + i, lane, x, gv, sv); }
        } else {
            i32x4 ra = *(const i32x4*)(F.ROUTE() + (size_t)tok0 * 8), rb = *(const i32x4*)(F.ROUTE() + (size_t)tok0 * 8 + 4);
            P1Row nx; p1_issue(F, nx, ra, rb, blk, tok0, lane);
            ra = *(const i32x4*)(F.ROUTE() + (size_t)(tok0 + 1) * 8); rb = *(const i32x4*)(F.ROUTE() + (size_t)(tok0 + 1) * 8 + 4);
#pragma unroll 1
            for (int i = 0; i < 16; ++i) { const int t = tok0 + i; const P1Row cu = nx;
                if (i < 15) { p1_issue(F, nx, ra, rb, blk, t + 1, lane);
                    if (i < 14) { ra = *(const i32x4*)(F.ROUTE() + (size_t)(t + 2) * 8); rb = *(const i32x4*)(F.ROUTE() + (size_t)(t + 2) * 8 + 4); } }
                f32x4 x[4];
#pragma unroll
                for (int j = 0; j < 4; ++j) { const u32x2 xv = cu.xb[j]; const f32x4 a = up4_fp8(cu.ya[j]), c = up4_fp8(cu.yc[j]);
                    const f32x4 m = a * cu.w0 + c * cu.w1;
                    x[j] = (f32x4){bflo(xv[0]), bfhi(xv[0]), bflo(xv[1]), bfhi(xv[1])} + g2v[j] * m;
                    if (l < NL) { u32x2 xo; xo[0] = pk2(x[j][0], x[j][1]); xo[1] = pk2(x[j][2], x[j][3]); THIN_ST((u32x2*)(F.XB() + (size_t)t * D + lane * 4 + 256 * j), xo); } }
                p1_finish(F, l, t, lane, x, gv, sv); }
        }
    }
}

struct ChunkRegs { u32x4 v[4]; f32x2 g[8]; unsigned q[8], k[8]; };
template <bool WITH_Q> __device__ __forceinline__ void chunk_load(const FP& F, ChunkRegs& R, int tok0, int h, int tid) {
    const int kp = tid & 31, seg = tid >> 5;
#pragma unroll
    for (int i = 0; i < 4; ++i) { const int id = tid + 512 * i, row = id >> 4, ch = id & 15; R.v[i] = *(const u32x4*)(F.PROJ() + (size_t)(tok0 + row) * NPJ + 1536 + h * 128 + ch * 8); }
#pragma unroll
    for (int i = 0; i < 8; ++i) { const size_t t = (size_t)(tok0 + seg * 8 + i); { const unsigned gg = *(const unsigned*)(F.GATE() + t * 256 + h * 64 + 2 * kp); R.g[i] = (f32x2){bflo(gg), bfhi(gg)}; } const bf16_t* pr = F.PROJ() + t * NPJ + h * 64 + 2 * kp; R.k[i] = *(const unsigned*)(pr + 1280); if (WITH_Q) R.q[i] = *(const unsigned*)(pr + 1024); }
}
struct ChunkPre { u32x4 v[4]; f32x2 g[8]; };
__device__ __forceinline__ void chunk_pre(const FP& F, ChunkPre& R, int tok0, int h, int tid) {
    const int kp = tid & 31, seg = tid >> 5;
#pragma unroll
    for (int i = 0; i < 4; ++i) { const int id = tid + 512 * i, row = id >> 4, ch = id & 15; R.v[i] = *(const u32x4*)(F.PROJ() + (size_t)(tok0 + row) * NPJ + 1536 + h * 128 + ch * 8); }
#pragma unroll
    for (int i = 0; i < 8; ++i) { const unsigned gg = *(const unsigned*)(F.GATE() + (size_t)(tok0 + seg * 8 + i) * 256 + h * 64 + 2 * kp); R.g[i] = (f32x2){bflo(gg), bfhi(gg)}; }
}
__device__ __forceinline__ void chunk_cumsum(LAS float* sSeg, f32x2 (&g)[8], f32x2& pre, f32x2& tot, f32x2& ref, int tid) {
    const int kp = tid & 31, seg = tid >> 5;
#pragma unroll
    for (int i = 1; i < 8; ++i) g[i] += g[i - 1];
    *(LAS f32x2*)(sSeg + seg * 64 + 2 * kp) = g[7];
    LDS_BAR();
    pre = (f32x2){0.f, 0.f}; tot = pre; ref = pre;
#pragma unroll
    for (int s = 0; s < 16; ++s) { const f32x2 v = *(const LAS f32x2*)(sSeg + s * 64 + 2 * kp); tot += v; if (s < seg) pre += v; if (s < 8) ref += v; }
}

__device__ __forceinline__ void p3_agg_sgu(const FP& F0, int l) {
    const FP F = F0.fresh();
    int tid_ = F.tid(); asm volatile("" : "+v"(tid_)); const int tid = tid_, w = tid >> 6, lane = tid & 63; LAS unsigned char* sc = F.lds + SCR_OFF;
    LAS unsigned char* sV = sc; LAS unsigned char* sK = sc + 36864; LAS float* sSeg = (LAS float*)(sc + 57344); LAS float* sDec = sSeg + 1024;
    LAS unsigned char* sVn = sc + 61696; LAS float* sRstd = (LAS float*)(sc + 98560);
    LAS float* sAvg = (LAS float*)(sc + 99072); LAS float* sBs = (LAS float*)(sc + 101120);
    { const float ga = F.avg()[l * 512 + tid], gb = F.abs_()[l * 512 + tid]; sAvg[tid] = ga; sBs[tid] = gb; }
    const int tt = 16 * w + (lane & 15);
    for (int unit = blockIdx.x; unit < 256; unit += gridDim.x) {
        const int bh = unit >> 3, j = unit & 7, b = bh >> 2, h = bh & 3, tokb = b * SEQ + j * 512, tok0 = unit * 128;
        f32x4 acc[4]; f32x2 bsum = (f32x2){0.f, 0.f};
#pragma unroll
        for (int n = 0; n < 4; ++n) acc[n] = (f32x4){0.f, 0.f, 0.f, 0.f};
        ChunkPre nx; chunk_pre(F, nx, tokb, h, tid);
        unsigned nk[8];
        { const int kp = tid & 31, seg = tid >> 5;
#pragma unroll
          for (int i = 0; i < 8; ++i) nk[i] = *(const unsigned*)(F.PROJ() + (size_t)(tokb + seg * 8 + i) * NPJ + 1280 + h * 64 + 2 * kp); }
        u32x4 vc[4];
#pragma unroll
        for (int i = 0; i < 4; ++i) { const int id = tid + 512 * i, row = id >> 4, ch = id & 15; vc[i] = *(const u32x4*)(F.PROJ() + (size_t)(tok0 + row) * NPJ + 512 + ch * 8); }
        if (tid < 128) { const f32x4 p0 = *(const f32x4*)(F.AVSQ() + (size_t)(tok0 + tid) * 8), p1 = *(const f32x4*)(F.AVSQ() + (size_t)(tok0 + tid) * 8 + 4);
            sRstd[tid] = frsq((((p0[0] + p0[1]) + (p0[2] + p0[3])) + ((p1[0] + p1[1]) + (p1[2] + p1[3]))) * (1.f / 512.f) + EPS); }
        LDS_BAR();
#pragma unroll 1
        for (int it = 0; it < 4; ++it) {
            ChunkRegs cu;
#pragma unroll
            for (int i = 0; i < 4; ++i) cu.v[i] = nx.v[i];
#pragma unroll
            for (int i = 0; i < 8; ++i) cu.g[i] = nx.g[i];
#pragma unroll
            for (int i = 0; i < 8; ++i) cu.k[i] = nk[i];
            if (it < 3) chunk_pre(F, nx, tokb + (it + 1) * 128, h, tid);
            const bf16_t* wrow = F.WSB() + ((size_t)(l * 4 + it) * 128 + tt) * 128 + 8 * (lane >> 4);
            u32x4 au[4];
#pragma unroll
            for (int a = 0; a < 4; ++a) au[a] = *(const u32x4*)(F.PROJ() + (size_t)(tok0 + tt) * NPJ + it * 128 + 32 * a + 8 * (lane >> 4));
            const float bs = sBs[it * 128 + tt];
#pragma unroll
            for (int i = 0; i < 4; ++i) { const int id = tid + 512 * i, row = id >> 4, ch = id & 15; *(LAS u32x4*)(sV + row * 288 + ch * 16) = cu.v[i]; }
#pragma unroll
            for (int i = 0; i < 4; ++i) { const int id = tid + 512 * i, row = id >> 4, ch = id & 15; const u32x4 v = vc[i]; const float rs = sRstd[row];
                const f32x4 g0 = *(const LAS f32x4*)(sAvg + it * 128 + ch * 8), g1 = *(const LAS f32x4*)(sAvg + it * 128 + ch * 8 + 4);
                u32x4 o; o[0] = pk2(bflo(v[0]) * rs * g0[0], bfhi(v[0]) * rs * g0[1]); o[1] = pk2(bflo(v[1]) * rs * g0[2], bfhi(v[1]) * rs * g0[3]);
                o[2] = pk2(bflo(v[2]) * rs * g1[0], bfhi(v[2]) * rs * g1[1]); o[3] = pk2(bflo(v[3]) * rs * g1[2], bfhi(v[3]) * rs * g1[3]);
                *(LAS u32x4*)(sVn + row * 288 + ch * 16) = o; }
            if (it < 3) {
#pragma unroll
                for (int i = 0; i < 4; ++i) { const int id = tid + 512 * i, row = id >> 4, ch = id & 15; vc[i] = *(const u32x4*)(F.PROJ() + (size_t)(tok0 + row) * NPJ + 512 + (it + 1) * 128 + ch * 8); } }
            f32x2 pre, tot, ref; chunk_cumsum(sSeg, cu.g, pre, tot, ref, tid);
            bf16x8 wf[4];
#pragma unroll
            for (int ks = 0; ks < 4; ++ks) wf[ks] = *(const bf16x8*)(wrow + 32 * ks);
            { const int kp = tid & 31, seg = tid >> 5;
#pragma unroll
              for (int i = 0; i < 8; ++i) { const int t = seg * 8 + i; const f32x2 bc = pre + cu.g[i];
                  *(LAS unsigned*)(sK + t * 160 + kp * 4) = pk2(bflo(cu.k[i]) * fexp(tot[0] - bc[0]), bfhi(cu.k[i]) * fexp(tot[1] - bc[1])); }
              if (seg == 0) *(LAS f32x2*)(sDec + 2 * kp) = (f32x2){fexp(tot[0]), fexp(tot[1])};
              if (it < 3) {
#pragma unroll
                  for (int i = 0; i < 8; ++i) nk[i] = *(const unsigned*)(F.PROJ() + (size_t)(tokb + (it + 1) * 128 + seg * 8 + i) * NPJ + 1280 + h * 64 + 2 * kp); } }
            bsum += tot;
            { f32x4 z[8];
#pragma unroll
              for (int m = 0; m < 8; ++m) z[m] = (f32x4){0.f, 0.f, 0.f, 0.f};
#pragma unroll
              for (int ks = 0; ks < 4; ++ks) if (32 * ks <= 16 * w + 15) {
#pragma unroll
                  for (int hf = 0; hf < 2; ++hf) { bf16x8 vf[4];
#pragma unroll
                      for (int m = 0; m < 4; ++m) vf[m] = tr_frag_p8(sVn, 288, 32 * ks, 4 * hf + m, lane);
                      PIN4(vf);
#pragma unroll
                      for (int m = 0; m < 4; ++m) z[4 * hf + m] = mfma16(vf[m], wf[ks], z[4 * hf + m]); } }
#pragma unroll
              for (int a = 0; a < 4; ++a) { const int col = it * 128 + 32 * a + 8 * (lane >> 4);
                  u32x4 o; o[0] = pk2(bflo(au[a][0]) * (z[2 * a][0] + bs), bfhi(au[a][0]) * (z[2 * a][1] + bs)); o[1] = pk2(bflo(au[a][1]) * (z[2 * a][2] + bs), bfhi(au[a][1]) * (z[2 * a][3] + bs));
                  o[2] = pk2(bflo(au[a][2]) * (z[2 * a + 1][0] + bs), bfhi(au[a][2]) * (z[2 * a + 1][1] + bs)); o[3] = pk2(bflo(au[a][3]) * (z[2 * a + 1][2] + bs), bfhi(au[a][3]) * (z[2 * a + 1][3] + bs));
                  THIN_ST((u32x4*)(F.Y() + (size_t)(tok0 + tt) * D + col), o); } }
            LDS_BAR();
#pragma unroll
            for (int n = 0; n < 4; ++n) acc[n] = acc[n] * sDec[16 * n + (lane & 15)];
#pragma unroll
            for (int ks = 0; ks < 4; ++ks) { bf16x8 a = tr_frag(sV, 288, 32 * ks, 16 * w, lane), kb[4];
#pragma unroll
                for (int n = 0; n < 4; ++n) kb[n] = tr_frag(sK, 160, 32 * ks, 16 * n, lane);
                asm volatile("" : "+v"(a), "+v"(kb[0]), "+v"(kb[1]), "+v"(kb[2]), "+v"(kb[3]));
#pragma unroll
                for (int n = 0; n < 4; ++n) acc[n] = mfma16(a, kb[n], acc[n]); }
            LDS_BAR();
        }
        float* kv = F.KV() + (size_t)unit * 8192 + (16 * w + 4 * (lane >> 4)) * 64 + (lane & 15);
#pragma unroll
        for (int n = 0; n < 4; ++n)
#pragma unroll
            for (int r = 0; r < 4; ++r) kv[r * 64 + 16 * n] = acc[n][r];
        if (tid < 32) *(f32x2*)(F.DEC() + (size_t)unit * 64 + 2 * tid) = (f32x2){fexp(bsum[0]), fexp(bsum[1])};
    }
}

__device__ __forceinline__ void p5_gla_seq(const FP& F0, int l) {
    const FP F = F0.fresh();
    int tid_ = F.tid(); asm volatile("" : "+v"(tid_)); const int tid = tid_, w = tid >> 6, lane = tid & 63, fr = lane & 15, fg = lane >> 4; LAS unsigned char* sc = F.lds + SCR_OFF;
    LAS unsigned char* sV = sc; LAS unsigned char* sQ = sc + 36864; LAS unsigned char* sKt = sc + 55296; LAS unsigned char* sS = sc + 73728; LAS unsigned char* sP = sc + 92160;
    LAS float* sSeg = (LAS float*)(sc + 126976);
    LAS float* sBog = (LAS float*)(sc + 131072);
    const int tt = 16 * w + fr;
    for (int unit = blockIdx.x; unit < 256; unit += gridDim.x) {
        const int bh = unit >> 3, j = unit & 7, b = bh >> 2, h = bh & 3, tokb = b * SEQ + j * 512;
        const float bgv = F.bog()[l * 512 + h * 128 + (tid & 127)];
        ChunkPre nx; chunk_pre(F, nx, tokb, h, tid);
        f32x4 st[4];
#pragma unroll
        for (int n = 0; n < 4; ++n) st[n] = (f32x4){0.f, 0.f, 0.f, 0.f};
#pragma unroll 1
        for (int i0 = 0; i0 < j; i0 += 4) {
            f32x4 kq[4][4], dq[4];
#pragma unroll
            for (int u = 0; u < 4; ++u) { const int ui = bh * 8 + (i0 + u < j ? i0 + u : i0); const float* kv = F.KV() + (size_t)ui * 8192 + (16 * w + 4 * fg) * 64 + fr;
#pragma unroll
                for (int n = 0; n < 4; ++n) { dq[u][n] = F.DEC()[ui * 64 + 16 * n + fr];
#pragma unroll
                    for (int r = 0; r < 4; ++r) kq[u][n][r] = kv[r * 64 + 16 * n]; } }
            asm volatile("" : "+v"(kq[0][0]), "+v"(kq[0][1]), "+v"(kq[0][2]), "+v"(kq[0][3]), "+v"(kq[1][0]), "+v"(kq[1][1]), "+v"(kq[1][2]), "+v"(kq[1][3]), "+v"(kq[2][0]), "+v"(kq[2][1]), "+v"(kq[2][2]), "+v"(kq[2][3]),
                              "+v"(kq[3][0]), "+v"(kq[3][1]), "+v"(kq[3][2]), "+v"(kq[3][3]), "+v"(dq[0]), "+v"(dq[1]), "+v"(dq[2]), "+v"(dq[3]));
#pragma unroll
            for (int u = 0; u < 4; ++u) if (i0 + u < j) {
#pragma unroll
                for (int n = 0; n < 4; ++n) st[n] = st[n] * dq[u][n] + kq[u][n]; } }
        if (tid < 128) sBog[tid] = bgv;
#pragma unroll 1
        for (int c = 0; c < 4; ++c) {
            const int tok0 = tokb + c * 128;
            ChunkRegs cu; u32x4 rr[4];
#pragma unroll
            for (int i = 0; i < 4; ++i) cu.v[i] = nx.v[i];
#pragma unroll
            for (int i = 0; i < 8; ++i) cu.g[i] = nx.g[i];
            { const int kp = tid & 31, seg = tid >> 5;
#pragma unroll
              for (int i = 0; i < 8; ++i) { const bf16_t* pr = F.PROJ() + (size_t)(tok0 + seg * 8 + i) * NPJ + h * 64 + 2 * kp; cu.k[i] = *(const unsigned*)(pr + 1280); cu.q[i] = *(const unsigned*)(pr + 1024); } }
            if (c < 3) chunk_pre(F, nx, tok0 + 128, h, tid);
#pragma unroll
            for (int a = 0; a < 4; ++a) rr[a] = *(const u32x4*)(F.PROJ() + (size_t)(tok0 + tt) * NPJ + 2048 + h * 128 + 32 * a + 8 * fg);
#pragma unroll
            for (int i = 0; i < 4; ++i) { const int id = tid + 512 * i, row = id >> 4, ch = id & 15; *(LAS u32x4*)(sV + row * 288 + ch * 16) = cu.v[i]; }
            f32x2 pre, tot, ref; chunk_cumsum(sSeg, cu.g, pre, tot, ref, tid);
            float escl[4];
#pragma unroll
            for (int n = 0; n < 4; ++n) { float t2 = 0.f, r2 = 0.f;
#pragma unroll
                for (int s = 0; s < 16; ++s) { const float v = sSeg[s * 64 + 16 * n + fr]; t2 += v; if (s < 8) r2 += v; }
                escl[n] = fexp(t2 - r2); st[n] = st[n] * fexp(r2);
#pragma unroll
                for (int r = 0; r < 4; ++r) *(LAS bf16_t*)(sS + (16 * w + 4 * fg + r) * 144 + (16 * n + fr) * 2) = (bf16_t)(pk2(st[n][r], 0.f) & 0xffffu); }
            { const int kp = tid & 31, seg = tid >> 5;
#pragma unroll
              for (int i = 0; i < 8; ++i) { const int t = seg * 8 + i; const f32x2 bc = pre + cu.g[i];
                  *(LAS unsigned*)(sQ + t * 144 + kp * 4) = pk2(bflo(cu.q[i]) * fexp(bc[0] - ref[0]), bfhi(cu.q[i]) * fexp(bc[1] - ref[1]));
                  *(LAS unsigned*)(sKt + t * 144 + kp * 4) = pk2(bflo(cu.k[i]) * fexp(ref[0] - bc[0]), bfhi(cu.k[i]) * fexp(ref[1] - bc[1])); } }
            LDS_BAR();
            const bf16x8 bq0 = *(const LAS bf16x8*)(sQ + tt * 144 + (8 * fg) * 2), bq1 = *(const LAS bf16x8*)(sQ + tt * 144 + (32 + 8 * fg) * 2);
#pragma unroll
            for (int g = 0; g < 2; ++g) if (4 * g <= (w | 1)) {
                bf16x8 kf[8];
#pragma unroll
                for (int q = 0; q < 4; ++q) { kf[2 * q] = *(const LAS bf16x8*)(sKt + (16 * (4 * g + q) + fr) * 144 + (8 * fg) * 2); kf[2 * q + 1] = *(const LAS bf16x8*)(sKt + (16 * (4 * g + q) + fr) * 144 + (32 + 8 * fg) * 2); }
                PIN8(kf);
#pragma unroll
                for (int q = 0; q < 4; ++q) { f32x4 a = mfma16(kf[2 * q], bq0, (f32x4){0.f, 0.f, 0.f, 0.f}); a = mfma16(kf[2 * q + 1], bq1, a);
                    const int s0 = 16 * (4 * g + q) + 4 * fg;
                    u32x2 o; o[0] = pk2(s0 <= tt ? a[0] : 0.f, s0 + 1 <= tt ? a[1] : 0.f); o[1] = pk2(s0 + 2 <= tt ? a[2] : 0.f, s0 + 3 <= tt ? a[3] : 0.f);
                    *(LAS u32x2*)(sP + tt * 272 + s0 * 2) = o; } }
            asm volatile("s_waitcnt lgkmcnt(0)" ::: "memory");
#pragma unroll 1
            for (int ks = 0; ks < 4; ++ks) { bf16x8 a = tr_frag(sV, 288, 32 * ks, 16 * w, lane), kb[4];
#pragma unroll
                for (int n = 0; n < 4; ++n) kb[n] = tr_frag(sKt, 144, 32 * ks, 16 * n, lane);
                asm volatile("" : "+v"(a), "+v"(kb[0]), "+v"(kb[1]), "+v"(kb[2]), "+v"(kb[3]));
#pragma unroll
                for (int n = 0; n < 4; ++n) st[n] = mfma16(a, kb[n], st[n]); }
#pragma unroll
            for (int n = 0; n < 4; ++n) st[n] = st[n] * escl[n];
            f32x4 acc[8];
#pragma unroll
            for (int m = 0; m < 8; ++m) acc[m] = (f32x4){0.f, 0.f, 0.f, 0.f};
#pragma unroll 1
            for (int ks = 0; ks < 4; ++ks) if (32 * ks <= 16 * w + 15) { bf16x8 bfr = *(const LAS bf16x8*)(sP + tt * 272 + (32 * ks + 8 * fg) * 2), vf[8];
#pragma unroll
                for (int m = 0; m < 8; ++m) vf[m] = tr_frag_p8(sV, 288, 32 * ks, m, lane);
                PIN8(vf); asm volatile("" : "+v"(bfr));
#pragma unroll
                for (int m = 0; m < 8; ++m) acc[m] = mfma16(vf[m], bfr, acc[m]); }
#pragma unroll
            for (int hf = 0; hf < 2; ++hf) { bf16x8 sf[8];
#pragma unroll
                for (int q = 0; q < 4; ++q) { const int vr = perm_p8(4 * hf + q, fr); sf[2 * q] = *(const LAS bf16x8*)(sS + vr * 144 + (8 * fg) * 2); sf[2 * q + 1] = *(const LAS bf16x8*)(sS + vr * 144 + (32 + 8 * fg) * 2); }
                PIN8(sf);
#pragma unroll
                for (int q = 0; q < 4; ++q) { acc[4 * hf + q] = mfma16(sf[2 * q], bq0, acc[4 * hf + q]); acc[4 * hf + q] = mfma16(sf[2 * q + 1], bq1, acc[4 * hf + q]); } }
            float ss = 0.f;
#pragma unroll
            for (int m = 0; m < 8; ++m) ss += acc[m][0] * acc[m][0] + acc[m][1] * acc[m][1] + acc[m][2] * acc[m][2] + acc[m][3] * acc[m][3];
            ss += __shfl_xor(ss, 16); ss += __shfl_xor(ss, 32);
            const float rstd = frsq(ss * (1.f / 128.f) + EPS);
#pragma unroll
            for (int a = 0; a < 4; ++a) { const int col = h * 128 + 32 * a + 8 * fg; const f32x4 g0 = *(const LAS f32x4*)(sBog + 32 * a + 8 * fg), g1 = *(const LAS f32x4*)(sBog + 32 * a + 8 * fg + 4);
                u32x4 o; o[0] = pk2(acc[2 * a][0] * rstd * g0[0] * bflo(rr[a][0]), acc[2 * a][1] * rstd * g0[1] * bfhi(rr[a][0])); o[1] = pk2(acc[2 * a][2] * rstd * g0[2] * bflo(rr[a][1]), acc[2 * a][3] * rstd * g0[3] * bfhi(rr[a][1]));
                o[2] = pk2(acc[2 * a + 1][0] * rstd * g1[0] * bflo(rr[a][2]), acc[2 * a + 1][1] * rstd * g1[1] * bfhi(rr[a][2])); o[3] = pk2(acc[2 * a + 1][2] * rstd * g1[2] * bflo(rr[a][3]), acc[2 * a + 1][3] * rstd * g1[3] * bfhi(rr[a][3]));
                THIN_ST((u32x4*)(F.Y() + (size_t)(tok0 + tt) * D + 512 + col), o); }
            LDS_BAR();
        }
    }
}

__device__ __forceinline__ void p7_norm_route(const FP& F0, int l) {
    const FP F = F0.fresh();
    int tid_ = F.tid(); asm volatile("" : "+v"(tid_)); const int tid = tid_, w = tid >> 6, lane = tid & 63, fr = lane & 15, fq = lane >> 4; LAS unsigned char* sc = F.lds + SCR_OFF;
    LAS unsigned char* sW = sc; LAS float* sG = (LAS float*)(sc + 99072); LAS float* sS = (LAS float*)(sc + 103168); LAS float* sLog = (LAS float*)(sc + 107264);
    LAS int* sCnt = (LAS int*)(sc + 131840); LAS int* sBase = sCnt + 32;
    for (int u = blockIdx.x; u < 256; u += gridDim.x) {
        const int b = u >> 5, tok0 = u * 128; const float* m = F.MOD() + ((size_t)l * 8 + b) * 6144;
        u32x4 wreg[12];
#pragma unroll
        for (int i = 0; i < 12; ++i) { const int id = tid + 512 * i, row = id >> 7, ch = id & 127; wreg[i] = *(const u32x4*)(F.WR() + ((size_t)l * 48 + row) * 1024 + ch * 8); }
        float gvv[2], svv[2];
#pragma unroll
        for (int jj = 0; jj < 2; ++jj) { const int j = tid + 512 * jj; gvv[jj] = F.n2g()[l * 1024 + j] * (1.f + m[4096 + j]); svv[jj] = m[3072 + j]; }
        const int t = tok0 + 16 * w + fr; const bf16_t* xr = F.XB() + (size_t)t * D + 16 * fq; float ss = 0.f;
#pragma unroll
        for (int q = 0; q < 4; ++q) { const f32x4 v = *(const f32x4*)(F.PSQ() + (size_t)t * 16 + 4 * q); ss += (v[0] + v[1]) + (v[2] + v[3]); }
        const float rstd = frsq(ss * (1.f / D) + EPS);
#pragma unroll
        for (int i = 0; i < 12; ++i) { const int id = tid + 512 * i, row = id >> 7, ch = id & 127; *(LAS u32x4*)(sW + row * 2064 + ch * 16) = wreg[i]; }
#pragma unroll
        for (int jj = 0; jj < 2; ++jj) { sG[tid + 512 * jj] = gvv[jj]; sS[tid + 512 * jj] = svv[jj]; }
        if (tid < 32) sCnt[tid] = 0;
        __syncthreads();
        f32x4 acc[3];
#pragma unroll
        for (int n = 0; n < 3; ++n) acc[n] = (f32x4){0.f, 0.f, 0.f, 0.f};
#pragma unroll 2
        for (int kc = 0; kc < 16; ++kc) { const int k0 = 64 * kc + 16 * fq; unsigned pk[8]; u32x4 h8;
#pragma unroll
            for (int q = 0; q < 2; ++q) { const u32x4 xv = *(const u32x4*)(xr + 64 * kc + 8 * q);
#pragma unroll
                for (int hh = 0; hh < 2; ++hh) { const f32x4 v = (f32x4){bflo(xv[2 * hh]), bfhi(xv[2 * hh]), bflo(xv[2 * hh + 1]), bfhi(xv[2 * hh + 1])};
                    const f32x4 gg = *(const LAS f32x4*)(sG + k0 + 8 * q + 4 * hh), sh = *(const LAS f32x4*)(sS + k0 + 8 * q + 4 * hh);
                    const f32x4 hv = v * rstd * gg + sh; pk[4 * q + 2 * hh] = pk2(hv[0], hv[1]); pk[4 * q + 2 * hh + 1] = pk2(hv[2], hv[3]); h8[2 * q + hh] = pk4_fp8(hv[0], hv[1], hv[2], hv[3]); } }
            u32x4 o0 = {pk[0], pk[1], pk[2], pk[3]}, o1 = {pk[4], pk[5], pk[6], pk[7]};
            THIN_ST((u32x4*)(F.H8() + (size_t)t * D + k0), h8);
            const bf16x8 a0 = __builtin_bit_cast(bf16x8, o0), a1 = __builtin_bit_cast(bf16x8, o1);
#pragma unroll
            for (int n = 0; n < 3; ++n) { LAS const unsigned char* bp = sW + (n * 16 + fr) * 2064 + k0 * 2;
                acc[n] = mfma16(a0, *(const LAS bf16x8*)bp, acc[n]); acc[n] = mfma16(a1, *(const LAS bf16x8*)(bp + 16), acc[n]); } }
#pragma unroll
        for (int n = 0; n < 3; ++n)
#pragma unroll
            for (int r = 0; r < 4; ++r) sLog[(w * 16 + 4 * fq + r) * 48 + n * 16 + fr] = acc[n][r];
        __syncthreads();
        int e0 = 0, e1 = 0, ls0 = 0, ls1 = 0; float w0 = 0.f, w1 = 0.f; const int tr_ = tok0 + 16 * w + lane;
        if (lane < 16) {
            float lg[36];
#pragma unroll
            for (int j = 0; j < 36; ++j) lg[j] = sLog[(w * 16 + lane) * 48 + j];
            float gmax = -3.0e38f; int grp = 0;
#pragma unroll
            for (int j = 0; j < 4; ++j) { lg[j] += F.b_group()[l * 4 + j]; if (lg[j] > gmax) { gmax = lg[j]; grp = j; } }
            float den = 0.f;
#pragma unroll
            for (int j = 0; j < 4; ++j) den += fexp(lg[j] - gmax);
            const float pg = 1.f / den; float m0 = -3.0e38f, m1 = -3.0e38f; int i0 = 0, i1 = 0;
#pragma unroll
            for (int j = 0; j < 8; ++j) { float v = 0.f;
#pragma unroll
                for (int gq = 0; gq < 4; ++gq) if (grp == gq) v = lg[4 + gq * 8 + j];
                v += F.b_router()[l * 32 + grp * 8 + j];
                if (v > m0) { m1 = m0; i1 = i0; m0 = v; i0 = j; } else if (v > m1) { m1 = v; i1 = j; } }
            const float ex = fexp(m1 - m0); w0 = pg / (1.f + ex); w1 = pg * ex / (1.f + ex); e0 = grp * 8 + i0; e1 = grp * 8 + i1;
            ls0 = __hip_atomic_fetch_add(sCnt + e0, 1, __ATOMIC_RELAXED, __HIP_MEMORY_SCOPE_WORKGROUP); ls1 = __hip_atomic_fetch_add(sCnt + e1, 1, __ATOMIC_RELAXED, __HIP_MEMORY_SCOPE_WORKGROUP);
        }
        __syncthreads();
        if (tid < 32) { const int cc = sCnt[tid]; sBase[tid] = cc ? __hip_atomic_fetch_add(F.CNT() + l * 32 + tid, cc, __ATOMIC_RELAXED, __HIP_MEMORY_SCOPE_AGENT) : 0; }
        __syncthreads();
        if (lane < 16) { const int s0 = sBase[e0] + ls0, s1 = sBase[e1] + ls1;
            F.TOKOF()[(size_t)e0 * 32768 + s0] = tr_; F.TOKOF()[(size_t)e1 * 32768 + s1] = tr_;
            *(i32x4*)(F.ROUTE() + (size_t)tr_ * 8) = (i32x4){e0, s0, __float_as_int(w0), e1}; *(i32x4*)(F.ROUTE() + (size_t)tr_ * 8 + 4) = (i32x4){s1, __float_as_int(w1), 0, 0}; }
        __syncthreads();
    }
}
__global__ void __launch_bounds__(512, 2) mega_fwd(Params p) {
    extern __shared__ __attribute__((aligned(16))) unsigned char lds_raw[];
    const FP F{p, (LAS unsigned char*)lds_raw, 0, __builtin_amdgcn_readfirstlane((int)(threadIdx.x >> 6))};
    for (int i = F.tid(); i < SCR_OFF / 4; i += 512) ((LAS unsigned*)F.lds)[i] = 0u;
    __syncthreads();
    (void)xcd_barrier_post((unsigned*)(p.ws + WS_CTL), (volatile LAS unsigned*)F.lds, F.tid() == 0);
#define bar XcdBarrier{(unsigned*)(p.ws + WS_CTL), xb_xcc_id(), (volatile LAS unsigned*)F.lds}, F.tid() == 0
    const int G = gridDim.x, c = blockIdx.x;
    LAS unsigned char* stage = F.lds + SCR_OFF;
    const LAS int* blk = (const LAS int*)(F.lds + L_BLK); const LAS int* cnt = (const LAS int*)(F.lds + L_CNT); const LAS int* nbp = (const LAS int*)(F.lds + L_NB);
    constexpr int QUOTA_P2 = 8, QUOTA_P9 = 4;

    convert_pull(F, 0, 1 << 30); p0_mod(F); p0_small(F);
    xcd_barrier(bar);
    for (int l = 0; l < NL; ++l) {
        p1_rows(F, l);
        xcd_barrier(bar);
        {
            const FP Fq = F.fresh();
            DenseSched S; S.nM = T / 256; S.nN = NIN / 256; S.nwg = S.nM * S.nN; S.G = G; S.c = c; S.Kb = 1024; S.Bt = (const char*)(Fq.WQ() + (size_t)l * NIN * 1024);
            EpiInProj E{Fq.PROJ(), Fq.GATE(), Fq.bba() + l * 256, Fq.AVSQ(), Fq.HS(), Fq.WQS() + l * NIN};
            pg8::gemm_phase<2>(stage, (const char*)Fq.H8I(), 1024, S, E, Fq.wv);
            if (l + 1 < NL && c >= S.nwg % G && (S.nwg % G) != 0) convert_pull(F, l + 1, QUOTA_P2);
        }
        xcd_barrier(bar);
        p3_agg_sgu(F, l);
        xcd_barrier(bar);
        p5_gla_seq(F, l);
        xcd_barrier(bar);
        {
            const FP Fq = F.fresh();
            DenseSched S; S.nM = T / 256; S.nN = 4; S.nwg = S.nM * 4; S.G = G; S.c = c; S.Kb = 2048; S.Bt = (const char*)(Fq.WOUT() + (size_t)l * 1024 * 1024);
            EpiOutProj E{l == 0 ? Fq.x_in() : nullptr, Fq.XB(), Fq.XB(), Fq.MOD() + (size_t)l * 8 * 6144 + 2048, Fq.PSQ()};
            pg8::gemm_phase<0>(stage, (const char*)Fq.Y(), 2048, S, E, Fq.wv);
        }
        xcd_barrier(bar);
        p7_norm_route(F, l);
        xcd_barrier(bar);
        moe_tables(F, l);
        {
            const FP Fq = F.fresh();
            MoeSched<true> S; S.nunits = nbp[0] * 4; S.G = G; S.c = c; S.Kb = 1024; S.blk = blk; S.cnt = cnt; S.tokof = Fq.TOKOF();
            S.W = (const char*)(Fq.W13B() + (size_t)l * 32 * 1024 * 1024); S.estride = (size_t)1024 * 1024; S.tstride = (size_t)256 * 1024;
            EpiMoe1 E{Fq.HID()};
            pg8::gemm_phase<1>(stage, (const char*)Fq.H8(), 1024, S, E, Fq.wv);
            if (l + 1 < NL && c >= S.nunits % G && (S.nunits % G) != 0) convert_pull(F, l + 1, QUOTA_P9);
        }
        xcd_barrier(bar);
        {
            const FP Fq = F.fresh();
            MoeSched<false> S; S.nunits = nbp[0] * 4; S.G = G; S.c = c; S.Kb = 512; S.blk = blk; S.cnt = cnt; S.tokof = Fq.TOKOF();
            S.W = (const char*)(Fq.W2B() + (size_t)l * 32 * 1024 * 512); S.estride = (size_t)1024 * 512; S.tstride = (size_t)256 * 512;
            EpiMoe2 E{Fq.YPAD()};
            pg8::gemm_phase<1>(stage, (const char*)Fq.HID(), 512, S, E, Fq.wv);
            if (l + 1 < NL) convert_pull(F, l + 1, 1 << 30);
        }
        xcd_barrier(bar);
    }
    p1_rows(F, NL);
}

extern "C" void kernel_launch(void* const* d_in, const int* in_sizes, int n_in, void* d_out, int out_size, void* d_ws, size_t ws_size, hipStream_t stream) {
    static int grid = 0;
    if (grid == 0) {
        if (n_in != 22 || out_size != T * D || ws_size < WS_END) { fprintf(stderr, "kernel_launch: unexpected shapes (n_in %d out %d ws %zu need %zu)\n", n_in, out_size, ws_size, (size_t)WS_END); grid = -1; return; }
        int dev = 0, cus = 0, per_cu = 0;
        if (hipGetDevice(&dev) != hipSuccess || hipDeviceGetAttribute(&cus, hipDeviceAttributeMultiprocessorCount, dev) != hipSuccess) { grid = -1; return; }
        if (hipFuncSetAttribute((const void*)mega_fwd, hipFuncAttributeMaxDynamicSharedMemorySize, LDS_BYTES) != hipSuccess) { fprintf(stderr, "kernel_launch: hipFuncSetAttribute failed\n"); grid = -1; return; }
        if (hipOccupancyMaxActiveBlocksPerMultiprocessor(&per_cu, (const void*)mega_fwd, 512, LDS_BYTES) != hipSuccess || per_cu < 1) { fprintf(stderr, "kernel_launch: occupancy query says %d\n", per_cu); }
        (void)hipGetLastError();
        grid = cus;
    }
    if (grid < 0) return;
    (void)hipMemsetAsync((char*)d_ws + WS_CTL, 0, CTL_BYTES, stream);
    Params p{};
    for (int i = 0; i < 22; ++i) p.in[i] = (const float*)d_in[i];
    p.out = (float*)d_out; p.ws = (unsigned char*)d_ws;
    hipLaunchKernelGGL(mega_fwd, dim3(grid), dim3(512), LDS_BYTES, stream, p);
}
```

```cpp
#include <hip/hip_runtime.h>
#include <stdint.h>
#include <stdio.h>

#define LAS __attribute__((address_space(3)))
typedef unsigned short bf16_t;
typedef short bf16x8 __attribute__((ext_vector_type(8)));
typedef short s16x4 __attribute__((ext_vector_type(4)));
typedef float f32x4 __attribute__((ext_vector_type(4)));
typedef float f32x2 __attribute__((ext_vector_type(2)));
typedef unsigned u32x4 __attribute__((ext_vector_type(4)));
typedef unsigned u32x2 __attribute__((ext_vector_type(2)));
typedef int i32x4 __attribute__((ext_vector_type(4)));
typedef int i32x8 __attribute__((ext_vector_type(8)));

constexpr int T = 32768, D = 1024, SEQ = 4096, NL = 4, PIN = 2576, NPJ = 2560, NIN = 2816;
constexpr int LDS_BYTES = 147456, SCR_OFF = 1024;
constexpr int L_BLK = 64, L_CNT = 256, L_NB = 384, L_QW = 448, L_BEX = 512;
constexpr float EPS = 1e-6f;
constexpr size_t al256(size_t x) { return (x + 255) & ~(size_t)255; }
constexpr size_t WS_CTL = 0, CTL_BYTES = 1 << 20, CTL_CNT = 16384, CTL_Q = 20480;
constexpr size_t WS_MOD = WS_CTL + CTL_BYTES;
constexpr size_t WS_WIN = WS_MOD + al256((size_t)4 * 8 * 6144 * 4);
constexpr size_t WS_WOUT = WS_WIN + (size_t)4 * 2816 * 1024 * 2;
constexpr size_t WS_W13 = WS_WOUT + (size_t)4 * 1024 * 1024 * 2;
constexpr size_t WS_W2 = WS_W13 + (size_t)4 * 32 * 1024 * 1024 * 2;
constexpr size_t WS_WS = WS_W2 + (size_t)4 * 32 * 1024 * 512 * 2;
constexpr size_t WS_WR = WS_WS + (size_t)4 * 4 * 128 * 128 * 2;
constexpr size_t WS_H = WS_WR + (size_t)4 * 48 * 1024 * 2;
constexpr size_t WS_PROJ = WS_H + (size_t)T * 1024 * 2;
constexpr size_t WS_GATE = WS_PROJ + (size_t)T * 2560 * 2;
constexpr size_t WS_KV = WS_GATE + (size_t)T * 256 * 4;
constexpr size_t WS_SST = WS_KV + (size_t)2048 * 8192 * 4;
constexpr size_t WS_DEC = WS_SST + (size_t)2048 * 8192 * 2;
constexpr size_t WS_Y = WS_DEC + (size_t)2048 * 64 * 4;
constexpr size_t WS_ROUTE = WS_Y + (size_t)T * 1024 * 2;
constexpr size_t WS_TOKOF = WS_ROUTE + (size_t)T * 32;
constexpr size_t WS_XB = WS_TOKOF + (size_t)32 * 32768 * 4;
constexpr size_t WS_PSQ = WS_XB + (size_t)T * 1024 * 2;
constexpr size_t WS_AVSQ = WS_PSQ + (size_t)T * 16 * 4;
constexpr size_t WS_HS = WS_AVSQ + (size_t)T * 8 * 4;
constexpr size_t WS_WQ = WS_HS + (size_t)T * 8 * 4;
constexpr size_t WS_WQS = WS_WQ + (size_t)4 * 2816 * 1024;
constexpr size_t WS_END = WS_WQS + al256((size_t)4 * 2816 * 4);
static_assert((size_t)73728 * 1024 * 2 <= (size_t)T * 2560 * 2, "YPAD alias");
static_assert((size_t)73728 * 512 * 2 <= (size_t)2048 * 8192 * 6, "HID alias");

__device__ __forceinline__ int lane_id() { int r; asm volatile("v_mbcnt_lo_u32_b32 %0, -1, 0\n\tv_mbcnt_hi_u32_b32 %0, -1, %0" : "=v"(r)); return r; }
__device__ __forceinline__ unsigned pk2(float lo, float hi) { unsigned r; asm("v_cvt_pk_bf16_f32 %0, %1, %2" : "=v"(r) : "v"(lo), "v"(hi)); return r; }
__device__ __forceinline__ float bflo(unsigned u) { return __uint_as_float(u << 16); }
__device__ __forceinline__ float bfhi(unsigned u) { return __uint_as_float(u & 0xffff0000u); }
__device__ __forceinline__ float bf1(bf16_t u) { return __uint_as_float(((unsigned)u) << 16); }
__device__ __forceinline__ float fexp(float x) { return __builtin_amdgcn_exp2f(x * 1.4426950408889634f); }
__device__ __forceinline__ float frcp(float x) { return __builtin_amdgcn_rcpf(x); }
__device__ __forceinline__ float frsq(float x) { return __builtin_amdgcn_rsqf(x); }
__device__ __forceinline__ float silu_f(float x) { return x * frcp(1.f + fexp(-x)); }
__device__ __forceinline__ float gelu_f(float x) { const float u = 1.5957691216057308f * (x + 0.044715f * x * x * x); return x * frcp(1.f + fexp(-u)); }
__device__ __forceinline__ f32x2 silu_pk(f32x2 x) { const f32x2 t = x * (-1.4426950408889634f); f32x2 e; e.x = __builtin_amdgcn_exp2f(t.x); e.y = __builtin_amdgcn_exp2f(t.y);
    const f32x2 d = e + 1.0f; f32x2 r; r.x = __builtin_amdgcn_rcpf(d.x); r.y = __builtin_amdgcn_rcpf(d.y); return x * r; }
__device__ __forceinline__ f32x2 gelu_pk(f32x2 x) { const f32x2 t = (x * x * (-0.10294324f) + (-2.3022082f)) * x; f32x2 e; e.x = __builtin_amdgcn_exp2f(t.x); e.y = __builtin_amdgcn_exp2f(t.y);
    const f32x2 d = e + 1.0f; f32x2 r; r.x = __builtin_amdgcn_rcpf(d.x); r.y = __builtin_amdgcn_rcpf(d.y); return x * r; }
__device__ __forceinline__ f32x4 silu4(f32x4 v) { const f32x2 a = silu_pk((f32x2){v[0], v[1]}), b = silu_pk((f32x2){v[2], v[3]}); return (f32x4){a.x, a.y, b.x, b.y}; }
__device__ __forceinline__ f32x4 gelu4(f32x4 v) { const f32x2 a = gelu_pk((f32x2){v[0], v[1]}), b = gelu_pk((f32x2){v[2], v[3]}); return (f32x4){a.x, a.y, b.x, b.y}; }
__device__ __forceinline__ float logsig_f(float x) { return fminf(x, 0.f) - 0.6931471805599453f * __builtin_amdgcn_logf(1.f + fexp(-fabsf(x))); }

#define XB_TMO      128
#define XB_XCNT(j)  (256  + 64 * (j))
#define XB_XSUB(j)  (1280 + 64 * (j))
#define XB_XGEN(j)  (2304 + 64 * (j))
#define XB_TOP      3328
#define XB_TOPGEN   3392
#define XCD_BAR_WORDS 3456
#define XB_SPIN_CAP (1u << 18)
__device__ __forceinline__ unsigned xb_ld(unsigned* p)              { return __hip_atomic_load(p, __ATOMIC_RELAXED, __HIP_MEMORY_SCOPE_AGENT); }
__device__ __forceinline__ unsigned xb_add(unsigned* p, unsigned v) { return __hip_atomic_fetch_add(p, v, __ATOMIC_RELAXED, __HIP_MEMORY_SCOPE_AGENT); }
__device__ __forceinline__ unsigned xb_xcc_id() { return (unsigned)__builtin_amdgcn_s_getreg((3 << 11) | 20) & 0xFu; }
#define XB_SPIN(cond, bar) do { unsigned _sp = 0; while (cond) { __builtin_amdgcn_s_sleep(1); \
    if ((++_sp & 255u) == 0u) { if (xb_ld(&(bar)[XB_TMO])) break; if (_sp > XB_SPIN_CAP) { atomicAdd(&(bar)[XB_TMO], 1u); break; } } } } while (0)
struct XcdBarrier { unsigned* bar; unsigned x; volatile LAS unsigned* st; };
__device__ __forceinline__ XcdBarrier xcd_barrier_post(unsigned* bar, volatile LAS unsigned* st, bool leader) {
    XcdBarrier b; b.bar = bar; b.x = xb_xcc_id(); b.st = st;
    if (leader) (void)xb_add(&bar[XB_XCNT(b.x)], 1u);
    return b;
}
__device__ __forceinline__ void xcd_barrier_complete(unsigned* bar, unsigned x, unsigned& nloc, unsigned& nx) {
    const unsigned G = gridDim.x * gridDim.y * gridDim.z;
    unsigned sum, cnt, mine, sp = 0u;
    for (;;) {
        sum = 0u; cnt = 0u; mine = 0u;
#pragma unroll
        for (unsigned j = 0; j < 16; ++j) { const unsigned c = xb_ld(&bar[XB_XCNT(j)]); sum += c; cnt += (c > 0u) ? 1u : 0u; mine = (j == x) ? c : mine; }
        if (sum == G) break;
        __builtin_amdgcn_s_sleep(1);
        if ((++sp & 255u) == 0u) { if (xb_ld(&bar[XB_TMO])) break; if (sp > XB_SPIN_CAP) { atomicAdd(&bar[XB_TMO], 1u); break; } }
    }
    nloc = mine > 0u ? mine : 1u; nx = cnt > 0u ? cnt : 1u;
}
__device__ __forceinline__ void xcd_barrier(const XcdBarrier& b, bool leader) {
    asm volatile("s_waitcnt vmcnt(0)" ::: "memory");
    __syncthreads();
    if (leader) {
        unsigned* bar = b.bar;
        __builtin_amdgcn_s_waitcnt(0);
        unsigned nloc = b.st[0], nx = b.st[1];
        if (nloc == 0u) { xcd_barrier_complete(bar, b.x, nloc, nx); b.st[0] = nloc; b.st[1] = nx; }
        const unsigned old = xb_add(&bar[XB_XSUB(b.x)], 1u);
        const unsigned gen = old / nloc;
        if (old + 1u == (gen + 1u) * nloc) {
            __builtin_amdgcn_fence(__ATOMIC_RELEASE, "agent");
            asm volatile("s_waitcnt vmcnt(0)" ::: "memory");
            const unsigned og = xb_add(&bar[XB_TOP], 1u);
            const unsigned tg = og / nx;
            if (og + 1u == (tg + 1u) * nx) xb_add(&bar[XB_TOPGEN], 1u);
            else XB_SPIN(xb_ld(&bar[XB_TOPGEN]) == tg, bar);
            __builtin_amdgcn_fence(__ATOMIC_ACQUIRE, "agent");
            xb_add(&bar[XB_XGEN(b.x)], 1u);
            asm volatile("s_waitcnt vmcnt(0)" ::: "memory");
        } else {
            XB_SPIN(xb_ld(&bar[XB_XGEN(b.x)]) == gen, bar);
            __builtin_amdgcn_fence(__ATOMIC_ACQUIRE, "agent");
            asm volatile("s_waitcnt vmcnt(0)" ::: "memory");
        }
    }
    __syncthreads();
}

namespace pg8 {
__device__ __forceinline__ bf16x8 as_bf16x8(i32x4 v) { return __builtin_bit_cast(bf16x8, v); }
__device__ __forceinline__ i32x4 lo4(i32x8 v) { return v.lo; }
__device__ __forceinline__ i32x4 hi4(i32x8 v) { return v.hi; }
constexpr int BM = 256, BK = 64, HALF = 128, HTB = HALF * BK * 2, STAGE_BYTES = 8 * HTB, NXCD = 8, WGM = 4;
__device__ __forceinline__ int lds_byte(int r, int c) { const int st = (r >> 4) * 2 + (c >> 5), rr = r & 15, cc = c & 31, ob = rr * 64 + cc * 2; return st * 1024 + (ob ^ (((ob >> 9) & 1) << 5)); }
__device__ __forceinline__ void stage_rc(int b, int& R, int& C) { const int st = b / 1024, sb = b % 1024, swz = sb ^ (((sb >> 9) & 1) << 5); R = (st >> 1) * 16 + swz / 64; C = (st & 1) * 32 + (swz % 64) / 2; }
__device__ __forceinline__ int perm32(int rho) { const int n = rho >> 4, i = rho & 15; return 8 * (i >> 2) + 4 * n + (i & 3); }
struct Unit { int pm, pn, e; };
__device__ __forceinline__ int xcd_remap(int L, int nwg) { const int q = nwg / NXCD, r = nwg % NXCD, xcd = L % NXCD, off = L / NXCD; return (xcd < r ? xcd * (q + 1) : r * (q + 1) + (xcd - r) * q) + off; }

template <int MODE, class Epi, class Sched>
__device__ __forceinline__ void gemm_phase(LAS unsigned char* lds, const char* Abase, const int Kb, const Sched& S, const Epi& E, const int wv) {
    int tid_ = wv * 64 + lane_id(); asm volatile("" : "+v"(tid_));
    const int tid = tid_, wid = __builtin_amdgcn_readfirstlane(tid >> 6), lane = tid & 63, wr = wid >> 2, wc = wid & 3, fr = lane & 15, fq = lane >> 4;
    constexpr bool GATHER = Sched::GATHER;
    const int nt = Kb / 128;
    int Ri[2], Ci[2]; unsigned voffB[2], voffA[2];
#pragma unroll
    for (int i = 0; i < 2; ++i) { int R, C; stage_rc(tid * 16 + i * 8192, R, C); Ri[i] = R; Ci[i] = C; const int Rb = Epi::PERM ? ((R & ~31) + perm32(R & 31)) : R; voffB[i] = (unsigned)(Rb * Kb + C * 2); voffA[i] = (unsigned)(R * Kb + C * 2); }
    const unsigned kstep = (unsigned)(BK * 2);
    const unsigned hstep = (unsigned)(HALF * Kb);
    const unsigned tstep = 2u * hstep;
    const unsigned ldsw = (unsigned)wid * 1024u;
    const int aoff = lds_byte(wr * 64 + fr, fq * 8), boff = lds_byte(wc * 32 + fr, fq * 8);
#define PG8_SA(b, h) (((b) * 2 + (h)) * HTB)
#define PG8_SB(b, h) ((4 + (b) * 2 + (h)) * HTB)
#define PG8_STAGE(bufoff, gbase, voff) do { _Pragma("unroll") for (int _i = 0; _i < 2; ++_i) \
        __builtin_amdgcn_global_load_lds((const unsigned*)((const char*)(gbase) + (voff)[_i]), (LAS unsigned*)(lds + (bufoff) + ldsw + _i * 8192), 16, 0, 0); } while (0)
#define PG8_LDA(dst, b, h) do { _Pragma("unroll") for (int m = 0; m < 4; ++m) { dst[m].lo = *(const LAS i32x4*)(lds + PG8_SA(b, h) + aoff + m * 2048); dst[m].hi = *(const LAS i32x4*)(lds + PG8_SA(b, h) + aoff + m * 2048 + 1024); } } while (0)
#define PG8_LDB(dst, b, h) do { _Pragma("unroll") for (int n = 0; n < 2; ++n) { dst[n].lo = *(const LAS i32x4*)(lds + PG8_SB(b, h) + boff + n * 2048); dst[n].hi = *(const LAS i32x4*)(lds + PG8_SB(b, h) + boff + n * 2048 + 1024); } } while (0)
#define PG8_MMA(ai, bj, At, Bt) do { __builtin_amdgcn_s_setprio(1); \
        if constexpr (MODE == 2) {   \
            _Pragma("unroll") for (int m = 0; m < 4; ++m) _Pragma("unroll") for (int n = 0; n < 2; ++n) asm volatile("v_mfma_i32_16x16x64_i8 %0, %1, %2, %0" : "+v"(acc[ai][bj][m][n]) : "v"(lo4(Bt[n])), "v"(lo4(At[m]))); \
            _Pragma("unroll") for (int m = 0; m < 4; ++m) _Pragma("unroll") for (int n = 0; n < 2; ++n) asm volatile("v_mfma_i32_16x16x64_i8 %0, %1, %2, %0" : "+v"(acc[ai][bj][m][n]) : "v"(hi4(Bt[n])), "v"(hi4(At[m]))); } \
        else _Pragma("unroll") for (int m = 0; m < 4; ++m) _Pragma("unroll") for (int n = 0; n < 2; ++n) { \
        if constexpr (MODE == 1) asm volatile("v_mfma_scale_f32_16x16x128_f8f6f4 %0, %1, %2, %0, %3, %3 op_sel_hi:[0,0,0]" : "+v"(acc[ai][bj][m][n]) : "v"(Bt[n]), "v"(At[m]), "v"(one_scale)); \
        else { acc[ai][bj][m][n] = __builtin_amdgcn_mfma_f32_16x16x32_bf16(as_bf16x8(Bt[n].lo), as_bf16x8(At[m].lo), acc[ai][bj][m][n], 0, 0, 0); \
               acc[ai][bj][m][n] = __builtin_amdgcn_mfma_f32_16x16x32_bf16(as_bf16x8(Bt[n].hi), as_bf16x8(At[m].hi), acc[ai][bj][m][n], 0, 0, 0); } } \
        __builtin_amdgcn_s_setprio(0); } while (0)
#define PG8_WAIT_V(n) asm volatile("s_waitcnt vmcnt(" #n ")" ::: "memory")
#define PG8_WAIT_L(n) asm volatile("s_waitcnt lgkmcnt(" #n ")" ::: "memory")
#define PG8_BAR __builtin_amdgcn_s_barrier()
#define PG8_SCHED __builtin_amdgcn_sched_barrier(0)
    Unit cur, nxt; int ui = 0;
    if (!S.next(0, cur)) return;
    f32x4 acc[2][2][4][2];
#pragma unroll
    for (int a = 0; a < 2; ++a)
#pragma unroll
        for (int b = 0; b < 2; ++b)
#pragma unroll
            for (int m = 0; m < 4; ++m)
#pragma unroll
                for (int n = 0; n < 2; ++n) acc[a][b][m][n] = (f32x4){0.f, 0.f, 0.f, 0.f};
    i32x8 At[4], B0[2], B1[2];
    const int one_scale = 0x7f7f7f7f;
    unsigned ao0[2], ao1[2], an0[2], an1[2];
    const char* cA0; const char* cA1;
    if constexpr (GATHER) { S.a_off(cur, Ri[0], Ci[0], ao0[0], ao1[0]); S.a_off(cur, Ri[1], Ci[1], ao0[1], ao1[1]); cA0 = Abase; cA1 = Abase; }
    else { ao0[0] = ao1[0] = an0[0] = an1[0] = voffA[0]; ao0[1] = ao1[1] = an0[1] = an1[1] = voffA[1]; cA0 = Abase + (size_t)((unsigned)cur.pm * tstep); cA1 = cA0 + hstep; }
    const char* cB = S.b_ptr(cur);
    PG8_STAGE(PG8_SB(0, 0), cB, voffB); PG8_STAGE(PG8_SB(0, 1), cB + hstep, voffB); PG8_STAGE(PG8_SA(0, 0), cA0, ao0); PG8_STAGE(PG8_SA(0, 1), cA1, ao1);
    if (wr == 1) PG8_BAR;
    PG8_WAIT_V(2); PG8_BAR;
    PG8_STAGE(PG8_SB(1, 0), cB + kstep, voffB); PG8_STAGE(PG8_SA(1, 0), cA0 + kstep, ao0); PG8_STAGE(PG8_SB(1, 1), cB + hstep + kstep, voffB);
    PG8_WAIT_V(6); PG8_BAR;
    for (;;) {
        const bool has_next = S.next(ui + 1, nxt);
        const char* nB = cB; const char* nA0 = cA0; const char* nA1 = cA1;
        if (has_next) { nB = S.b_ptr(nxt);
            if constexpr (GATHER) S.tok_stage(nxt, lds + STAGE_BYTES + 4096 + ((ui + 1) & 1) * 1024, tid, wid);
            else { nA0 = Abase + (size_t)((unsigned)nxt.pm * tstep); nA1 = nA0 + hstep; } }
        else if constexpr (GATHER) { an0[0] = ao0[0]; an0[1] = ao0[1]; an1[0] = ao1[0]; an1[1] = ao1[1]; }
        if constexpr (MODE == 2) E.stage(cur, lds + STAGE_BYTES + (ui & 1) * 2048, tid, wid);
        for (int t = 0; t < nt; t += 2) {
            const bool last = (t == nt - 2);
            const char* a1h1 = cA1 + (unsigned)(t + 1) * kstep;
            const char* a2h0 = last ? nA0 : cA0 + (unsigned)(t + 2) * kstep; const char* a2h1 = last ? nA1 : cA1 + (unsigned)(t + 2) * kstep;
            const char* b2 = last ? nB : cB + (unsigned)(t + 2) * kstep;
            const char* a3h0 = a2h0 + kstep; const char* b3 = b2 + kstep;
            unsigned x0[2], x1[2];
            if constexpr (GATHER) { if (last && has_next) { const LAS int* tk = (const LAS int*)(lds + STAGE_BYTES + 4096 + ((ui + 1) & 1) * 1024); S.a_off_lds(nxt, tk, Ri[0], Ci[0], an0[0], an1[0]); S.a_off_lds(nxt, tk, Ri[1], Ci[1], an0[1], an1[1]); } }
            if constexpr (GATHER) { x0[0] = last ? an0[0] : ao0[0]; x0[1] = last ? an0[1] : ao0[1]; x1[0] = last ? an1[0] : ao1[0]; x1[1] = last ? an1[1] : ao1[1]; }
            else { x0[0] = x1[0] = voffA[0]; x0[1] = x1[1] = voffA[1]; }
            PG8_LDB(B0, 0, 0); PG8_LDB(B1, 0, 1); PG8_SCHED; PG8_LDA(At, 0, 0); PG8_STAGE(PG8_SA(1, 1), a1h1, ao1);
            PG8_WAIT_V(8); PG8_WAIT_L(0); PG8_BAR; PG8_MMA(0, 0, At, B0); PG8_MMA(0, 1, At, B1); PG8_BAR; PG8_SCHED;
            PG8_LDA(At, 0, 1); PG8_STAGE(PG8_SB(0, 0), b2, voffB); PG8_STAGE(PG8_SB(0, 1), b2 + hstep, voffB); PG8_STAGE(PG8_SA(0, 0), a2h0, x0);
            PG8_WAIT_V(8); PG8_WAIT_L(0); PG8_BAR; PG8_MMA(1, 0, At, B0); PG8_MMA(1, 1, At, B1); PG8_BAR; PG8_SCHED;
            PG8_LDB(B0, 1, 0); PG8_LDB(B1, 1, 1); PG8_SCHED; PG8_LDA(At, 1, 0); PG8_STAGE(PG8_SA(0, 1), a2h1, x1);
            PG8_WAIT_V(8); PG8_WAIT_L(0); PG8_BAR; PG8_MMA(0, 0, At, B0); PG8_MMA(0, 1, At, B1); PG8_BAR; PG8_SCHED;
            PG8_LDA(At, 1, 1); PG8_STAGE(PG8_SB(1, 0), b3, voffB); PG8_STAGE(PG8_SB(1, 1), b3 + hstep, voffB); PG8_STAGE(PG8_SA(1, 0), a3h0, x0);
            PG8_WAIT_V(8); PG8_WAIT_L(0); PG8_BAR; PG8_MMA(1, 0, At, B0); PG8_MMA(1, 1, At, B1); PG8_BAR; PG8_SCHED;
        }
        if (wr == 0) PG8_BAR;
        if constexpr (MODE != 0) asm volatile("s_nop 15" ::: "memory");
        if constexpr (MODE == 2) E(acc, cur, wr, wc, fr, fq, (const LAS float*)(lds + STAGE_BYTES + (ui & 1) * 2048)); else E(acc, cur, wr, wc, fr, fq);
        if (!has_next) break;
#pragma unroll
        for (int a = 0; a < 2; ++a)
#pragma unroll
            for (int b = 0; b < 2; ++b)
#pragma unroll
                for (int m = 0; m < 4; ++m)
#pragma unroll
                    for (int n = 0; n < 2; ++n) acc[a][b][m][n] = (f32x4){0.f, 0.f, 0.f, 0.f};
        cur = nxt; cB = nB; cA0 = nA0; cA1 = nA1; ++ui; if constexpr (GATHER) { ao0[0] = an0[0]; ao0[1] = an0[1]; ao1[0] = an1[0]; ao1[1] = an1[1]; }
        if (wr == 1) PG8_BAR;
    }
    PG8_WAIT_V(0);
    PG8_BAR;
#undef PG8_SA
#undef PG8_SB
#undef PG8_STAGE
#undef PG8_LDA
#undef PG8_LDB
#undef PG8_MMA
#undef PG8_WAIT_V
#undef PG8_WAIT_L
#undef PG8_BAR
#undef PG8_SCHED
}
}
#define LDS_BAR() do { asm volatile("s_waitcnt lgkmcnt(0)" ::: "memory"); __builtin_amdgcn_s_barrier(); asm volatile("" ::: "memory"); } while (0)
constexpr float W8_SCALE = 32.f, W8_INV = 1.f / 32.f;
constexpr float Y8_SCALE = 8.f;
struct Params { const float* in[22]; float* out; unsigned char* ws; };
struct FP {
    const Params& P; LAS unsigned char* lds; int zi; int wv;
    __device__ __forceinline__ FP fresh() const { int q; asm volatile("s_mov_b32 %0, 0" : "=s"(q)); return FP{P, lds, q, wv}; }
#define FP_IN(name, idx) __device__ __forceinline__ const float* name() const { return P.in[idx + zi]; }
    FP_IN(x_in, 0) FP_IN(c, 1) FP_IN(w_ada, 2) FP_IN(b_ada, 3) FP_IN(n1g, 4) FP_IN(n2g, 5) FP_IN(w_in, 6) FP_IN(avg, 7) FP_IN(aws, 8) FP_IN(abs_, 9) FP_IN(bwa, 10) FP_IN(bba, 11)
    FP_IN(bog, 12) FP_IN(w_out, 13) FP_IN(w_group, 14) FP_IN(b_group, 15) FP_IN(w_router, 16) FP_IN(b_router, 17) FP_IN(w1, 18) FP_IN(w3, 19) FP_IN(w2, 20) FP_IN(fgain, 21)
#undef FP_IN
#define FP_WS(type, name, off) __device__ __forceinline__ type* name() const { return (type*)((&P.ws)[zi] + (off)); }
    FP_WS(float, MOD, WS_MOD) FP_WS(bf16_t, WIN, WS_WIN) FP_WS(bf16_t, WOUT, WS_WOUT) FP_WS(bf16_t, W13, WS_W13) FP_WS(bf16_t, W2, WS_W2) FP_WS(bf16_t, WSB, WS_WS) FP_WS(bf16_t, WR, WS_WR)
    FP_WS(bf16_t, H, WS_H) FP_WS(bf16_t, PROJ, WS_PROJ) FP_WS(unsigned char, YPAD, WS_PROJ) FP_WS(unsigned char, HID, WS_KV) FP_WS(unsigned char, Y8, WS_Y) FP_WS(unsigned char, H8, WS_H) FP_WS(unsigned char, H8I, WS_H + (size_t)T * 1024) FP_WS(float, HS, WS_HS) FP_WS(unsigned char, WQ, WS_WQ) FP_WS(float, WQS, WS_WQS) FP_WS(unsigned char, W13B, WS_W13) FP_WS(unsigned char, W2B, WS_W2) FP_WS(bf16_t, SST, WS_SST) FP_WS(bf16_t, Y, WS_Y) FP_WS(bf16_t, GATE, WS_GATE)
    FP_WS(float, KV, WS_KV) FP_WS(float, DEC, WS_DEC) FP_WS(int, ROUTE, WS_ROUTE) FP_WS(int, TOKOF, WS_TOKOF) FP_WS(int, CNT, WS_CTL + CTL_CNT) FP_WS(int, QH, WS_CTL + CTL_Q) FP_WS(bf16_t, XB, WS_XB) FP_WS(float, PSQ, WS_PSQ) FP_WS(float, AVSQ, WS_AVSQ)
#undef FP_WS
    __device__ __forceinline__ float* xcur() const { return (&P.out)[zi]; }
    __device__ __forceinline__ int tid() const { return wv * 64 + lane_id(); }
};

struct DenseSched {
    static constexpr bool GATHER = false;
    int nM, nN, nwg, G, c, Kb; const char* Bt;
    __device__ __forceinline__ bool next(int i, pg8::Unit& u) const {
        const int L = i * G + c; if (L >= nwg) return false;
        const int wgid = pg8::xcd_remap(L, nwg);
        const int nig = pg8::WGM * nN, gid = wgid / nig, fm = gid * pg8::WGM, gsz = (nM - fm) < pg8::WGM ? (nM - fm) : pg8::WGM;
        u.pm = fm + ((wgid % nig) % gsz); u.pn = (wgid % nig) / gsz; u.e = 0; return true;
    }
    __device__ __forceinline__ void a_off(const pg8::Unit&, int, int, unsigned&, unsigned&) const {}
    __device__ __forceinline__ const char* b_ptr(const pg8::Unit& u) const { return Bt + (size_t)u.pn * 256 * Kb; }
};
template <bool GATHER_> struct MoeSched {
    static constexpr bool GATHER = GATHER_;
    int nunits, G, c, Kb; const LAS int* blk; const LAS int* cnt; const int* tokof; const char* W; size_t estride, tstride;
    __device__ __forceinline__ bool next(int i, pg8::Unit& u) const {
        const int L = i * G + c; if (L >= nunits) return false;
        const int wgid = pg8::xcd_remap(L, nunits);
        u.pm = wgid >> 2; u.pn = wgid & 3; u.e = (int)((const LAS unsigned char*)blk)[(L_BEX - L_BLK) + u.pm]; return true;
    }
    __device__ __forceinline__ void a_off(const pg8::Unit& u, int R, int C, unsigned& o0, unsigned& o1) const {
        const int s0 = (u.pm - blk[u.e]) * 256 + R, s1 = s0 + 128, n = cnt[u.e];
        const int t0 = s0 < n ? tokof[u.e * 32768 + s0] : 0, t1 = s1 < n ? tokof[u.e * 32768 + s1] : 0;
        o0 = (unsigned)(t0 * Kb + C * 2); o1 = (unsigned)(t1 * Kb + C * 2);
    }
    __device__ __forceinline__ void tok_stage(const pg8::Unit& u, LAS unsigned char* dst, int tid, int wid) const {
        if (wid < 4) __builtin_amdgcn_global_load_lds((const unsigned*)(tokof + u.e * 32768 + (u.pm - blk[u.e]) * 256 + tid), (LAS unsigned*)(dst + wid * 256), 4, 0, 0);
    }
    __device__ __forceinline__ void a_off_lds(const pg8::Unit& u, const LAS int* st, int R, int C, unsigned& o0, unsigned& o1) const {
        const int s0 = (u.pm - blk[u.e]) * 256 + R, s1 = s0 + 128, n = cnt[u.e];
        const int t0 = s0 < n ? st[R] : 0, t1 = s1 < n ? st[R + 128] : 0;
        o0 = (unsigned)(t0 * Kb + C * 2); o1 = (unsigned)(t1 * Kb + C * 2);
    }
    __device__ __forceinline__ const char* b_ptr(const pg8::Unit& u) const { return W + (size_t)u.e * estride + (size_t)u.pn * tstride; }
};

#define THIN_ST(p, v) (*(p) = (v))
#define EPI_ST(p, v) (*(p) = (v))
struct EpiInProj {
    static constexpr bool PERM = true;
    bf16_t* PROJ; bf16_t* GATE; const float* b_alpha; float* avsq; const float* hs; const float* wqs;
    __device__ __forceinline__ void stage(const pg8::Unit& u, LAS unsigned char* dst, int tid, int wid) const {
        const float* src = tid < 256 ? hs + (size_t)(u.pm * 256 + tid) * 8 : wqs + u.pn * 256 + (tid - 256);
        __builtin_amdgcn_global_load_lds((const unsigned*)src, (LAS unsigned*)(dst + wid * 256), 4, 0, 0);
    }
    __device__ __forceinline__ void operator()(const f32x4 (&acc)[2][2][4][2], const pg8::Unit& u, int wr, int wc, int fr, int fq, const LAS float* sc) const {
        int rl_ = wr * 64 + fr, cl_ = wc * 32 + 8 * fq; asm volatile("" : "+v"(rl_), "+v"(cl_));
        const int row0 = u.pm * 256 + rl_, cl = cl_;
        float rsv[2][4]; f32x4 csv[2][2];
#pragma unroll
        for (int ai = 0; ai < 2; ++ai)
#pragma unroll
            for (int m = 0; m < 4; ++m) rsv[ai][m] = sc[rl_ + ai * 128 + m * 16];
#pragma unroll
        for (int bj = 0; bj < 2; ++bj)
#pragma unroll
            for (int n = 0; n < 2; ++n) csv[bj][n] = *(const LAS f32x4*)(sc + 256 + bj * 128 + cl + 4 * n);
#define EIP_ACC(ai, bj, m, n) (__builtin_convertvector(__builtin_bit_cast(i32x4, acc[ai][bj][m][n]), f32x4) * csv[bj][n] * rsv[ai][m])
        if (u.pn == 10) {
#pragma unroll
            for (int bj = 0; bj < 2; ++bj) { const f32x4 b0 = *(const f32x4*)(b_alpha + bj * 128 + cl), b1 = *(const f32x4*)(b_alpha + bj * 128 + cl + 4);
#pragma unroll
                for (int ai = 0; ai < 2; ++ai)
#pragma unroll
                    for (int m = 0; m < 4; ++m) { bf16_t* gp = GATE + (size_t)(row0 + ai * 128 + m * 16) * 256 + bj * 128 + cl; f32x4 v0 = EIP_ACC(ai, bj, m, 0) + b0, v1 = EIP_ACC(ai, bj, m, 1) + b1;
#pragma unroll
                        for (int j = 0; j < 4; ++j) { v0[j] = logsig_f(v0[j]) * 0.0625f; v1[j] = logsig_f(v1[j]) * 0.0625f; }
                        u32x4 w; w.x = pk2(v0[0], v0[1]); w.y = pk2(v0[2], v0[3]); w.z = pk2(v1[0], v1[1]); w.w = pk2(v1[2], v1[3]);
                        EPI_ST((u32x4*)gp, w); } }
        } else {
            const int mode = u.pn < 4 ? 0 : (u.pn == 4 ? 1 : (u.pn < 8 ? 2 : 3));
#pragma unroll
            for (int ai = 0; ai < 2; ++ai)
#pragma unroll
                for (int m = 0; m < 4; ++m) { bf16_t* rp = PROJ + (size_t)(row0 + ai * 128 + m * 16) * NPJ + u.pn * 256 + cl; float ssq = 0.f;
#pragma unroll
                    for (int bj = 0; bj < 2; ++bj) { f32x4 v0 = EIP_ACC(ai, bj, m, 0), v1 = EIP_ACC(ai, bj, m, 1);
                        if (mode == 0) {
                            v0 = gelu4(v0); v1 = gelu4(v1);
                            ssq += v0[0] * v0[0] + v0[1] * v0[1] + v0[2] * v0[2] + v0[3] * v0[3] + v1[0] * v1[0] + v1[1] * v1[1] + v1[2] * v1[2] + v1[3] * v1[3]; }
                        else if (mode == 1) { v0 = v0 * 0.125f; v1 = v1 * 0.125f; }
                        else if (mode == 3) {
                            v0 = silu4(v0); v1 = silu4(v1); }
                        u32x4 w; w.x = pk2(v0[0], v0[1]); w.y = pk2(v0[2], v0[3]); w.z = pk2(v1[0], v1[1]); w.w = pk2(v1[2], v1[3]);
                        EPI_ST((u32x4*)(rp + bj * 128), w); }
                    if (u.pn == 2 || u.pn == 3) { ssq += __shfl_xor(ssq, 16); ssq += __shfl_xor(ssq, 32);
                        if (fq == 0) avsq[(size_t)(row0 + ai * 128 + m * 16) * 8 + (u.pn - 2) * 4 + wc] = ssq; } }
        }
    }
};
#undef EIP_ACC
struct EpiOutProj {
    static constexpr bool PERM = true;
    const float* xin32; const bf16_t* xin16; bf16_t* xout; const float* g1; float* psq;
    __device__ __forceinline__ void operator()(const f32x4 (&acc)[2][2][4][2], const pg8::Unit& u, int wr, int wc, int fr, int fq) const {
        const int row0 = u.pm * 256 + wr * 64 + fr, col0 = u.pn * 256 + wc * 32 + 8 * fq; const float* gb = g1 + (size_t)(u.pm >> 4) * 6144 + col0;
        f32x4 gv[2][2];
#pragma unroll
        for (int bj = 0; bj < 2; ++bj)
#pragma unroll
            for (int n = 0; n < 2; ++n) gv[bj][n] = *(const f32x4*)(gb + bj * 128 + n * 4) * (W8_INV / Y8_SCALE);
#define EOP_ROW(X0, X1, ai, m, bj) do { f32x4 x0 = (X0), x1 = (X1); x0 += gv[bj][0] * acc[ai][bj][m][0]; x1 += gv[bj][1] * acc[ai][bj][m][1]; \
            ssq += x0[0] * x0[0] + x0[1] * x0[1] + x0[2] * x0[2] + x0[3] * x0[3] + x1[0] * x1[0] + x1[1] * x1[1] + x1[2] * x1[2] + x1[3] * x1[3]; \
            u32x4 w; w.x = pk2(x0[0], x0[1]); w.y = pk2(x0[2], x0[3]); w.z = pk2(x1[0], x1[1]); w.w = pk2(x1[2], x1[3]); \
            EPI_ST((u32x4*)(xout + (size_t)(row0 + ai * 128 + m * 16) * D + col0 + bj * 128), w); } while (0)
#define EOP_PSQ(ai, m) do { ssq += __shfl_xor(ssq, 16); ssq += __shfl_xor(ssq, 32); if (fq == 0) psq[(size_t)(row0 + ai * 128 + m * 16) * 16 + u.pn * 4 + wc] = ssq; } while (0)
        if (xin32 == nullptr) {
#pragma unroll
            for (int ai = 0; ai < 2; ++ai) { u32x4 xv[4][2];
#pragma unroll
                for (int m = 0; m < 4; ++m)
#pragma unroll
                    for (int bj = 0; bj < 2; ++bj) xv[m][bj] = *(const u32x4*)(xin16 + (size_t)(row0 + ai * 128 + m * 16) * D + col0 + bj * 128);
                asm volatile("" : "+v"(xv[0][0]), "+v"(xv[0][1]), "+v"(xv[1][0]), "+v"(xv[1][1]), "+v"(xv[2][0]), "+v"(xv[2][1]), "+v"(xv[3][0]), "+v"(xv[3][1]));
#pragma unroll
                for (int m = 0; m < 4; ++m) { float ssq = 0.f;
#pragma unroll
                    for (int bj = 0; bj < 2; ++bj) { const u32x4 q = xv[m][bj];
                        EOP_ROW(((f32x4){bflo(q[0]), bfhi(q[0]), bflo(q[1]), bfhi(q[1])}), ((f32x4){bflo(q[2]), bfhi(q[2]), bflo(q[3]), bfhi(q[3])}), ai, m, bj); }
                    EOP_PSQ(ai, m); } }
        } else {
#pragma unroll
            for (int ai = 0; ai < 2; ++ai)
#pragma unroll
                for (int mh = 0; mh < 2; ++mh) { f32x4 xf[2][2][2];
#pragma unroll
                    for (int m = 0; m < 2; ++m)
#pragma unroll
                        for (int bj = 0; bj < 2; ++bj) { const float* xp = xin32 + (size_t)(row0 + ai * 128 + (2 * mh + m) * 16) * D + col0 + bj * 128; xf[m][bj][0] = *(const f32x4*)xp; xf[m][bj][1] = *(const f32x4*)(xp + 4); }
                    asm volatile("" : "+v"(xf[0][0][0]), "+v"(xf[0][0][1]), "+v"(xf[0][1][0]), "+v"(xf[0][1][1]), "+v"(xf[1][0][0]), "+v"(xf[1][0][1]), "+v"(xf[1][1][0]), "+v"(xf[1][1][1]));
#pragma unroll
                    for (int m = 0; m < 2; ++m) { float ssq = 0.f;
#pragma unroll
                        for (int bj = 0; bj < 2; ++bj) EOP_ROW(xf[m][bj][0], xf[m][bj][1], ai, (2 * mh + m), bj);
                        EOP_PSQ(ai, (2 * mh + m)); } }
        }
#undef EOP_ROW
#undef EOP_PSQ
    }
};
__device__ __forceinline__ unsigned pk4_fp8(float a, float b, float c, float d) { int r = __builtin_amdgcn_cvt_pk_fp8_f32(a, b, 0, false); r = __builtin_amdgcn_cvt_pk_fp8_f32(c, d, r, true); return (unsigned)r; }
__device__ __forceinline__ f32x4 up4_fp8(unsigned u) { const f32x2 a = __builtin_amdgcn_cvt_pk_f32_fp8((int)u, false), b = __builtin_amdgcn_cvt_pk_f32_fp8((int)u, true); return (f32x4){a[0], a[1], b[0], b[1]}; }
struct EpiMoe1 {
    static constexpr bool PERM = true;
    unsigned char* HID;
    __device__ __forceinline__ void operator()(const f32x4 (&acc)[2][2][4][2], const pg8::Unit& u, int wr, int wc, int fr, int fq) const {
        const int row0 = u.pm * 256 + wr * 64 + fr, col0 = u.pn * 128 + wc * 32 + 8 * fq;
#pragma unroll
        for (int ai = 0; ai < 2; ++ai)
#pragma unroll
            for (int m = 0; m < 4; ++m) { f32x4 v0 = acc[ai][0][m][0] * W8_INV, v1 = acc[ai][0][m][1] * W8_INV; const f32x4 g0 = acc[ai][1][m][0] * W8_INV, g1 = acc[ai][1][m][1] * W8_INV;
                v0 = silu4(v0) * g0; v1 = silu4(v1) * g1;
                u32x2 w; w.x = pk4_fp8(v0[0], v0[1], v0[2], v0[3]); w.y = pk4_fp8(v1[0], v1[1], v1[2], v1[3]);
                EPI_ST((u32x2*)(HID + (size_t)(row0 + ai * 128 + m * 16) * 512 + col0), w); }
    }
};
struct EpiMoe2 {
    static constexpr bool PERM = true;
    unsigned char* YPAD;
    __device__ __forceinline__ void operator()(const f32x4 (&acc)[2][2][4][2], const pg8::Unit& u, int wr, int wc, int fr, int fq) const {
        const int row0 = u.pm * 256 + wr * 64 + fr, col0 = u.pn * 256 + wc * 32 + 8 * fq;
#pragma unroll
        for (int ai = 0; ai < 2; ++ai)
#pragma unroll
            for (int m = 0; m < 4; ++m)
#pragma unroll
                for (int bj = 0; bj < 2; ++bj) { const f32x4 v0 = acc[ai][bj][m][0] * W8_INV, v1 = acc[ai][bj][m][1] * W8_INV;
                    u32x2 w; w.x = pk4_fp8(v0[0], v0[1], v0[2], v0[3]); w.y = pk4_fp8(v1[0], v1[1], v1[2], v1[3]);
                    EPI_ST((u32x2*)(YPAD + (size_t)(row0 + ai * 128 + m * 16) * 1024 + col0 + bj * 128), w); }
    }
};

__device__ __forceinline__ bf16x8 tr_frag(LAS const unsigned char* img, int pitch, int k0, int x0, int lane) {
    LAS const unsigned char* p = img + (k0 + 8 * (lane >> 4) + ((lane & 15) >> 2)) * pitch + (x0 + 4 * (lane & 3)) * 2;
    const s16x4 a = __builtin_amdgcn_ds_read_tr16_b64_v4i16((LAS s16x4*)p), b = __builtin_amdgcn_ds_read_tr16_b64_v4i16((LAS s16x4*)(p + 4 * pitch));
    return (bf16x8){a[0], a[1], a[2], a[3], b[0], b[1], b[2], b[3]};
}
__device__ __forceinline__ bf16x8 tr_frag_p8(LAS const unsigned char* img, int pitch, int k0, int m, int lane) {
    LAS const unsigned char* p = img + (k0 + 8 * (lane >> 4) + ((lane & 15) >> 2)) * pitch + (32 * (m >> 1) + 8 * (lane & 3) + 4 * (m & 1)) * 2;
    const s16x4 a = __builtin_amdgcn_ds_read_tr16_b64_v4i16((LAS s16x4*)p), b = __builtin_amdgcn_ds_read_tr16_b64_v4i16((LAS s16x4*)(p + 4 * pitch));
    return (bf16x8){a[0], a[1], a[2], a[3], b[0], b[1], b[2], b[3]};
}
__device__ __forceinline__ int perm_p8(int m, int i) { return 32 * (m >> 1) + 8 * (i >> 2) + 4 * (m & 1) + (i & 3); }
__device__ __forceinline__ f32x4 mfma16(bf16x8 a, bf16x8 b, f32x4 c) { return __builtin_amdgcn_mfma_f32_16x16x32_bf16(a, b, c, 0, 0, 0); }
#define PIN4(x) asm volatile("" : "+v"((x)[0]), "+v"((x)[1]), "+v"((x)[2]), "+v"((x)[3]))
#define PIN8(x) asm volatile("" : "+v"((x)[0]), "+v"((x)[1]), "+v"((x)[2]), "+v"((x)[3]), "+v"((x)[4]), "+v"((x)[5]), "+v"((x)[6]), "+v"((x)[7]))
struct TrTile { const float* src; unsigned char* dst; int ldn, K, kind, k0, n0; };
__device__ __forceinline__ TrTile tr_desc(const FP& F, int l, int r) {
    TrTile t;
    if (r < 160) { t.src = F.w_in() + (size_t)l * 1024 * PIN; t.ldn = PIN; t.K = 1024; t.kind = 0; t.dst = (unsigned char*)(F.WIN() + (size_t)l * NIN * 1024); t.k0 = (r / 10) * 64; t.n0 = (r % 10) * 256; }
    else if (r < 224) { r -= 160; t.src = F.w_out() + (size_t)l * 1024 * 1024; t.ldn = 1024; t.K = 1024; t.kind = 3; t.dst = (unsigned char*)F.WOUT() + (size_t)l * 1024 * 1024; t.k0 = (r / 4) * 64; t.n0 = (r % 4) * 256; }
    else if (r < 1248) { r -= 224; const int e = r >> 5; r &= 31; t.src = F.w1() + ((size_t)l * 32 + e) * 1024 * 512; t.ldn = 512; t.K = 1024; t.kind = 1; t.dst = F.W13B() + ((size_t)l * 32 + e) * 1024 * 1024; t.k0 = (r >> 1) * 64; t.n0 = (r & 1) * 256; }
    else if (r < 2272) { r -= 1248; const int e = r >> 5; r &= 31; t.src = F.w3() + ((size_t)l * 32 + e) * 1024 * 512; t.ldn = 512; t.K = 1024; t.kind = 2; t.dst = F.W13B() + ((size_t)l * 32 + e) * 1024 * 1024; t.k0 = (r >> 1) * 64; t.n0 = (r & 1) * 256; }
    else { r -= 2272; const int e = r >> 5; r &= 31; t.src = F.w2() + ((size_t)l * 32 + e) * 512 * 1024; t.ldn = 1024; t.K = 512; t.kind = 3; t.dst = F.W2B() + ((size_t)l * 32 + e) * 1024 * 512; t.k0 = (r >> 2) * 64; t.n0 = (r & 3) * 256; }
    return t;
}
__device__ __forceinline__ void tr_load(const TrTile& t, f32x4 (&v)[8], int tid) {
    if (t.kind == 0) { const int kp = tid >> 4, nq = (tid & 15) * 4;
#pragma unroll
        for (int i = 0; i < 4; ++i) { const float* p = t.src + (size_t)(t.k0 + 2 * kp) * t.ldn + t.n0 + nq + 64 * i; v[i] = *(const f32x4*)p; v[4 + i] = *(const f32x4*)(p + t.ldn); } }
    else { const int kq = tid >> 5, nq = (tid & 31) * 4;
#pragma unroll
        for (int i = 0; i < 2; ++i)
#pragma unroll
            for (int rr = 0; rr < 4; ++rr) v[4 * i + rr] = *(const f32x4*)(t.src + (size_t)(t.k0 + 4 * kq + rr) * t.ldn + t.n0 + nq + 128 * i); }
}
__device__ __forceinline__ void convert_pull(const FP& F0, int l, int quota) {
    const FP F = F0.fresh();
    int tid_ = F.tid(); asm volatile("" : "+v"(tid_)); const int tid = tid_; volatile LAS int* qw = (volatile LAS int*)(F.lds + L_QW);
    LAS unsigned* sT = (LAS unsigned*)(F.lds + SCR_OFF);
    __syncthreads();
    if (tid == 0) qw[0] = quota > 0 ? __hip_atomic_fetch_add(F.QH() + l * 64, 1, __ATOMIC_RELAXED, __HIP_MEMORY_SCOPE_AGENT) : 3296;
    __syncthreads();
    int r = qw[0]; f32x4 v[8]; TrTile cur;
    if (r < 3296) { cur = tr_desc(F, l, r); tr_load(cur, v, tid); }
    for (int n = 1; r < 3296; ++n) {
        if (tid == 0) qw[1] = n < quota ? __hip_atomic_fetch_add(F.QH() + l * 64, 1, __ATOMIC_RELAXED, __HIP_MEMORY_SCOPE_AGENT) : 3296;
        if (cur.kind == 0) { const int kp = tid >> 4, nq = (tid & 15) * 4;
#pragma unroll
            for (int i = 0; i < 4; ++i)
#pragma unroll
                for (int j = 0; j < 4; ++j) sT[(nq + 64 * i + j) * 33 + kp] = pk2(v[i][j], v[4 + i][j]); }
        else { const int kq = tid >> 5, nq = (tid & 31) * 4;
#pragma unroll
            for (int i = 0; i < 2; ++i)
#pragma unroll
                for (int j = 0; j < 4; ++j) sT[(nq + 128 * i + j) * 17 + kq] = pk4_fp8(v[4 * i][j] * W8_SCALE, v[4 * i + 1][j] * W8_SCALE, v[4 * i + 2][j] * W8_SCALE, v[4 * i + 3][j] * W8_SCALE); }
        LDS_BAR();
        const int rn = qw[1]; const TrTile t = cur;
        if (rn < 3296) { cur = tr_desc(F, l, rn); tr_load(cur, v, tid); }
        if (t.kind == 0) {
#pragma unroll
            for (int i = 0; i < 4; ++i) { const int id = tid + 512 * i, nl = id >> 3, kc = id & 7;
                u32x4 w; w.x = sT[nl * 33 + kc * 4]; w.y = sT[nl * 33 + kc * 4 + 1]; w.z = sT[nl * 33 + kc * 4 + 2]; w.w = sT[nl * 33 + kc * 4 + 3];
                *(u32x4*)(t.dst + ((size_t)(t.n0 + nl) * t.K + t.k0 + kc * 8) * 2) = w; } }
        else {
#pragma unroll
            for (int i = 0; i < 2; ++i) { const int id = tid + 512 * i, nl = id >> 2, kc = id & 3; const int nn = t.n0 + nl;
                const int drow = t.kind == 3 ? nn : ((nn >> 7) * 256 + (nn & 127) + (t.kind == 2 ? 128 : 0));
                u32x4 w; w.x = sT[nl * 17 + kc * 4]; w.y = sT[nl * 17 + kc * 4 + 1]; w.z = sT[nl * 17 + kc * 4 + 2]; w.w = sT[nl * 17 + kc * 4 + 3];
                *(u32x4*)(t.dst + (size_t)drow * t.K + t.k0 + kc * 16) = w; } }
        LDS_BAR();
        r = rn;
    }
    __syncthreads();
}
__device__ __forceinline__ void p0_mod(const FP& F0) {
    const FP F = F0.fresh();
    int tid_ = F.tid(); asm volatile("" : "+v"(tid_)); const int tid = tid_; LAS float* sC = (LAS float*)(F.lds + SCR_OFF); LAS float* sR = sC + 8192;
    for (int j = tid; j < 8192; j += 512) sC[j] = silu_f(F.c()[j]);
    __syncthreads();
    const int cg = tid & 31, ks = tid >> 5;
    for (int it = blockIdx.x; it < 192; it += gridDim.x) {
        const int l = it / 48, j0 = (it % 48) * 128 + cg * 4; const float* wp = F.w_ada() + ((size_t)l * 1024 + ks * 64) * 6144 + j0;
        f32x4 acc[8];
#pragma unroll
        for (int b = 0; b < 8; ++b) acc[b] = (f32x4){0.f, 0.f, 0.f, 0.f};
#pragma unroll 4
        for (int k = 0; k < 64; ++k) { const f32x4 w = *(const f32x4*)(wp + (size_t)k * 6144);
#pragma unroll
            for (int b = 0; b < 8; ++b) acc[b] += w * sC[b * 1024 + ks * 64 + k]; }
#pragma unroll
        for (int b = 0; b < 8; ++b) *(LAS f32x4*)(sR + (ks * 8 + b) * 128 + cg * 4) = acc[b];
        __syncthreads();
        for (int o = tid; o < 1024; o += 512) { const int b = o >> 7, j = o & 127; float s = F.b_ada()[l * 6144 + (it % 48) * 128 + j];
#pragma unroll
            for (int q = 0; q < 16; ++q) s += sR[(q * 8 + b) * 128 + j];
            F.MOD()[((size_t)l * 8 + b) * 6144 + (it % 48) * 128 + j] = s; }
        __syncthreads();
    }
}
__device__ __forceinline__ void p0_small(const FP& F0) {
    const FP F = F0.fresh();
    int tid_ = F.tid(); asm volatile("" : "+v"(tid_));
    const size_t gsz = (size_t)gridDim.x * 512, g0 = (size_t)blockIdx.x * 512 + tid_;
    for (size_t i = g0; i < (size_t)4 * 256 * 1024; i += gsz) { const int l = (int)(i >> 18), n = (int)((i >> 10) & 255), k = (int)(i & 1023);
        const float* wl = F.w_in() + ((size_t)l * 1024 + k) * PIN + 2560; const float* wa = F.bwa() + (size_t)l * 16 * 256 + n; float s = 0.f;
#pragma unroll
        for (int r = 0; r < 16; ++r) s += wl[r] * wa[r * 256];
        F.WIN()[((size_t)l * NIN + 2560 + n) * 1024 + k] = (bf16_t)(pk2(s, 0.f) & 0xffffu); }
    for (size_t i = g0; i < (size_t)4 * 4 * 128 * 128; i += gsz) { const int t = (int)((i >> 7) & 127), s = (int)(i & 127); F.WSB()[i] = (bf16_t)(pk2(s <= t ? F.aws()[i] : 0.f, 0.f) & 0xffffu); }
    for (size_t i = g0; i < (size_t)4 * 48 * 1024; i += gsz) { const int l = (int)(i / (48 * 1024)), n = (int)((i >> 10) % 48), k = (int)(i & 1023);
        const float v = n < 4 ? F.w_group()[((size_t)l * 1024 + k) * 4 + n] : (n < 36 ? F.w_router()[((size_t)l * 1024 + k) * 32 + (n - 4)] : 0.f);
        F.WR()[i] = (bf16_t)(pk2(v, 0.f) & 0xffffu); }
}

__device__ __forceinline__ void moe_tables(const FP& F0, int l) {
    const FP F = F0.fresh();
    LAS int* blk = (LAS int*)(F.lds + L_BLK); LAS int* cnt = (LAS int*)(F.lds + L_CNT); LAS int* nb = (LAS int*)(F.lds + L_NB);
    __syncthreads();
    const int tx = F.tid();
    if (tx < 32) cnt[tx] = __hip_atomic_load(F.CNT() + l * 32 + tx, __ATOMIC_RELAXED, __HIP_MEMORY_SCOPE_AGENT);
    __syncthreads();
    if (tx == 0) { int s = 0; for (int e = 0; e < 32; ++e) { blk[e] = s; s += (cnt[e] + 255) >> 8; } blk[32] = s; nb[0] = s; }
    __syncthreads();
    if (tx < 288) { int e = 0; while (e < 31 && blk[e + 1] <= tx) ++e; ((LAS unsigned char*)(F.lds + L_BEX))[tx] = (unsigned char)e; }
    __syncthreads();
}

struct P1Row { u32x2 xb[4]; unsigned ya[4], yc[4]; float w0, w1; };
__device__ __forceinline__ void p1_issue(const FP& F, P1Row& R, const i32x4& r0, const i32x4& r1, const LAS int* blk, int t, int lane) {
    R.w0 = __int_as_float(r0[2]); R.w1 = __int_as_float(r1[1]);
    const unsigned char* y0 = F.YPAD() + ((size_t)blk[r0[0]] * 256 + r0[1]) * 1024; const unsigned char* y1 = F.YPAD() + ((size_t)blk[r0[3]] * 256 + r1[0]) * 1024;
#pragma unroll
    for (int j = 0; j < 4; ++j) { R.xb[j] = *(const u32x2*)(F.XB() + (size_t)t * D + lane * 4 + 256 * j); R.ya[j] = *(const unsigned*)(y0 + lane * 4 + 256 * j); R.yc[j] = *(const unsigned*)(y1 + lane * 4 + 256 * j); }
}
__device__ __forceinline__ void p1_finish(const FP& F, int l, int t, int lane, f32x4 (&x)[4], const f32x4 (&gv)[4], const f32x4 (&sv)[4]) {
    float ss = 0.f;
#pragma unroll
    for (int j = 0; j < 4; ++j) ss += x[j][0] * x[j][0] + x[j][1] * x[j][1] + x[j][2] * x[j][2] + x[j][3] * x[j][3];
#pragma unroll
    for (int o = 32; o >= 1; o >>= 1) ss += __shfl_xor(ss, o);
    const float rstd = frsq(ss * (1.f / D) + EPS);
    if (l < NL) {
        f32x4 hv[4]; float am = 0.f;
#pragma unroll
        for (int j = 0; j < 4; ++j) { hv[j] = x[j] * rstd * gv[j] + sv[j]; am = fmaxf(fmaxf(am, fmaxf(fabsf(hv[j][0]), fabsf(hv[j][1]))), fmaxf(fabsf(hv[j][2]), fabsf(hv[j][3]))); }
#pragma unroll
        for (int o = 32; o >= 1; o >>= 1) am = fmaxf(am, __shfl_xor(am, o));
        const float inv = am > 0.f ? 127.f / am : 0.f;
#pragma unroll
        for (int j = 0; j < 4; ++j) { const f32x4 q = hv[j] * inv + 12582912.f;
            const unsigned o = (__float_as_uint(q[0]) & 0xffu) | ((__float_as_uint(q[1]) & 0xffu) << 8) | ((__float_as_uint(q[2]) & 0xffu) << 16) | (__float_as_uint(q[3]) << 24);
            THIN_ST((unsigned*)(F.H8I() + (size_t)t * D + lane * 4 + 256 * j), o); }
        if (lane == 0) F.HS()[(size_t)t * 8] = am * (1.f / 127.f);
    } else {
#pragma unroll
        for (int j = 0; j < 4; ++j) { const f32x4 hv = x[j] * rstd * gv[j] + sv[j]; THIN_ST((f32x4*)(F.xcur() + (size_t)t * D + lane * 4 + 256 * j), hv); }
    }
}
__device__ __forceinline__ void win_requant(const FP& F, int l, int w, int lane) {
    for (int r = blockIdx.x * 8 + w; r < NIN; r += gridDim.x * 8) {
        const bf16_t* src = F.WIN() + ((size_t)l * NIN + r) * 1024 + lane * 16;
        const u32x4 a = *(const u32x4*)src, b = *(const u32x4*)(src + 8);
        float v[16];
#pragma unroll
        for (int i = 0; i < 4; ++i) { v[2 * i] = bflo(a[i]); v[2 * i + 1] = bfhi(a[i]); v[8 + 2 * i] = bflo(b[i]); v[8 + 2 * i + 1] = bfhi(b[i]); }
        float am = 0.f;
#pragma unroll
        for (int i = 0; i < 16; ++i) am = fmaxf(am, fabsf(v[i]));
#pragma unroll
        for (int o = 32; o >= 1; o >>= 1) am = fmaxf(am, __shfl_xor(am, o));
        const float inv = am > 0.f ? 127.f / am : 0.f;
        u32x4 o;
#pragma unroll
        for (int i = 0; i < 4; ++i) { unsigned q[4];
#pragma unroll
            for (int e = 0; e < 4; ++e) q[e] = __float_as_uint(v[4 * i + e] * inv + 12582912.f);
            o[i] = (q[0] & 0xffu) | ((q[1] & 0xffu) << 8) | ((q[2] & 0xffu) << 16) | (q[3] << 24); }
        *(u32x4*)(F.WQ() + ((size_t)l * NIN + r) * 1024 + lane * 16) = o;
        if (lane == 0) F.WQS()[l * NIN + r] = am * (1.f / 127.f);
    }
}
__device__ __forceinline__ void p1_rows(const FP& F0, int l) {
    const FP F = F0.fresh();
    int tid_ = F.tid(); asm volatile("" : "+v"(tid_)); const int tid = tid_, w = tid >> 6, lane = tid & 63; const LAS int* blk = (const LAS int*)(F.lds + L_BLK);
    if (l < NL) win_requant(F, l, w, lane);
    for (int u = blockIdx.x; u < 256; u += gridDim.x) {
        const int b = u >> 5, tok0 = u * 128 + w * 16;
        f32x4 gv[4], sv[4], g2v[4];
#pragma unroll
        for (int j = 0; j < 4; ++j) { const int col = lane * 4 + 256 * j;
            if (l < NL) { const float* m = F.MOD() + ((size_t)l * 8 + b) * 6144; const f32x4 g = *(const f32x4*)(F.n1g() + l * 1024 + col), sc = *(const f32x4*)(m + 1024 + col); gv[j] = g * (sc + 1.0f); sv[j] = *(const f32x4*)(m + col); }
            else { gv[j] = *(const f32x4*)(F.fgain() + col); sv[j] = (f32x4){0.f, 0.f, 0.f, 0.f}; }
            g2v[j] = l > 0 ? *(const f32x4*)(F.MOD() + ((size_t)(l - 1) * 8 + b) * 6144 + 5120 + col) : (f32x4){0.f, 0.f, 0.f, 0.f}; }
        if (l == 0) {
            f32x4 xn[4];
#pragma unroll
            for (int j = 0; j < 4; ++j) xn[j] = *(const f32x4*)(F.x_in() + (size_t)tok0 * D + lane * 4 + 256 * j);
#pragma unroll 1
            for (int i = 0; i < 16; ++i) { f32x4 x[4];
#pragma unroll
                for (int j = 0; j < 4; ++j) x[j] = xn[j];
                if (i < 15) {
#pragma unroll
                    for (int j = 0; j < 4; ++j) xn[j] = *(const f32x4*)(F.x_in() + (size_t)(tok0 + i + 1) * D + lane * 4 + 256 * j); }
                p1_finish(F, l, tok0 + i, lane, x, gv, sv); }
        } else {
            i32x4 ra = *(const i32x4*)(F.ROUTE() + (size_t)tok0 * 8), rb = *(const i32x4*)(F.ROUTE() + (size_t)tok0 * 8 + 4);
            P1Row nx; p1_issue(F, nx, ra, rb, blk, tok0, lane);
            ra = *(const i32x4*)(F.ROUTE() + (size_t)(tok0 + 1) * 8); rb = *(const i32x4*)(F.ROUTE() + (size_t)(tok0 + 1) * 8 + 4);
#pragma unroll 1
            for (int i = 0; i < 16; ++i) { const int t = tok0 + i; const P1Row cu = nx;
                if (i < 15) { p1_issue(F, nx, ra, rb, blk, t + 1, lane);
                    if (i < 14) { ra = *(const i32x4*)(F.ROUTE() + (size_t)(t + 2) * 8); rb = *(const i32x4*)(F.ROUTE() + (size_t)(t + 2) * 8 + 4); } }
                f32x4 x[4];
#pragma unroll
                for (int j = 0; j < 4; ++j) { const u32x2 xv = cu.xb[j]; const f32x4 a = up4_fp8(cu.ya[j]), c = up4_fp8(cu.yc[j]);
                    const f32x4 m = a * cu.w0 + c * cu.w1;
                    x[j] = (f32x4){bflo(xv[0]), bfhi(xv[0]), bflo(xv[1]), bfhi(xv[1])} + g2v[j] * m;
                    if (l < NL) { u32x2 xo; xo[0] = pk2(x[j][0], x[j][1]); xo[1] = pk2(x[j][2], x[j][3]); THIN_ST((u32x2*)(F.XB() + (size_t)t * D + lane * 4 + 256 * j), xo); } }
                p1_finish(F, l, t, lane, x, gv, sv); }
        }
    }
}

struct ChunkRegs { u32x4 v[4]; f32x2 g[8]; unsigned q[8], k[8]; };
template <bool WITH_Q> __device__ __forceinline__ void chunk_load(const FP& F, ChunkRegs& R, int tok0, int h, int tid) {
    const int kp = tid & 31, seg = tid >> 5;
#pragma unroll
    for (int i = 0; i < 4; ++i) { const int id = tid + 512 * i, row = id >> 4, ch = id & 15; R.v[i] = *(const u32x4*)(F.PROJ() + (size_t)(tok0 + row) * NPJ + 1536 + h * 128 + ch * 8); }
#pragma unroll
    for (int i = 0; i < 8; ++i) { const size_t t = (size_t)(tok0 + seg * 8 + i); { const unsigned gg = *(const unsigned*)(F.GATE() + t * 256 + h * 64 + 2 * kp); R.g[i] = (f32x2){bflo(gg), bfhi(gg)}; } const bf16_t* pr = F.PROJ() + t * NPJ + h * 64 + 2 * kp; R.k[i] = *(const unsigned*)(pr + 1280); if (WITH_Q) R.q[i] = *(const unsigned*)(pr + 1024); }
}
struct ChunkPre { u32x4 v[4]; f32x2 g[8]; };
__device__ __forceinline__ void chunk_pre(const FP& F, ChunkPre& R, int tok0, int h, int tid) {
    const int kp = tid & 31, seg = tid >> 5;
#pragma unroll
    for (int i = 0; i < 4; ++i) { const int id = tid + 512 * i, row = id >> 4, ch = id & 15; R.v[i] = *(const u32x4*)(F.PROJ() + (size_t)(tok0 + row) * NPJ + 1536 + h * 128 + ch * 8); }
#pragma unroll
    for (int i = 0; i < 8; ++i) { const unsigned gg = *(const unsigned*)(F.GATE() + (size_t)(tok0 + seg * 8 + i) * 256 + h * 64 + 2 * kp); R.g[i] = (f32x2){bflo(gg), bfhi(gg)}; }
}
__device__ __forceinline__ void chunk_cumsum(LAS float* sSeg, f32x2 (&g)[8], f32x2& pre, f32x2& tot, f32x2& ref, int tid) {
    const int kp = tid & 31, seg = tid >> 5;
#pragma unroll
    for (int i = 1; i < 8; ++i) g[i] += g[i - 1];
    *(LAS f32x2*)(sSeg + seg * 64 + 2 * kp) = g[7];
    LDS_BAR();
    pre = (f32x2){0.f, 0.f}; tot = pre; ref = pre;
#pragma unroll
    for (int s = 0; s < 16; ++s) { const f32x2 v = *(const LAS f32x2*)(sSeg + s * 64 + 2 * kp); tot += v; if (s < seg) pre += v; if (s < 8) ref += v; }
}

__device__ __forceinline__ void p3_agg_sgu(const FP& F0, int l) {
    const FP F = F0.fresh();
    int tid_ = F.tid(); asm volatile("" : "+v"(tid_)); const int tid = tid_, w = tid >> 6, lane = tid & 63; LAS unsigned char* sc = F.lds + SCR_OFF;
    LAS unsigned char* sV = sc; LAS unsigned char* sK = sc + 36864; LAS float* sSeg = (LAS float*)(sc + 57344); LAS float* sDec = sSeg + 1024;
    LAS unsigned char* sVn = sc + 61696; LAS float* sRstd = (LAS float*)(sc + 98560);
    LAS float* sAvg = (LAS float*)(sc + 99072); LAS float* sBs = (LAS float*)(sc + 101120);
    { const float ga = F.avg()[l * 512 + tid], gb = F.abs_()[l * 512 + tid]; sAvg[tid] = ga; sBs[tid] = gb; }
    const int tt = 16 * w + (lane & 15);
    for (int unit = blockIdx.x; unit < 256; unit += gridDim.x) {
        const int bh = unit >> 3, j = unit & 7, b = bh >> 2, h = bh & 3, tokb = b * SEQ + j * 512, tok0 = unit * 128;
        f32x4 acc[4]; f32x2 bsum = (f32x2){0.f, 0.f};
#pragma unroll
        for (int n = 0; n < 4; ++n) acc[n] = (f32x4){0.f, 0.f, 0.f, 0.f};
        ChunkPre nx; chunk_pre(F, nx, tokb, h, tid);
        unsigned nk[8];
        { const int kp = tid & 31, seg = tid >> 5;
#pragma unroll
          for (int i = 0; i < 8; ++i) nk[i] = *(const unsigned*)(F.PROJ() + (size_t)(tokb + seg * 8 + i) * NPJ + 1280 + h * 64 + 2 * kp); }
        u32x4 vc[4];
#pragma unroll
        for (int i = 0; i < 4; ++i) { const int id = tid + 512 * i, row = id >> 4, ch = id & 15; vc[i] = *(const u32x4*)(F.PROJ() + (size_t)(tok0 + row) * NPJ + 512 + ch * 8); }
        if (tid < 128) { const f32x4 p0 = *(const f32x4*)(F.AVSQ() + (size_t)(tok0 + tid) * 8), p1 = *(const f32x4*)(F.AVSQ() + (size_t)(tok0 + tid) * 8 + 4);
            sRstd[tid] = frsq((((p0[0] + p0[1]) + (p0[2] + p0[3])) + ((p1[0] + p1[1]) + (p1[2] + p1[3]))) * (1.f / 512.f) + EPS); }
        LDS_BAR();
#pragma unroll 1
        for (int it = 0; it < 4; ++it) {
            ChunkRegs cu;
#pragma unroll
            for (int i = 0; i < 4; ++i) cu.v[i] = nx.v[i];
#pragma unroll
            for (int i = 0; i < 8; ++i) cu.g[i] = nx.g[i];
#pragma unroll
            for (int i = 0; i < 8; ++i) cu.k[i] = nk[i];
            if (it < 3) chunk_pre(F, nx, tokb + (it + 1) * 128, h, tid);
            const bf16_t* wrow = F.WSB() + ((size_t)(l * 4 + it) * 128 + tt) * 128 + 8 * (lane >> 4);
            u32x4 au[4];
#pragma unroll
            for (int a = 0; a < 4; ++a) au[a] = *(const u32x4*)(F.PROJ() + (size_t)(tok0 + tt) * NPJ + it * 128 + 32 * a + 8 * (lane >> 4));
            const float bs = sBs[it * 128 + tt];
#pragma unroll
            for (int i = 0; i < 4; ++i) { const int id = tid + 512 * i, row = id >> 4, ch = id & 15; *(LAS u32x4*)(sV + row * 288 + ch * 16) = cu.v[i]; }
#pragma unroll
            for (int i = 0; i < 4; ++i) { const int id = tid + 512 * i, row = id >> 4, ch = id & 15; const u32x4 v = vc[i]; const float rs = sRstd[row];
                const f32x4 g0 = *(const LAS f32x4*)(sAvg + it * 128 + ch * 8), g1 = *(const LAS f32x4*)(sAvg + it * 128 + ch * 8 + 4);
                u32x4 o; o[0] = pk2(bflo(v[0]) * rs * g0[0], bfhi(v[0]) * rs * g0[1]); o[1] = pk2(bflo(v[1]) * rs * g0[2], bfhi(v[1]) * rs * g0[3]);
                o[2] = pk2(bflo(v[2]) * rs * g1[0], bfhi(v[2]) * rs * g1[1]); o[3] = pk2(bflo(v[3]) * rs * g1[2], bfhi(v[3]) * rs * g1[3]);
                *(LAS u32x4*)(sVn + row * 288 + ch * 16) = o; }
            if (it < 3) {
#pragma unroll
                for (int i = 0; i < 4; ++i) { const int id = tid + 512 * i, row = id >> 4, ch = id & 15; vc[i] = *(const u32x4*)(F.PROJ() + (size_t)(tok0 + row) * NPJ + 512 + (it + 1) * 128 + ch * 8); } }
            f32x2 pre, tot, ref; chunk_cumsum(sSeg, cu.g, pre, tot, ref, tid);
            bf16x8 wf[4];
#pragma unroll
            for (int ks = 0; ks < 4; ++ks) wf[ks] = *(const bf16x8*)(wrow + 32 * ks);
            { const int kp = tid & 31, seg = tid >> 5;
#pragma unroll
              for (int i = 0; i < 8; ++i) { const int t = seg * 8 + i; const f32x2 bc = pre + cu.g[i];
                  *(LAS unsigned*)(sK + t * 160 + kp * 4) = pk2(bflo(cu.k[i]) * fexp(tot[0] - bc[0]), bfhi(cu.k[i]) * fexp(tot[1] - bc[1])); }
              if (seg == 0) *(LAS f32x2*)(sDec + 2 * kp) = (f32x2){fexp(tot[0]), fexp(tot[1])};
              if (it < 3) {
#pragma unroll
                  for (int i = 0; i < 8; ++i) nk[i] = *(const unsigned*)(F.PROJ() + (size_t)(tokb + (it + 1) * 128 + seg * 8 + i) * NPJ + 1280 + h * 64 + 2 * kp); } }
            bsum += tot;
            { f32x4 z[8];
#pragma unroll
              for (int m = 0; m < 8; ++m) z[m] = (f32x4){0.f, 0.f, 0.f, 0.f};
#pragma unroll
              for (int ks = 0; ks < 4; ++ks) if (32 * ks <= 16 * w + 15) {
#pragma unroll
                  for (int hf = 0; hf < 2; ++hf) { bf16x8 vf[4];
#pragma unroll
                      for (int m = 0; m < 4; ++m) vf[m] = tr_frag_p8(sVn, 288, 32 * ks, 4 * hf + m, lane);
                      PIN4(vf);
#pragma unroll
                      for (int m = 0; m < 4; ++m) z[4 * hf + m] = mfma16(vf[m], wf[ks], z[4 * hf + m]); } }
#pragma unroll
              for (int a = 0; a < 4; ++a) { const int col = it * 128 + 32 * a + 8 * (lane >> 4);
                  u32x2 o; o[0] = pk4_fp8(Y8_SCALE * bflo(au[a][0]) * (z[2 * a][0] + bs), Y8_SCALE * bfhi(au[a][0]) * (z[2 * a][1] + bs), Y8_SCALE * bflo(au[a][1]) * (z[2 * a][2] + bs), Y8_SCALE * bfhi(au[a][1]) * (z[2 * a][3] + bs));
                  o[1] = pk4_fp8(Y8_SCALE * bflo(au[a][2]) * (z[2 * a + 1][0] + bs), Y8_SCALE * bfhi(au[a][2]) * (z[2 * a + 1][1] + bs), Y8_SCALE * bflo(au[a][3]) * (z[2 * a + 1][2] + bs), Y8_SCALE * bfhi(au[a][3]) * (z[2 * a + 1][3] + bs));
                  THIN_ST((u32x2*)(F.Y8() + (size_t)(tok0 + tt) * D + col), o); } }
            LDS_BAR();
#pragma unroll
            for (int n = 0; n < 4; ++n) acc[n] = acc[n] * sDec[16 * n + (lane & 15)];
#pragma unroll
            for (int ks = 0; ks < 4; ++ks) { bf16x8 a = tr_frag(sV, 288, 32 * ks, 16 * w, lane), kb[4];
#pragma unroll
                for (int n = 0; n < 4; ++n) kb[n] = tr_frag(sK, 160, 32 * ks, 16 * n, lane);
                asm volatile("" : "+v"(a), "+v"(kb[0]), "+v"(kb[1]), "+v"(kb[2]), "+v"(kb[3]));
#pragma unroll
                for (int n = 0; n < 4; ++n) acc[n] = mfma16(a, kb[n], acc[n]); }
            LDS_BAR();
        }
        float* kv = F.KV() + (size_t)unit * 8192 + (16 * w + 4 * (lane >> 4)) * 64 + (lane & 15);
#pragma unroll
        for (int n = 0; n < 4; ++n)
#pragma unroll
            for (int r = 0; r < 4; ++r) kv[r * 64 + 16 * n] = acc[n][r];
        if (tid < 32) *(f32x2*)(F.DEC() + (size_t)unit * 64 + 2 * tid) = (f32x2){fexp(bsum[0]), fexp(bsum[1])};
    }
}

__device__ __forceinline__ void p5_gla_seq(const FP& F0, int l) {
    const FP F = F0.fresh();
    int tid_ = F.tid(); asm volatile("" : "+v"(tid_)); const int tid = tid_, w = tid >> 6, lane = tid & 63, fr = lane & 15, fg = lane >> 4; LAS unsigned char* sc = F.lds + SCR_OFF;
    LAS unsigned char* sV = sc; LAS unsigned char* sQ = sc + 36864; LAS unsigned char* sKt = sc + 55296; LAS unsigned char* sS = sc + 73728; LAS unsigned char* sP = sc + 92160;
    LAS float* sSeg = (LAS float*)(sc + 126976);
    LAS float* sBog = (LAS float*)(sc + 131072);
    const int tt = 16 * w + fr;
    for (int unit = blockIdx.x; unit < 256; unit += gridDim.x) {
        const int bh = unit >> 3, j = unit & 7, b = bh >> 2, h = bh & 3, tokb = b * SEQ + j * 512;
        const float bgv = F.bog()[l * 512 + h * 128 + (tid & 127)];
        ChunkPre nx; chunk_pre(F, nx, tokb, h, tid);
        f32x4 st[4];
#pragma unroll
        for (int n = 0; n < 4; ++n) st[n] = (f32x4){0.f, 0.f, 0.f, 0.f};
#pragma unroll 1
        for (int i0 = 0; i0 < j; i0 += 4) {
            f32x4 kq[4][4], dq[4];
#pragma unroll
            for (int u = 0; u < 4; ++u) { const int ui = bh * 8 + (i0 + u < j ? i0 + u : i0); const float* kv = F.KV() + (size_t)ui * 8192 + (16 * w + 4 * fg) * 64 + fr;
#pragma unroll
                for (int n = 0; n < 4; ++n) { dq[u][n] = F.DEC()[ui * 64 + 16 * n + fr];
#pragma unroll
                    for (int r = 0; r < 4; ++r) kq[u][n][r] = kv[r * 64 + 16 * n]; } }
            asm volatile("" : "+v"(kq[0][0]), "+v"(kq[0][1]), "+v"(kq[0][2]), "+v"(kq[0][3]), "+v"(kq[1][0]), "+v"(kq[1][1]), "+v"(kq[1][2]), "+v"(kq[1][3]), "+v"(kq[2][0]), "+v"(kq[2][1]), "+v"(kq[2][2]), "+v"(kq[2][3]),
                              "+v"(kq[3][0]), "+v"(kq[3][1]), "+v"(kq[3][2]), "+v"(kq[3][3]), "+v"(dq[0]), "+v"(dq[1]), "+v"(dq[2]), "+v"(dq[3]));
#pragma unroll
            for (int u = 0; u < 4; ++u) if (i0 + u < j) {
#pragma unroll
                for (int n = 0; n < 4; ++n) st[n] = st[n] * dq[u][n] + kq[u][n]; } }
        { int t2 = tid; asm volatile("" : "+v"(t2)); if (t2 < 128) sBog[t2] = bgv * Y8_SCALE; }
#pragma unroll 1
        for (int c = 0; c < 4; ++c) {
            const int tok0 = tokb + c * 128;
            ChunkRegs cu; u32x4 rr[4];
#pragma unroll
            for (int i = 0; i < 4; ++i) cu.v[i] = nx.v[i];
#pragma unroll
            for (int i = 0; i < 8; ++i) cu.g[i] = nx.g[i];
            { const int kp = tid & 31, seg = tid >> 5;
#pragma unroll
              for (int i = 0; i < 8; ++i) { const bf16_t* pr = F.PROJ() + (size_t)(tok0 + seg * 8 + i) * NPJ + h * 64 + 2 * kp; cu.k[i] = *(const unsigned*)(pr + 1280); cu.q[i] = *(const unsigned*)(pr + 1024); } }
            if (c < 3) chunk_pre(F, nx, tok0 + 128, h, tid);
#pragma unroll
            for (int a = 0; a < 4; ++a) rr[a] = *(const u32x4*)(F.PROJ() + (size_t)(tok0 + tt) * NPJ + 2048 + h * 128 + 32 * a + 8 * fg);
#pragma unroll
            for (int i = 0; i < 4; ++i) { const int id = tid + 512 * i, row = id >> 4, ch = id & 15; *(LAS u32x4*)(sV + row * 288 + ch * 16) = cu.v[i]; }
            f32x2 pre, tot, ref; chunk_cumsum(sSeg, cu.g, pre, tot, ref, tid);
            float escl[4];
#pragma unroll
            for (int n = 0; n < 4; ++n) { float t2 = 0.f, r2 = 0.f;
#pragma unroll
                for (int s = 0; s < 16; ++s) { const float v = sSeg[s * 64 + 16 * n + fr]; t2 += v; if (s < 8) r2 += v; }
                escl[n] = fexp(t2 - r2); st[n] = st[n] * fexp(r2);
#pragma unroll
                for (int r = 0; r < 4; ++r) *(LAS bf16_t*)(sS + (16 * w + 4 * fg + r) * 144 + (16 * n + fr) * 2) = (bf16_t)(pk2(st[n][r], 0.f) & 0xffffu); }
            { const int kp = tid & 31, seg = tid >> 5;
#pragma unroll
              for (int i = 0; i < 8; ++i) { const int t = seg * 8 + i; const f32x2 bc = pre + cu.g[i];
                  *(LAS unsigned*)(sQ + t * 144 + kp * 4) = pk2(bflo(cu.q[i]) * fexp(bc[0] - ref[0]), bfhi(cu.q[i]) * fexp(bc[1] - ref[1]));
                  *(LAS unsigned*)(sKt + t * 144 + kp * 4) = pk2(bflo(cu.k[i]) * fexp(ref[0] - bc[0]), bfhi(cu.k[i]) * fexp(ref[1] - bc[1])); } }
            LDS_BAR();
            const bf16x8 bq0 = *(const LAS bf16x8*)(sQ + tt * 144 + (8 * fg) * 2), bq1 = *(const LAS bf16x8*)(sQ + tt * 144 + (32 + 8 * fg) * 2);
#pragma unroll
            for (int g = 0; g < 2; ++g) if (4 * g <= (w | 1)) {
                bf16x8 kf[8];
#pragma unroll
                for (int q = 0; q < 4; ++q) { kf[2 * q] = *(const LAS bf16x8*)(sKt + (16 * (4 * g + q) + fr) * 144 + (8 * fg) * 2); kf[2 * q + 1] = *(const LAS bf16x8*)(sKt + (16 * (4 * g + q) + fr) * 144 + (32 + 8 * fg) * 2); }
                PIN8(kf);
#pragma unroll
                for (int q = 0; q < 4; ++q) { f32x4 a = mfma16(kf[2 * q], bq0, (f32x4){0.f, 0.f, 0.f, 0.f}); a = mfma16(kf[2 * q + 1], bq1, a);
                    const int s0 = 16 * (4 * g + q) + 4 * fg;
                    u32x2 o; o[0] = pk2(s0 <= tt ? a[0] : 0.f, s0 + 1 <= tt ? a[1] : 0.f); o[1] = pk2(s0 + 2 <= tt ? a[2] : 0.f, s0 + 3 <= tt ? a[3] : 0.f);
                    *(LAS u32x2*)(sP + tt * 272 + s0 * 2) = o; } }
            asm volatile("s_waitcnt lgkmcnt(0)" ::: "memory");
#pragma unroll 1
            for (int ks = 0; ks < 4; ++ks) { bf16x8 a = tr_frag(sV, 288, 32 * ks, 16 * w, lane), kb[4];
#pragma unroll
                for (int n = 0; n < 4; ++n) kb[n] = tr_frag(sKt, 144, 32 * ks, 16 * n, lane);
                asm volatile("" : "+v"(a), "+v"(kb[0]), "+v"(kb[1]), "+v"(kb[2]), "+v"(kb[3]));
#pragma unroll
                for (int n = 0; n < 4; ++n) st[n] = mfma16(a, kb[n], st[n]); }
#pragma unroll
            for (int n = 0; n < 4; ++n) st[n] = st[n] * escl[n];
            f32x4 acc[8];
#pragma unroll
            for (int m = 0; m < 8; ++m) acc[m] = (f32x4){0.f, 0.f, 0.f, 0.f};
#pragma unroll 1
            for (int ks = 0; ks < 4; ++ks) if (32 * ks <= 16 * w + 15) { bf16x8 bfr = *(const LAS bf16x8*)(sP + tt * 272 + (32 * ks + 8 * fg) * 2), vf[8];
#pragma unroll
                for (int m = 0; m < 8; ++m) vf[m] = tr_frag_p8(sV, 288, 32 * ks, m, lane);
                PIN8(vf); asm volatile("" : "+v"(bfr));
#pragma unroll
                for (int m = 0; m < 8; ++m) acc[m] = mfma16(vf[m], bfr, acc[m]); }
#pragma unroll
            for (int hf = 0; hf < 2; ++hf) { bf16x8 sf[8];
#pragma unroll
                for (int q = 0; q < 4; ++q) { const int vr = perm_p8(4 * hf + q, fr); sf[2 * q] = *(const LAS bf16x8*)(sS + vr * 144 + (8 * fg) * 2); sf[2 * q + 1] = *(const LAS bf16x8*)(sS + vr * 144 + (32 + 8 * fg) * 2); }
                PIN8(sf);
#pragma unroll
                for (int q = 0; q < 4; ++q) { acc[4 * hf + q] = mfma16(sf[2 * q], bq0, acc[4 * hf + q]); acc[4 * hf + q] = mfma16(sf[2 * q + 1], bq1, acc[4 * hf + q]); } }
            float ss = 0.f;
#pragma unroll
            for (int m = 0; m < 8; ++m) ss += acc[m][0] * acc[m][0] + acc[m][1] * acc[m][1] + acc[m][2] * acc[m][2] + acc[m][3] * acc[m][3];
            ss += __shfl_xor(ss, 16); ss += __shfl_xor(ss, 32);
            const float rstd = frsq(ss * (1.f / 128.f) + EPS);
#pragma unroll
            for (int a = 0; a < 4; ++a) { const int col = h * 128 + 32 * a + 8 * fg; const f32x4 g0 = *(const LAS f32x4*)(sBog + 32 * a + 8 * fg), g1 = *(const LAS f32x4*)(sBog + 32 * a + 8 * fg + 4);
                u32x2 o; o[0] = pk4_fp8(acc[2 * a][0] * rstd * g0[0] * bflo(rr[a][0]), acc[2 * a][1] * rstd * g0[1] * bfhi(rr[a][0]), acc[2 * a][2] * rstd * g0[2] * bflo(rr[a][1]), acc[2 * a][3] * rstd * g0[3] * bfhi(rr[a][1]));
                o[1] = pk4_fp8(acc[2 * a + 1][0] * rstd * g1[0] * bflo(rr[a][2]), acc[2 * a + 1][1] * rstd * g1[1] * bfhi(rr[a][2]), acc[2 * a + 1][2] * rstd * g1[2] * bflo(rr[a][3]), acc[2 * a + 1][3] * rstd * g1[3] * bfhi(rr[a][3]));
                THIN_ST((u32x2*)(F.Y8() + (size_t)(tok0 + tt) * D + 512 + col), o); }
            LDS_BAR();
        }
    }
}

__device__ __forceinline__ void p7_norm_route(const FP& F0, int l) {
    const FP F = F0.fresh();
    int tid_ = F.tid(); asm volatile("" : "+v"(tid_)); const int tid = tid_, w = tid >> 6, lane = tid & 63, fr = lane & 15, fq = lane >> 4; LAS unsigned char* sc = F.lds + SCR_OFF;
    LAS unsigned char* sW = sc; LAS float* sG = (LAS float*)(sc + 99072); LAS float* sS = (LAS float*)(sc + 103168); LAS float* sLog = (LAS float*)(sc + 107264);
    LAS int* sCnt = (LAS int*)(sc + 131840); LAS int* sBase = sCnt + 32;
    for (int u = blockIdx.x; u < 256; u += gridDim.x) {
        const int b = u >> 5, tok0 = u * 128; const float* m = F.MOD() + ((size_t)l * 8 + b) * 6144;
        u32x4 wreg[12];
#pragma unroll
        for (int i = 0; i < 12; ++i) { const int id = tid + 512 * i, row = id >> 7, ch = id & 127; wreg[i] = *(const u32x4*)(F.WR() + ((size_t)l * 48 + row) * 1024 + ch * 8); }
        float gvv[2], svv[2];
#pragma unroll
        for (int jj = 0; jj < 2; ++jj) { const int j = tid + 512 * jj; gvv[jj] = F.n2g()[l * 1024 + j] * (1.f + m[4096 + j]); svv[jj] = m[3072 + j]; }
        const int t = tok0 + 16 * w + fr; const bf16_t* xr = F.XB() + (size_t)t * D + 16 * fq; float ss = 0.f;
#pragma unroll
        for (int q = 0; q < 4; ++q) { const f32x4 v = *(const f32x4*)(F.PSQ() + (size_t)t * 16 + 4 * q); ss += (v[0] + v[1]) + (v[2] + v[3]); }
        const float rstd = frsq(ss * (1.f / D) + EPS);
#pragma unroll
        for (int i = 0; i < 12; ++i) { const int id = tid + 512 * i, row = id >> 7, ch = id & 127; *(LAS u32x4*)(sW + row * 2064 + ch * 16) = wreg[i]; }
#pragma unroll
        for (int jj = 0; jj < 2; ++jj) { sG[tid + 512 * jj] = gvv[jj]; sS[tid + 512 * jj] = svv[jj]; }
        if (tid < 32) sCnt[tid] = 0;
        __syncthreads();
        f32x4 acc[3];
#pragma unroll
        for (int n = 0; n < 3; ++n) acc[n] = (f32x4){0.f, 0.f, 0.f, 0.f};
#pragma unroll 2
        for (int kc = 0; kc < 16; ++kc) { const int k0 = 64 * kc + 16 * fq; unsigned pk[8]; u32x4 h8;
#pragma unroll
            for (int q = 0; q < 2; ++q) { const u32x4 xv = *(const u32x4*)(xr + 64 * kc + 8 * q);
#pragma unroll
                for (int hh = 0; hh < 2; ++hh) { const f32x4 v = (f32x4){bflo(xv[2 * hh]), bfhi(xv[2 * hh]), bflo(xv[2 * hh + 1]), bfhi(xv[2 * hh + 1])};
                    const f32x4 gg = *(const LAS f32x4*)(sG + k0 + 8 * q + 4 * hh), sh = *(const LAS f32x4*)(sS + k0 + 8 * q + 4 * hh);
                    const f32x4 hv = v * rstd * gg + sh; pk[4 * q + 2 * hh] = pk2(hv[0], hv[1]); pk[4 * q + 2 * hh + 1] = pk2(hv[2], hv[3]); h8[2 * q + hh] = pk4_fp8(hv[0], hv[1], hv[2], hv[3]); } }
            u32x4 o0 = {pk[0], pk[1], pk[2], pk[3]}, o1 = {pk[4], pk[5], pk[6], pk[7]};
            THIN_ST((u32x4*)(F.H8() + (size_t)t * D + k0), h8);
            const bf16x8 a0 = __builtin_bit_cast(bf16x8, o0), a1 = __builtin_bit_cast(bf16x8, o1);
#pragma unroll
            for (int n = 0; n < 3; ++n) { LAS const unsigned char* bp = sW + (n * 16 + fr) * 2064 + k0 * 2;
                acc[n] = mfma16(a0, *(const LAS bf16x8*)bp, acc[n]); acc[n] = mfma16(a1, *(const LAS bf16x8*)(bp + 16), acc[n]); } }
#pragma unroll
        for (int n = 0; n < 3; ++n)
#pragma unroll
            for (int r = 0; r < 4; ++r) sLog[(w * 16 + 4 * fq + r) * 48 + n * 16 + fr] = acc[n][r];
        __syncthreads();
        int e0 = 0, e1 = 0, ls0 = 0, ls1 = 0; float w0 = 0.f, w1 = 0.f; const int tr_ = tok0 + 16 * w + lane;
        if (lane < 16) {
            float lg[36];
#pragma unroll
            for (int j = 0; j < 36; ++j) lg[j] = sLog[(w * 16 + lane) * 48 + j];
            float gmax = -3.0e38f; int grp = 0;
#pragma unroll
            for (int j = 0; j < 4; ++j) { lg[j] += F.b_group()[l * 4 + j]; if (lg[j] > gmax) { gmax = lg[j]; grp = j; } }
            float den = 0.f;
#pragma unroll
            for (int j = 0; j < 4; ++j) den += fexp(lg[j] - gmax);
            const float pg = 1.f / den; float m0 = -3.0e38f, m1 = -3.0e38f; int i0 = 0, i1 = 0;
#pragma unroll
            for (int j = 0; j < 8; ++j) { float v = 0.f;
#pragma unroll
                for (int gq = 0; gq < 4; ++gq) if (grp == gq) v = lg[4 + gq * 8 + j];
                v += F.b_router()[l * 32 + grp * 8 + j];
                if (v > m0) { m1 = m0; i1 = i0; m0 = v; i0 = j; } else if (v > m1) { m1 = v; i1 = j; } }
            const float ex = fexp(m1 - m0); w0 = pg / (1.f + ex); w1 = pg * ex / (1.f + ex); e0 = grp * 8 + i0; e1 = grp * 8 + i1;
            ls0 = __hip_atomic_fetch_add(sCnt + e0, 1, __ATOMIC_RELAXED, __HIP_MEMORY_SCOPE_WORKGROUP); ls1 = __hip_atomic_fetch_add(sCnt + e1, 1, __ATOMIC_RELAXED, __HIP_MEMORY_SCOPE_WORKGROUP);
        }
        __syncthreads();
        if (tid < 32) { const int cc = sCnt[tid]; sBase[tid] = cc ? __hip_atomic_fetch_add(F.CNT() + l * 32 + tid, cc, __ATOMIC_RELAXED, __HIP_MEMORY_SCOPE_AGENT) : 0; }
        __syncthreads();
        if (lane < 16) { const int s0 = sBase[e0] + ls0, s1 = sBase[e1] + ls1;
            F.TOKOF()[(size_t)e0 * 32768 + s0] = tr_; F.TOKOF()[(size_t)e1 * 32768 + s1] = tr_;
            *(i32x4*)(F.ROUTE() + (size_t)tr_ * 8) = (i32x4){e0, s0, __float_as_int(w0), e1}; *(i32x4*)(F.ROUTE() + (size_t)tr_ * 8 + 4) = (i32x4){s1, __float_as_int(w1), 0, 0}; }
        __syncthreads();
    }
}
__global__ void __launch_bounds__(512, 2) mega_fwd(Params p) {
    extern __shared__ __attribute__((aligned(16))) unsigned char lds_raw[];
    const FP F{p, (LAS unsigned char*)lds_raw, 0, __builtin_amdgcn_readfirstlane((int)(threadIdx.x >> 6))};
    for (int i = F.tid(); i < SCR_OFF / 4; i += 512) ((LAS unsigned*)F.lds)[i] = 0u;
    __syncthreads();
    (void)xcd_barrier_post((unsigned*)(p.ws + WS_CTL), (volatile LAS unsigned*)F.lds, F.tid() == 0);
#define bar XcdBarrier{(unsigned*)(p.ws + WS_CTL), xb_xcc_id(), (volatile LAS unsigned*)F.lds}, F.tid() == 0
    const int G = gridDim.x, c = blockIdx.x;
    LAS unsigned char* stage = F.lds + SCR_OFF;
    const LAS int* blk = (const LAS int*)(F.lds + L_BLK); const LAS int* cnt = (const LAS int*)(F.lds + L_CNT); const LAS int* nbp = (const LAS int*)(F.lds + L_NB);
    constexpr int QUOTA_P2 = 8, QUOTA_P9 = 4;

    convert_pull(F, 0, 1 << 30); p0_mod(F); p0_small(F);
    xcd_barrier(bar);
    for (int l = 0; l < NL; ++l) {
        p1_rows(F, l);
        xcd_barrier(bar);
        {
            const FP Fq = F.fresh();
            DenseSched S; S.nM = T / 256; S.nN = NIN / 256; S.nwg = S.nM * S.nN; S.G = G; S.c = c; S.Kb = 1024; S.Bt = (const char*)(Fq.WQ() + (size_t)l * NIN * 1024);
            EpiInProj E{Fq.PROJ(), Fq.GATE(), Fq.bba() + l * 256, Fq.AVSQ(), Fq.HS(), Fq.WQS() + l * NIN};
            pg8::gemm_phase<2>(stage, (const char*)Fq.H8I(), 1024, S, E, Fq.wv);
            if (l + 1 < NL && c >= S.nwg % G && (S.nwg % G) != 0) convert_pull(F, l + 1, QUOTA_P2);
        }
        xcd_barrier(bar);
        p3_agg_sgu(F, l);
        xcd_barrier(bar);
        p5_gla_seq(F, l);
        xcd_barrier(bar);
        {
            const FP Fq = F.fresh();
            DenseSched S; S.nM = T / 256; S.nN = 4; S.nwg = S.nM * 4; S.G = G; S.c = c; S.Kb = 1024; S.Bt = (const char*)Fq.WOUT() + (size_t)l * 1024 * 1024;
            EpiOutProj E{l == 0 ? Fq.x_in() : nullptr, Fq.XB(), Fq.XB(), Fq.MOD() + (size_t)l * 8 * 6144 + 2048, Fq.PSQ()};
            pg8::gemm_phase<1>(stage, (const char*)Fq.Y8(), 1024, S, E, Fq.wv);
        }
        xcd_barrier(bar);
        p7_norm_route(F, l);
        xcd_barrier(bar);
        moe_tables(F, l);
        {
            const FP Fq = F.fresh();
            MoeSched<true> S; S.nunits = nbp[0] * 4; S.G = G; S.c = c; S.Kb = 1024; S.blk = blk; S.cnt = cnt; S.tokof = Fq.TOKOF();
            S.W = (const char*)(Fq.W13B() + (size_t)l * 32 * 1024 * 1024); S.estride = (size_t)1024 * 1024; S.tstride = (size_t)256 * 1024;
            EpiMoe1 E{Fq.HID()};
            pg8::gemm_phase<1>(stage, (const char*)Fq.H8(), 1024, S, E, Fq.wv);
            if (l + 1 < NL && c >= S.nunits % G && (S.nunits % G) != 0) convert_pull(F, l + 1, QUOTA_P9);
        }
        xcd_barrier(bar);
        {
            const FP Fq = F.fresh();
            MoeSched<false> S; S.nunits = nbp[0] * 4; S.G = G; S.c = c; S.Kb = 512; S.blk = blk; S.cnt = cnt; S.tokof = Fq.TOKOF();
            S.W = (const char*)(Fq.W2B() + (size_t)l * 32 * 1024 * 512); S.estride = (size_t)1024 * 512; S.tstride = (size_t)256 * 512;
            EpiMoe2 E{Fq.YPAD()};
            pg8::gemm_phase<1>(stage, (const char*)Fq.HID(), 512, S, E, Fq.wv);
            if (l + 1 < NL) convert_pull(F, l + 1, 1 << 30);
        }
        xcd_barrier(bar);
    }
    p1_rows(F, NL);
}

extern "C" void kernel_launch(void* const* d_in, const int* in_sizes, int n_in, void* d_out, int out_size, void* d_ws, size_t ws_size, hipStream_t stream) {
    static int grid = 0;
    if (grid == 0) {
        if (n_in != 22 || out_size != T * D || ws_size < WS_END) { fprintf(stderr, "kernel_launch: unexpected shapes (n_in %d out %d ws %zu need %zu)\n", n_in, out_size, ws_size, (size_t)WS_END); grid = -1; return; }
        int dev = 0, cus = 0, per_cu = 0;
        if (hipGetDevice(&dev) != hipSuccess || hipDeviceGetAttribute(&cus, hipDeviceAttributeMultiprocessorCount, dev) != hipSuccess) { grid = -1; return; }
        if (hipFuncSetAttribute((const void*)mega_fwd, hipFuncAttributeMaxDynamicSharedMemorySize, LDS_BYTES) != hipSuccess) { fprintf(stderr, "kernel_launch: hipFuncSetAttribute failed\n"); grid = -1; return; }
        if (hipOccupancyMaxActiveBlocksPerMultiprocessor(&per_cu, (const void*)mega_fwd, 512, LDS_BYTES) != hipSuccess || per_cu < 1) { fprintf(stderr, "kernel_launch: occupancy query says %d\n", per_cu); }
        (void)hipGetLastError();
        grid = cus;
    }
    if (grid < 0) return;
    (void)hipMemsetAsync((char*)d_ws + WS_CTL, 0, CTL_BYTES, stream);
    Params p{};
    for (int i = 0; i < 22; ++i) p.in[i] = (const float*)d_in[i];
    p.out = (float*)d_out; p.ws = (unsigned char*)d_ws;
    hipLaunchKernelGGL(mega_fwd, dim3(grid), dim3(512), LDS_BYTES, stream, p);
}
```
